# Optimizing an MI355X kernel written in HIP

```python
import functools
import math
import jax
import jax.numpy as jnp
from jax import lax
import numpy as np

D_MODEL = 1024
BATCH = 16
SEQ = 4096
DEPTH = 2

GRID_W = 64
CTX_LEN = 256
HEAD_DIM = 64
ROPE_BASE = 10000.0
Q_BLOCK = 128
NORM_EPS = 1e-6
N_MOD = 6

HY_CH = D_MODEL // 2
HY_ORDER = 2
HY_BANDS = 16
HY_EMB = 1 + 2 * HY_BANDS
HY_HID = 64
HY_DIRS = 2
HY_DECAY_TARGET = 1e-2
HY_FAST_DECAY = 0.3
HY_SLOW_DECAY = 1.5
HY_FILTER_EPS = 1e-6

SWA_Q_HEADS = (D_MODEL // 2) // HEAD_DIM
SWA_KV_HEADS = SWA_Q_HEADS // 4
SWA_WINDOW = 128

GA_Q_HEADS = D_MODEL // HEAD_DIM
GA_KV_HEADS = GA_Q_HEADS // 4

N_GROUPS = 4
EXP_PER_GROUP = 8
N_EXPERTS = N_GROUPS * EXP_PER_GROUP
TOP_K = 2
D_EXPERT = D_MODEL // 2
MOE_BLOCK = 256

kernel_name = 'hybrid_hyena_swa_axialgqa_hmoe_dit'


def _rmsnorm(x, g):
    xf = x.astype(jnp.float32)
    y = xf * lax.rsqrt(jnp.mean(xf * xf, axis=-1, keepdims=True) + NORM_EPS)
    return (y * g.astype(jnp.float32)).astype(x.dtype)


def _axial_rope_tables(n_lat):
    rows = n_lat // GRID_W
    row, col = jnp.meshgrid(jnp.arange(rows), jnp.arange(GRID_W), indexing='ij')
    d_axis = HEAD_DIM // 2
    inv = ROPE_BASE ** (-jnp.arange(0, d_axis, 2, dtype=jnp.float32) / d_axis)
    ang_r = row.reshape(-1).astype(jnp.float32)[:, None] * inv[None, :]
    ang_c = col.reshape(-1).astype(jnp.float32)[:, None] * inv[None, :]
    return (jnp.cos(ang_r), jnp.sin(ang_r), jnp.cos(ang_c), jnp.sin(ang_c))


def _rotate(x, cos, sin):
    shape = (1, cos.shape[0]) + (1,) * (x.ndim - 3) + (cos.shape[1],)
    cos = cos.reshape(shape)
    sin = sin.reshape(shape)
    x1, x2 = jnp.split(x, 2, axis=-1)
    return jnp.concatenate([x1 * cos - x2 * sin, x2 * cos + x1 * sin], axis=-1)


def _apply_axial_rope(x, tables):
    cr, sr, cc, sc = tables
    d_axis = HEAD_DIM // 2
    xf = x.astype(jnp.float32)
    out = jnp.concatenate([_rotate(xf[..., :d_axis], cr, sr), _rotate(xf[..., d_axis:], cc, sc)], axis=-1)
    return out.astype(x.dtype)


def _joint_softmax(scores):
    m = functools.reduce(jnp.maximum, [jnp.max(s, axis=-1, keepdims=True) for s in scores])
    e = [jnp.exp(s - m) for s in scores]
    denom = functools.reduce(jnp.add, [jnp.sum(t, axis=-1, keepdims=True) for t in e])
    return [t / denom for t in e]


def _scores(q, k):
    return jnp.einsum('bqhgd,bkhd->bhgqk', q, k).astype(jnp.float32) * (HEAD_DIM ** -0.5)


def _values(p, v):
    return jnp.einsum('bhgqk,bkhd->bqhgd', p.astype(v.dtype), v)


def _sink_scores(sink, like):
    b, h, g, q, _ = like.shape
    return jnp.broadcast_to(sink.astype(jnp.float32)[None, :, :, None, None], (b, h, g, q, 1))


def _windowed_attention(q, k, v, kc, vc, sink):
    b, n, hkv, g, dh = q.shape
    nb = n // Q_BLOCK
    pad = ((0, 0), (Q_BLOCK, Q_BLOCK), (0, 0), (0, 0))
    kp = jnp.pad(k, pad)
    vp = jnp.pad(v, pad)
    qi = jnp.arange(Q_BLOCK)
    ki = jnp.arange(3 * Q_BLOCK)

    def block(i):
        q0 = i * Q_BLOCK
        qb = lax.dynamic_slice_in_dim(q, q0, Q_BLOCK, axis=1)
        kb = lax.dynamic_slice_in_dim(kp, q0, 3 * Q_BLOCK, axis=1)
        vb = lax.dynamic_slice_in_dim(vp, q0, 3 * Q_BLOCK, axis=1)
        t = q0 + qi
        s = q0 - Q_BLOCK + ki
        valid = (jnp.abs(t[:, None] - s[None, :]) <= SWA_WINDOW) & (s >= 0)[None, :] & (s < n)[None, :]
        s_lat = jnp.where(valid, _scores(qb, kb), -jnp.inf)
        s_ctx = _scores(qb, kc)
        p_ctx, p_lat, _ = _joint_softmax([s_ctx, s_lat, _sink_scores(sink, s_ctx)])
        return _values(p_ctx, vc) + _values(p_lat, vb)

    out = lax.map(block, jnp.arange(nb))
    return jnp.moveaxis(out, 0, 1).reshape(b, n, hkv * g * dh)


def _dense_attention(q, k, v, kc, vc):
    b, n, hkv, g, dh = q.shape
    nb = n // Q_BLOCK

    def block(i):
        qb = lax.dynamic_slice_in_dim(q, i * Q_BLOCK, Q_BLOCK, axis=1)
        p_ctx, p_lat = _joint_softmax([_scores(qb, kc), _scores(qb, k)])
        return _values(p_ctx, vc) + _values(p_lat, v)

    out = lax.map(block, jnp.arange(nb))
    return jnp.moveaxis(out, 0, 1).reshape(b, n, hkv * g * dh)


def _context_attention(qc, kc, vc, sink=None):
    b, lc, hkv, g, dh = qc.shape
    s = _scores(qc, kc)
    parts = [s] if sink is None else [s, _sink_scores(sink, s)]
    p = _joint_softmax(parts)[0]
    return _values(p, vc).reshape(b, lc, hkv * g * dh)


def _short_conv(u, w, b):
    n = u.shape[1]
    up = jnp.pad(u, ((0, 0), (1, 1), (0, 0)))
    return up[:, :n] * w[0] + up[:, 1:n + 1] * w[1] + up[:, 2:] * w[2] + b


def _hyena_filters(n, w1, b1, w2, b2, w3, freq):
    f32 = jnp.float32
    t = jnp.arange(n, dtype=f32)
    t_norm = t / max(n - 1, 1)
    bands = jnp.linspace(1e-4, HY_BANDS - 1, HY_BANDS, dtype=f32)
    ang = (2.0 * math.pi / n) * t[:, None] * bands[None, :]
    z = jnp.concatenate([t_norm[:, None], jnp.cos(ang), -jnp.sin(ang)], axis=-1)
    fr = freq.astype(f32)
    hdn = jnp.sin(fr * (z @ w1.astype(f32) + b1.astype(f32)))
    hdn = jnp.sin(fr * (hdn @ w2.astype(f32) + b2.astype(f32)))
    h = (hdn @ w3.astype(f32)).reshape(n, HY_DIRS, HY_ORDER, HY_CH)
    max_decay = math.log(HY_DECAY_TARGET) / HY_FAST_DECAY
    min_decay = math.log(HY_DECAY_TARGET) / HY_SLOW_DECAY
    deltas = jnp.linspace(min_decay, max_decay, HY_CH, dtype=f32)
    window = jnp.exp(-t_norm[:, None] * jnp.abs(deltas)[None, :])
    h = h * window[:, None, None, :]
    fwd = h[:, 0]
    bwd = h[1:, 1][::-1]
    filt = jnp.concatenate([fwd, jnp.zeros((1, HY_ORDER, HY_CH), f32), bwd], axis=0)
    return filt / (jnp.sum(jnp.abs(filt), axis=0, keepdims=True) + HY_FILTER_EPS)


def _long_conv(u, filt, skip):
    n = u.shape[1]
    uf = u.astype(jnp.float32)
    spec = jnp.fft.rfft(uf, n=2 * n, axis=1) * jnp.fft.rfft(filt, n=2 * n, axis=0)[None]
    y = jnp.fft.irfft(spec, n=2 * n, axis=1)[:, :n]
    return (y + uf * skip.astype(jnp.float32)).astype(u.dtype)


def _hyena(u, conv_w, conv_b, f_w1, f_b1, f_w2, f_b2, f_w3, f_freq, skip):
    u = _short_conv(u, conv_w, conv_b)
    v, x1, x2 = jnp.split(u, 3, axis=-1)
    filt = _hyena_filters(u.shape[1], f_w1, f_b1, f_w2, f_b2, f_w3, f_freq)
    z = x1 * _long_conv(v, filt[:, 0], skip[0])
    return x2 * _long_conv(z, filt[:, 1], skip[1])


def _even_mixer(h, hc, rope, w_in, w_out, conv_w, conv_b, f_w1, f_b1, f_w2, f_b2, f_w3, f_freq, skip, sink, with_ctx):
    b, n, _ = h.shape
    lc = hc.shape[1]
    g = SWA_Q_HEADS // SWA_KV_HEADS
    d_hy = 3 * HY_CH
    d_q = SWA_Q_HEADS * HEAD_DIM
    d_kv = SWA_KV_HEADS * HEAD_DIM
    hy_args = (conv_w, conv_b, f_w1, f_b1, f_w2, f_b2, f_w3, f_freq, skip)
    sink_hg = sink.reshape(SWA_KV_HEADS, g)
    p = h @ w_in
    q = _apply_axial_rope(p[..., d_hy:d_hy + d_q].reshape(b, n, SWA_Q_HEADS, HEAD_DIM), rope)
    q = q.reshape(b, n, SWA_KV_HEADS, g, HEAD_DIM)
    k = _apply_axial_rope(p[..., d_hy + d_q:d_hy + d_q + d_kv].reshape(b, n, SWA_KV_HEADS, HEAD_DIM), rope)
    v = p[..., d_hy + d_q + d_kv:].reshape(b, n, SWA_KV_HEADS, HEAD_DIM)
    pkv = hc @ w_in[:, d_hy + d_q:]
    kc = pkv[..., :d_kv].reshape(b, lc, SWA_KV_HEADS, HEAD_DIM)
    vc = pkv[..., d_kv:].reshape(b, lc, SWA_KV_HEADS, HEAD_DIM)
    y_hy = _hyena(p[..., :d_hy], *hy_args)
    y_att = _windowed_attention(q, k, v, kc, vc, sink_hg)
    y = jnp.concatenate([y_hy, y_att], axis=-1) @ w_out
    if not with_ctx:
        return y, None
    pqc = hc @ w_in[:, :d_hy + d_q]
    qc = pqc[..., d_hy:].reshape(b, lc, SWA_KV_HEADS, g, HEAD_DIM)
    yc_hy = _hyena(pqc[..., :d_hy], *hy_args)
    yc = jnp.concatenate([yc_hy, _context_attention(qc, kc, vc, sink_hg)], axis=-1) @ w_out
    return y, yc


def _odd_mixer(h, hc, rope, w_qkv, w_out, qn_g, kn_g, with_ctx):
    b, n, _ = h.shape
    lc = hc.shape[1]
    g = GA_Q_HEADS // GA_KV_HEADS
    d_q = GA_Q_HEADS * HEAD_DIM
    d_kv = GA_KV_HEADS * HEAD_DIM
    p = h @ w_qkv
    q = _rmsnorm(p[..., :d_q].reshape(b, n, GA_Q_HEADS, HEAD_DIM), qn_g)
    k = _rmsnorm(p[..., d_q:d_q + d_kv].reshape(b, n, GA_KV_HEADS, HEAD_DIM), kn_g)
    v = p[..., d_q + d_kv:].reshape(b, n, GA_KV_HEADS, HEAD_DIM)
    q = _apply_axial_rope(q, rope).reshape(b, n, GA_KV_HEADS, g, HEAD_DIM)
    k = _apply_axial_rope(k, rope)
    pkv = hc @ w_qkv[:, d_q:]
    kc = _rmsnorm(pkv[..., :d_kv].reshape(b, lc, GA_KV_HEADS, HEAD_DIM), kn_g)
    vc = pkv[..., d_kv:].reshape(b, lc, GA_KV_HEADS, HEAD_DIM)
    y = _dense_attention(q, k, v, kc, vc) @ w_out
    if not with_ctx:
        return y, None
    qc = _rmsnorm((hc @ w_qkv[:, :d_q]).reshape(b, lc, GA_Q_HEADS, HEAD_DIM), qn_g)
    yc = _context_attention(qc.reshape(b, lc, GA_KV_HEADS, g, HEAD_DIM), kc, vc) @ w_out
    return y, yc


def _grouped_experts(t, experts, gates, w_gate, w_up, w_down):
    n_tok, d = t.shape
    n_assign = n_tok * TOP_K
    e_flat = experts.reshape(n_assign)
    g_flat = gates.reshape(n_assign)
    tok = jnp.broadcast_to(jnp.arange(n_tok)[:, None], (n_tok, TOP_K)).reshape(n_assign)
    order = jnp.argsort(e_flat)
    e_s = e_flat[order]
    tok_s = tok[order]
    g_s = g_flat[order]
    counts = jnp.bincount(e_flat, length=N_EXPERTS)
    padded = ((counts + MOE_BLOCK - 1) // MOE_BLOCK) * MOE_BLOCK
    ends = jnp.cumsum(padded)
    pstart = ends - padded
    start = jnp.cumsum(counts) - counts
    slot = pstart[e_s] + (jnp.arange(n_assign) - start[e_s])
    n_blocks = -(-n_assign // MOE_BLOCK) + N_EXPERTS
    n_slots = n_blocks * MOE_BLOCK
    slot_tok = jnp.zeros((n_slots,), jnp.int32).at[slot].set(tok_s.astype(jnp.int32))
    slot_gate = jnp.zeros((n_slots,), jnp.float32).at[slot].set(g_s)
    block_exp = jnp.minimum(jnp.searchsorted(ends, jnp.arange(n_blocks) * MOE_BLOCK, side='right'), N_EXPERTS - 1)

    def run(args):
        e, toks, gb = args
        xb = t[toks]
        hid = jax.nn.silu(xb @ w_gate[e]) * (xb @ w_up[e])
        return (hid @ w_down[e]) * gb.astype(t.dtype)[:, None]

    out = lax.map(run, (block_exp, slot_tok.reshape(n_blocks, MOE_BLOCK), slot_gate.reshape(n_blocks, MOE_BLOCK)))
    return jnp.zeros((n_tok, d), t.dtype).at[slot_tok].add(out.reshape(n_slots, d))


def _hier_moe(t, wg, bg, we, be, w_gate, w_up, w_down):
    n_tok = t.shape[0]
    tf = t.astype(jnp.float32)
    g_logits = tf @ wg.astype(jnp.float32) + bg.astype(jnp.float32)
    _, grp = lax.top_k(g_logits, 1)
    p_grp = jnp.take_along_axis(jax.nn.softmax(g_logits, axis=-1), grp, axis=-1)
    e_logits = (tf @ we.astype(jnp.float32) + be.astype(jnp.float32)).reshape(n_tok, N_GROUPS, EXP_PER_GROUP)
    e_logits = jnp.take_along_axis(e_logits, grp[:, :, None], axis=1)[:, 0]
    top_l, top_i = lax.top_k(e_logits, TOP_K)
    gates = p_grp * jax.nn.softmax(top_l, axis=-1)
    experts = grp * EXP_PER_GROUP + top_i
    return _grouped_experts(t, experts, gates, w_gate, w_up, w_down)


def setup_inputs(seed: int = 0) -> dict:
    key = jax.random.key(seed)
    ks = list(jax.random.split(key, 32))
    f32 = jnp.float32
    d = D_MODEL
    n_even = (DEPTH + 1) // 2
    n_odd = DEPTH // 2
    d_in_even = 3 * HY_CH + (SWA_Q_HEADS + 2 * SWA_KV_HEADS) * HEAD_DIM
    d_mix_even = HY_CH + SWA_Q_HEADS * HEAD_DIM
    d_qkv_odd = (GA_Q_HEADS + 2 * GA_KV_HEADS) * HEAD_DIM
    d_mix_odd = GA_Q_HEADS * HEAD_DIM

    def nrm(i, shape, scale):
        return jax.random.normal(ks[i], shape, f32) * scale

    return {
        'x': nrm(0, (BATCH, SEQ, d), 1.0),
        'c': nrm(1, (BATCH, d), 1.0),
        'ctx': nrm(2, (BATCH, CTX_LEN, d), 1.0),
        'c_ctx': nrm(3, (d,), 1.0),
        'ada_w': nrm(4, (DEPTH, d, N_MOD * d), 0.5 * d ** -0.5),
        'ada_b': nrm(5, (DEPTH, N_MOD * d), 0.02),
        'norm1_g': 1.0 + nrm(6, (DEPTH, d), 0.02),
        'norm2_g': 1.0 + nrm(7, (DEPTH, d), 0.02),
        'ev_w_in': nrm(8, (n_even, d, d_in_even), d ** -0.5),
        'ev_w_out': nrm(9, (n_even, d_mix_even, d), d_mix_even ** -0.5),
        'hy_conv_w': nrm(10, (n_even, 3, 3 * HY_CH), 3 ** -0.5),
        'hy_conv_b': nrm(11, (n_even, 3 * HY_CH), 0.02),
        'hy_f_w1': nrm(12, (n_even, HY_EMB, HY_HID), 1.0),
        'hy_f_b1': nrm(13, (n_even, HY_HID), 0.02),
        'hy_f_w2': nrm(14, (n_even, HY_HID, HY_HID), HY_HID ** -0.5),
        'hy_f_b2': nrm(15, (n_even, HY_HID), 0.02),
        'hy_f_w3': nrm(16, (n_even, HY_HID, HY_DIRS * HY_ORDER * HY_CH), HY_HID ** -0.5),
        'hy_f_freq': 1.0 + nrm(17, (n_even, HY_HID), 0.02),
        'hy_skip': nrm(18, (n_even, HY_ORDER, HY_CH), 0.1),
        'swa_sink': nrm(19, (n_even, SWA_Q_HEADS), 0.5),
        'od_w_qkv': nrm(20, (n_odd, d, d_qkv_odd), d ** -0.5),
        'od_w_out': nrm(21, (n_odd, d_mix_odd, d), d_mix_odd ** -0.5),
        'od_q_norm_g': 1.0 + nrm(22, (n_odd, HEAD_DIM), 0.02),
        'od_k_norm_g': 1.0 + nrm(23, (n_odd, HEAD_DIM), 0.02),
        'rt_group_w': nrm(24, (DEPTH, d, N_GROUPS), d ** -0.5),
        'rt_group_b': nrm(25, (DEPTH, N_GROUPS), 0.01),
        'rt_exp_w': nrm(26, (DEPTH, d, N_EXPERTS), d ** -0.5),
        'rt_exp_b': nrm(27, (DEPTH, N_EXPERTS), 0.01),
        'moe_w_gate': nrm(28, (DEPTH, N_EXPERTS, d, D_EXPERT), d ** -0.5),
        'moe_w_up': nrm(29, (DEPTH, N_EXPERTS, d, D_EXPERT), d ** -0.5),
        'moe_w_down': nrm(30, (DEPTH, N_EXPERTS, D_EXPERT, d), D_EXPERT ** -0.5),
        'final_norm_g': 1.0 + nrm(31, (d,), 0.02),
    }


def reference(x, c, ctx, c_ctx, ada_w, ada_b, norm1_g, norm2_g, ev_w_in, ev_w_out, hy_conv_w, hy_conv_b,
              hy_f_w1, hy_f_b1, hy_f_w2, hy_f_b2, hy_f_w3, hy_f_freq, hy_skip, swa_sink, od_w_qkv, od_w_out,
              od_q_norm_g, od_k_norm_g, rt_group_w, rt_group_b, rt_exp_w, rt_exp_b, moe_w_gate, moe_w_up,
              moe_w_down, final_norm_g):
    b, n, d = x.shape
    rope = _axial_rope_tables(n)
    xc = ctx
    sc = jax.nn.silu(c)
    scc = jax.nn.silu(c_ctx)
    for layer in range(DEPTH):
        with_ctx = layer < DEPTH - 1
        mod = (sc @ ada_w[layer] + ada_b[layer]).reshape(b, N_MOD, 1, d)
        modc = (scc @ ada_w[layer] + ada_b[layer]).reshape(N_MOD, d)
        h = _rmsnorm(x, norm1_g[layer]) * (1 + mod[:, 1]) + mod[:, 0]
        hc = _rmsnorm(xc, norm1_g[layer]) * (1 + modc[1]) + modc[0]
        if layer % 2 == 0:
            e = layer // 2
            y, yc = _even_mixer(h, hc, rope, ev_w_in[e], ev_w_out[e], hy_conv_w[e], hy_conv_b[e], hy_f_w1[e],
                                hy_f_b1[e], hy_f_w2[e], hy_f_b2[e], hy_f_w3[e], hy_f_freq[e], hy_skip[e],
                                swa_sink[e], with_ctx)
        else:
            o = layer // 2
            y, yc = _odd_mixer(h, hc, rope, od_w_qkv[o], od_w_out[o], od_q_norm_g[o], od_k_norm_g[o], with_ctx)
        x = x + mod[:, 2] * y
        h2 = _rmsnorm(x, norm2_g[layer]) * (1 + mod[:, 4]) + mod[:, 3]
        moe_w = (rt_group_w[layer], rt_group_b[layer], rt_exp_w[layer], rt_exp_b[layer],
                 moe_w_gate[layer], moe_w_up[layer], moe_w_down[layer])
        if with_ctx:
            xc = xc + modc[2] * yc
            h2c = _rmsnorm(xc, norm2_g[layer]) * (1 + modc[4]) + modc[3]
            tokens = jnp.concatenate([h2.reshape(b * n, d), h2c.reshape(-1, d)], axis=0)
            out = _hier_moe(tokens, *moe_w)
            x = x + mod[:, 5] * out[:b * n].reshape(b, n, d)
            xc = xc + modc[5] * out[b * n:].reshape(xc.shape)
        else:
            x = x + mod[:, 5] * _hier_moe(h2.reshape(b * n, d), *moe_w).reshape(b, n, d)
    return _rmsnorm(x, final_norm_g)
```

```cpp
#include <hip/hip_runtime.h>
#include <hip/hip_bf16.h>
#include <cstdio>
#include <cstdint>
#include <cmath>

#define GAS __attribute__((address_space(1)))
#define LAS __attribute__((address_space(3)))
typedef unsigned short bf16;
typedef unsigned short bf16_t;
typedef short bf16x8 __attribute__((ext_vector_type(8)));
typedef short s16x4 __attribute__((ext_vector_type(4)));
typedef float f32x2 __attribute__((ext_vector_type(2)));
typedef float f32x4 __attribute__((ext_vector_type(4)));
typedef float f32x16 __attribute__((ext_vector_type(16)));
typedef unsigned u32x2 __attribute__((ext_vector_type(2)));
typedef unsigned u32x4 __attribute__((ext_vector_type(4)));
typedef unsigned v4u __attribute__((ext_vector_type(4)));
typedef GAS unsigned gu32;

constexpr int NB = 16, SEQ = 4096, CTXL = 256, DM = 1024, RPB = SEQ + CTXL  , NROWS = NB * RPB  ;
constexpr int HYC = 512, HD = 64, NEXP = 32, DEXP = 512, NMOD = 6;
constexpr int D_IN_EVEN = 2304, D_ATT0 = 768, D_QKV1 = 1536;
constexpr float NORM_EPS = 1e-6f;
constexpr float LOG2E = 1.4426950408889634f;
constexpr float QSCALE = 0.125f * 1.4426950408889634f;
constexpr int CAP = NROWS;
constexpr int MAXSLOTS = 147456;

constexpr size_t MiB = 1u << 20;
constexpr size_t WS_CTL = 0, CTL_ZERO_BYTES = 1 * MiB;
constexpr size_t WS_MOD = 1 * MiB;
constexpr size_t WS_ROPE = 2 * MiB;
constexpr size_t WS_HD2 = 2 * MiB + 65536;
constexpr size_t WS_ROUTE = 3 * MiB + 512 * 1024;
constexpr size_t WS_TOKIDX = 5 * MiB;
constexpr size_t WS_GATE = 14 * MiB;
constexpr size_t WS_HRAW = 23 * MiB;
constexpr size_t WS_HRAWC = 55 * MiB;
constexpr size_t WS_WHY = 57 * MiB;
constexpr size_t WS_WATT0 = 60 * MiB;
constexpr size_t WS_WOUT0 = 62 * MiB;
constexpr size_t WS_WQKV1 = 64 * MiB;
constexpr size_t WS_WOUT1 = 67 * MiB;
constexpr size_t WS_WGU = 69 * MiB;
constexpr size_t WS_WDN = 197 * MiB;
constexpr size_t WS_XC = 261 * MiB;
constexpr size_t WS_BUF1 = 277 * MiB;
constexpr size_t WS_BUF2 = 413 * MiB;
constexpr size_t WS_BUF3 = 617 * MiB;
constexpr size_t WS_BUF5 = 719 * MiB;
constexpr size_t WS_BUF4 = 863 * MiB;
constexpr size_t WS_Y = 863 * MiB;
constexpr size_t WS_END = 999 * MiB;
static_assert(WS_BUF2 + (size_t)MAXSLOTS * 1024 * 2 <= WS_BUF5, "MOUT fits BUF2+BUF3");
constexpr int CW_TMO = 0, CW_CODE = 1;
constexpr int CW_CNT = 1024;
constexpr int CW_BAR = 4096;

constexpr int LDS_BYTES = 160 * 1024 - 256;
constexpr int MISC_OFF = LDS_BYTES - 256;

#define RLX_AGENT __ATOMIC_RELAXED, __HIP_MEMORY_SCOPE_AGENT
#define LDS_WAIT() asm volatile("s_waitcnt lgkmcnt(0)" ::: "memory")
#define VM_WAIT() asm volatile("s_waitcnt vmcnt(0)" ::: "memory")
__device__ __forceinline__ unsigned f2bf(float f) { unsigned u = __builtin_bit_cast(unsigned, f); return (u + 0x7fffu + ((u >> 16) & 1u)) >> 16; }
typedef float f32x2_t_ __attribute__((ext_vector_type(2))); typedef __bf16 bf16x2_t_ __attribute__((ext_vector_type(2)));
__device__ __forceinline__ unsigned pk2(float lo, float hi) { f32x2_t_ v = {lo, hi}; bf16x2_t_ b = __builtin_convertvector(v, bf16x2_t_); return __builtin_bit_cast(unsigned, b); }
__device__ __forceinline__ float bf2f(unsigned short b) { return __builtin_bit_cast(float, (unsigned)b << 16); }
__device__ __forceinline__ float bflo(unsigned w) { return __builtin_bit_cast(float, w << 16); }
__device__ __forceinline__ float bfhi(unsigned w) { return __builtin_bit_cast(float, w & 0xffff0000u); }
__device__ __forceinline__ unsigned cvt_pk_bf16(float lo, float hi) { unsigned r; asm volatile("v_cvt_pk_bf16_f32 %0, %1, %2" : "=v"(r) : "v"(lo), "v"(hi)); return r; }
__device__ __forceinline__ float wave_sum(float v) {
#pragma unroll
    for (int o = 1; o < 64; o <<= 1) v += __shfl_xor(v, o);
    return v;
}
__device__ __forceinline__ int lane_id() { unsigned z = 0u; asm volatile("" : "+s"(z)); return (int)__builtin_amdgcn_mbcnt_hi(~0u, __builtin_amdgcn_mbcnt_lo(~0u, z)); }
__device__ __forceinline__ float silu_f(float x) { return x / (1.f + __expf(-x)); }
namespace pg8 {
constexpr int BM = 256, BK = 64, HALF = 128, HTB = HALF * BK * 2  , STAGE_BYTES = 8 * HTB, NXCD = 8, WGM = 8;
__host__ __device__ __forceinline__ int lds_byte(int r, int c) { const int st = (r >> 4) * 2 + (c >> 5), rr = r & 15, cc = c & 31, ob = rr * 64 + cc * 2; return st * 1024 + (ob ^ (((ob >> 9) & 1) << 5)); }
__host__ __device__ __forceinline__ void stage_rc(int b, int& R, int& C) { const int st = b / 1024, sb = b % 1024, swz = sb ^ (((sb >> 9) & 1) << 5); R = (st >> 1) * 16 + swz / 64; C = (st & 1) * 32 + (swz % 64) / 2; }
__host__ __device__ __forceinline__ int perm32(int rho) { const int n = rho >> 4, i = rho & 15; return 8 * (i >> 2) + 4 * n + (i & 3); }

struct Unit { int pm, pn, e, aux; };

template <class Epi, class Sched, bool ALIGN_EPI = false>
__device__ __forceinline__ void gemm_phase(LAS unsigned char* lds, const int K, const Sched& S, const Epi& E, const int wave_id) {
    const int wid = wave_id, lane = lane_id(), tid = wid * 64 + lane, wr = wid >> 2, wc = wid & 3, fr = lane & 15, fq = lane >> 4;
    const int nt = K / BK;
    int R0, C0, R1, C1; stage_rc(tid * 16, R0, C0); stage_rc(tid * 16 + 8192, R1, C1);
    unsigned voffB[2];
    voffB[0] = (unsigned)(((R0 & ~31) + perm32(R0 & 31)) * K + C0) * 2u; voffB[1] = (unsigned)(((R1 & ~31) + perm32(R1 & 31)) * K + C1) * 2u;
    const size_t kstep = (size_t)(BK * 2);
    const size_t hstep = (size_t)HALF * K * 2;
    const unsigned ldsw = (unsigned)wid * 1024u;
    const int aoff = lds_byte(wr * 64 + fr, fq * 8), boff = lds_byte(wc * 32 + fr, fq * 8);
#define PG8_SA(b, h) (((b) * 2 + (h)) * HTB)
#define PG8_SB(b, h) ((4 + (b) * 2 + (h)) * HTB)
#define PG8_STAGE2(bufoff, gbase, v0, v1) do { \
        __builtin_amdgcn_global_load_lds((const unsigned*)((const char*)(gbase) + (v0)), (LAS unsigned*)(lds + (bufoff) + ldsw), 16, 0, 0); \
        __builtin_amdgcn_global_load_lds((const unsigned*)((const char*)(gbase) + (v1)), (LAS unsigned*)(lds + (bufoff) + ldsw + 8192), 16, 0, 0); } while (0)
#define PG8_STAGEB(bufoff, gbase) PG8_STAGE2(bufoff, gbase, voffB[0], voffB[1])
#define PG8_LDA(dst, b, h) do { _Pragma("unroll") for (int m = 0; m < 4; ++m) _Pragma("unroll") for (int k = 0; k < 2; ++k) dst[m][k] = *(const LAS bf16x8*)(lds + PG8_SA(b, h) + aoff + m * 2048 + k * 1024); } while (0)
#define PG8_LDB(dst, b, h) do { _Pragma("unroll") for (int n = 0; n < 2; ++n) _Pragma("unroll") for (int k = 0; k < 2; ++k) dst[n][k] = *(const LAS bf16x8*)(lds + PG8_SB(b, h) + boff + n * 2048 + k * 1024); } while (0)
#define PG8_MMA(ai, bj, At, Bt) do { __builtin_amdgcn_s_setprio(1); _Pragma("unroll") for (int m = 0; m < 4; ++m) _Pragma("unroll") for (int n = 0; n < 2; ++n) _Pragma("unroll") for (int k = 0; k < 2; ++k) \
        acc[ai][bj][m][n] = __builtin_amdgcn_mfma_f32_16x16x32_bf16(Bt[n][k], At[m][k], acc[ai][bj][m][n], 0, 0, 0); __builtin_amdgcn_s_setprio(0); } while (0)
#define PG8_WAIT_V(n) asm volatile("s_waitcnt vmcnt(" #n ")" ::: "memory")
#define PG8_WAIT_L(n) asm volatile("s_waitcnt lgkmcnt(" #n ")" ::: "memory")
#define PG8_BAR __builtin_amdgcn_s_barrier()
#define PG8_SCHED __builtin_amdgcn_sched_barrier(0)
    Unit cur, nxt; int ui = 0;
    if (!S.next(0, cur)) return;
    f32x4 acc[2][2][4][2];
#pragma unroll
    for (int a = 0; a < 2; ++a)
#pragma unroll
        for (int b = 0; b < 2; ++b)
#pragma unroll
            for (int m = 0; m < 4; ++m)
#pragma unroll
                for (int n = 0; n < 2; ++n) acc[a][b][m][n] = (f32x4){0.f, 0.f, 0.f, 0.f};
    bf16x8 At[4][2], B0[2][2], B1[2][2];
    unsigned cv00, cv01, cv10, cv11, nv00, nv01, nv10, nv11;
    if constexpr (Sched::GATHER) { int r0, r1, r2, r3; S.a_rows(cur, R0, R1, r0, r1, r2, r3);
        cv00 = (unsigned)(r0 * K + C0) * 2u; cv01 = (unsigned)(r1 * K + C1) * 2u; cv10 = (unsigned)(r2 * K + C0) * 2u; cv11 = (unsigned)(r3 * K + C1) * 2u;
    } else { cv00 = (unsigned)(R0 * K + C0) * 2u; cv01 = (unsigned)(R1 * K + C1) * 2u; cv10 = cv00 + (unsigned)hstep; cv11 = cv01 + (unsigned)hstep; }
    nv00 = cv00; nv01 = cv01; nv10 = cv10; nv11 = cv11;
    const char* cA = S.a_base(cur); const char* cB = S.b_base(cur);
    PG8_STAGEB(PG8_SB(0, 0), cB); PG8_STAGEB(PG8_SB(0, 1), cB + hstep); PG8_STAGE2(PG8_SA(0, 0), cA, cv00, cv01); PG8_STAGE2(PG8_SA(0, 1), cA, cv10, cv11);
    if (wr == 1) PG8_BAR;
    PG8_WAIT_V(2); PG8_BAR;
    PG8_STAGEB(PG8_SB(1, 0), cB + kstep); PG8_STAGE2(PG8_SA(1, 0), cA + kstep, cv00, cv01); PG8_STAGEB(PG8_SB(1, 1), cB + hstep + kstep);
    PG8_WAIT_V(6); PG8_BAR;
    for (;;) {
        const bool has_next = S.next(ui + 1, nxt);
        const char* nA = has_next ? S.a_base(nxt) : cA; const char* nB = has_next ? S.b_base(nxt) : cB;
        if constexpr (Sched::GATHER) { if (has_next) { int r0, r1, r2, r3; S.a_rows(nxt, R0, R1, r0, r1, r2, r3);
            nv00 = (unsigned)(r0 * K + C0) * 2u; nv01 = (unsigned)(r1 * K + C1) * 2u; nv10 = (unsigned)(r2 * K + C0) * 2u; nv11 = (unsigned)(r3 * K + C1) * 2u; } else { nv00 = cv00; nv01 = cv01; nv10 = cv10; nv11 = cv11; } }
        for (int t = 0; t < nt; t += 2) {
            const bool last = (t == nt - 2);
            const char* a1 = cA + (size_t)(t + 1) * kstep;
            const char* a2 = last ? nA : cA + (size_t)(t + 2) * kstep; const char* b2 = last ? nB : cB + (size_t)(t + 2) * kstep;
            const char* a3 = a2 + kstep; const char* b3 = b2 + kstep;
            unsigned s00 = cv00, s01 = cv01, s10 = cv10, s11 = cv11;
            if constexpr (Sched::GATHER) { if (last) { s00 = nv00; s01 = nv01; s10 = nv10; s11 = nv11; } }
            PG8_LDB(B0, 0, 0); PG8_LDB(B1, 0, 1); PG8_SCHED; PG8_LDA(At, 0, 0); PG8_STAGE2(PG8_SA(1, 1), a1, cv10, cv11);
            PG8_WAIT_V(8); PG8_WAIT_L(0); PG8_BAR; PG8_MMA(0, 0, At, B0); PG8_MMA(0, 1, At, B1); PG8_BAR; PG8_SCHED;
            PG8_LDA(At, 0, 1); PG8_STAGEB(PG8_SB(0, 0), b2); PG8_STAGEB(PG8_SB(0, 1), b2 + hstep); PG8_STAGE2(PG8_SA(0, 0), a2, s00, s01);
            PG8_WAIT_V(8); PG8_WAIT_L(0); PG8_BAR; PG8_MMA(1, 0, At, B0); PG8_MMA(1, 1, At, B1); PG8_BAR; PG8_SCHED;
            PG8_LDB(B0, 1, 0); PG8_LDB(B1, 1, 1); PG8_SCHED; PG8_LDA(At, 1, 0); PG8_STAGE2(PG8_SA(0, 1), a2, s10, s11);
            PG8_WAIT_V(8); PG8_WAIT_L(0); PG8_BAR; PG8_MMA(0, 0, At, B0); PG8_MMA(0, 1, At, B1); PG8_BAR; PG8_SCHED;
            PG8_LDA(At, 1, 1); PG8_STAGEB(PG8_SB(1, 0), b3); PG8_STAGEB(PG8_SB(1, 1), b3 + hstep); PG8_STAGE2(PG8_SA(1, 0), a3, s00, s01);
            PG8_WAIT_V(8); PG8_WAIT_L(0); PG8_BAR; PG8_MMA(1, 0, At, B0); PG8_MMA(1, 1, At, B1); PG8_BAR; PG8_SCHED;
        }
        if constexpr (ALIGN_EPI) { if (wr == 0) PG8_BAR; }
        E(acc, cur, wr, wc, fr, fq);
        if (!has_next) break;
#pragma unroll
        for (int a = 0; a < 2; ++a)
#pragma unroll
            for (int b = 0; b < 2; ++b)
#pragma unroll
                for (int m = 0; m < 4; ++m)
#pragma unroll
                    for (int n = 0; n < 2; ++n) acc[a][b][m][n] = (f32x4){0.f, 0.f, 0.f, 0.f};
        cur = nxt; cA = nA; cB = nB; ++ui; cv00 = nv00; cv01 = nv01; cv10 = nv10; cv11 = nv11;
        if constexpr (ALIGN_EPI) { if (wr == 1) PG8_BAR; }
    }
    PG8_WAIT_V(0);
    if constexpr (!ALIGN_EPI) { if (wr == 0) PG8_BAR; }
    PG8_BAR;
#undef PG8_SA
#undef PG8_SB
#undef PG8_STAGE2
#undef PG8_STAGEB
#undef PG8_LDA
#undef PG8_LDB
#undef PG8_MMA
#undef PG8_WAIT_V
#undef PG8_WAIT_L
#undef PG8_BAR
#undef PG8_SCHED
}
}
namespace pg8 {
__device__ __forceinline__ int xcd_remap(int L, int n) { const int q = n / NXCD, r = n % NXCD, xcd = L % NXCD, off = L / NXCD; return (xcd < r ? xcd * (q + 1) : r * (q + 1) + (xcd - r) * q) + off; }
struct SchedDense {
    static constexpr bool GATHER = false;
    const char* A; const char* Bt; int K; int nM, nN, nwg, G, c;
    __device__ __forceinline__ void init(const void* A_, const void* Bt_, int M, int N, int K_, int G_, int c_) { A = (const char*)A_; Bt = (const char*)Bt_; K = K_; nM = M / BM; nN = N / BM; nwg = nM * nN; G = G_; c = c_; }
    __device__ __forceinline__ bool next(int i, Unit& u) const {
        const long L = (long)i * G + c; if (L >= nwg) return false;
        int wgid = (int)L; { const int q = nwg / NXCD, r = nwg % NXCD, xcd = wgid % NXCD, off = wgid / NXCD; wgid = (xcd < r ? xcd * (q + 1) : r * (q + 1) + (xcd - r) * q) + off; }
        const int nig = WGM * nN, gid = wgid / nig, fm = gid * WGM, gsz = (nM - fm) < WGM ? (nM - fm) : WGM;
        u.pm = fm + ((wgid % nig) % gsz); u.pn = (wgid % nig) / gsz; u.e = 0; u.aux = 0; return true;
    }
    __device__ __forceinline__ const char* a_base(const Unit& u) const { return A + (size_t)u.pm * BM * K * 2; }
    __device__ __forceinline__ const char* b_base(const Unit& u) const { return Bt + (size_t)u.pn * BM * K * 2; }
    __device__ __forceinline__ void a_rows(const Unit&, int, int, int&, int&, int&, int&) const {}
};
struct SchedQkv1 {
    static constexpr bool GATHER = false;
    const char* A; const char* Bt; int K; int G, c;
    __device__ __forceinline__ bool next(int i, Unit& u) const {
        const int L0 = i * G + c; if (L0 >= 256 * 6 + 32) return false; const int L = xcd_remap(L0, 256 * 6 + 32); const int NL = 256 * 6;
        if (L < NL) { const int g = L / 48, w = L % 48; const int lt = g * 8 + (w % 8); u.pn = w / 8; u.pm = (lt / 16) * 17 + 1 + (lt % 16); u.e = 0; u.aux = 0; return true; }
        const int r = L - NL; if (r >= 32) return false;
        u.pm = (r >> 1) * 17; u.pn = 4 + (r & 1); u.e = 0; u.aux = 0; return true;
    }
    __device__ __forceinline__ const char* a_base(const Unit& u) const { return A + (size_t)u.pm * BM * K * 2; }
    __device__ __forceinline__ const char* b_base(const Unit& u) const { return Bt + (size_t)u.pn * BM * K * 2; }
    __device__ __forceinline__ void a_rows(const Unit&, int, int, int&, int&, int&, int&) const {}
};
struct SchedInProj {
    static constexpr bool GATHER = false;
    const char* H; const char* Why; const char* Watt; int G, c;
    __device__ __forceinline__ bool next(int i, Unit& u) const {
        const int L0 = i * G + c; if (L0 >= 9 * 272) return false; const int L = xcd_remap(L0, 9 * 272); const int N0 = 6 * 272;
        if (L < N0) { u.e = 0; u.pn = L / 6; u.pm = L % 6; u.aux = 0; return true; }
        const int r = L - N0; if (r >= 3 * 272) return false;
        u.e = 1; const int g = r / 24, w = r % 24; u.pm = g * 8 + (w % 8); u.pn = w / 8; u.aux = 0; return true;
    }
    __device__ __forceinline__ const char* a_base(const Unit& u) const { return (u.e == 0 ? Why : H) + (size_t)u.pm * BM * 1024 * 2; }
    __device__ __forceinline__ const char* b_base(const Unit& u) const { return (u.e == 0 ? H : Watt) + (size_t)u.pn * BM * 1024 * 2; }
    __device__ __forceinline__ void a_rows(const Unit&, int, int, int&, int&, int&, int&) const {}
};
struct SchedLat {
    static constexpr bool GATHER = false;
    const char* A; const char* Bt; int K; int nN; int G, c;
    __device__ __forceinline__ bool next(int i, Unit& u) const {
        const int L0 = i * G + c; if (L0 >= 256 * nN) return false; const int L = xcd_remap(L0, 256 * nN);
        const int per = 8 * nN; const int g = L / per, w = L % per; const int lt = g * 8 + (w % 8); u.pn = w / 8; u.pm = (lt / 16) * 17 + 1 + (lt % 16); u.e = 0; u.aux = 0; return true;
    }
    __device__ __forceinline__ const char* a_base(const Unit& u) const { return A + (size_t)u.pm * BM * K * 2; }
    __device__ __forceinline__ const char* b_base(const Unit& u) const { return Bt + (size_t)u.pn * BM * K * 2; }
    __device__ __forceinline__ void a_rows(const Unit&, int, int, int&, int&, int&, int&) const {}
};
template <bool GATH>
struct SchedMoe {
    static constexpr bool GATHER = GATH;
    const char* A; const char* W; size_t wstride; int K; const LAS int* tab; const int* tokidx; int G, c;
    __device__ __forceinline__ bool next(int i, Unit& u) const {
        const int L0 = i * G + c; const int nu = tab[32] * 4; if (L0 >= nu) return false; const int L = xcd_remap(L0, nu); const int tau = L >> 2;
        int e = 0;
#pragma unroll 1
        for (int s = 16; s >= 1; s >>= 1) if (tab[e + s] <= tau) e += s;
        u.pm = tau; u.pn = L & 3; u.e = e; u.aux = tau - tab[e]; return true;
    }
    __device__ __forceinline__ const char* a_base(const Unit& u) const { return GATH ? A : A + (size_t)u.pm * BM * K * 2; }
    __device__ __forceinline__ const char* b_base(const Unit& u) const { return W + (size_t)u.e * wstride + (size_t)u.pn * BM * K * 2; }
    __device__ __forceinline__ void a_rows(const Unit& u, int R0, int R1, int& r0, int& r1, int& r2, int& r3) const {
        const int cnt = tab[64 + u.e]; const int* ti = tokidx + (size_t)u.e * CAP; const int p = u.aux * BM;
        int p0 = p + R0, p1 = p + R1, p2 = p + 128 + R0, p3 = p + 128 + R1;
        p0 = p0 < cnt ? p0 : 0; p1 = p1 < cnt ? p1 : 0; p2 = p2 < cnt ? p2 : 0; p3 = p3 < cnt ? p3 : 0;
        r0 = ti[p0]; r1 = ti[p1]; r2 = ti[p2]; r3 = ti[p3];
    }
};

struct EpiBf16 {
    bf16* O; int ldc;
    __device__ __forceinline__ void operator()(const f32x4 (&acc)[2][2][4][2], const Unit& u, int wr, int wc, int fr, int fq) const {
        const int row0 = u.pm * BM + wr * 64 + fr, col0 = u.pn * BM + wc * 32 + 8 * fq;
#pragma unroll
        for (int ai = 0; ai < 2; ++ai)
#pragma unroll
            for (int m = 0; m < 4; ++m) { bf16* rowp = O + (size_t)(row0 + ai * HALF + m * 16) * ldc + col0;
#pragma unroll
                for (int bj = 0; bj < 2; ++bj) { const f32x4 v0 = acc[ai][bj][m][0], v1 = acc[ai][bj][m][1];
                    u32x4 w; w.x = cvt_pk_bf16(v0[0], v0[1]); w.y = cvt_pk_bf16(v0[2], v0[3]); w.z = cvt_pk_bf16(v1[0], v1[1]); w.w = cvt_pk_bf16(v1[2], v1[3]);
                    *(u32x4*)(rowp + bj * HALF) = w; } }
    }
};
template <int LAYER>
struct EpiQkv {
    bf16* O; int ldc; const f32x2* rope  ; const float* qg; const float* kg;
    __device__ __forceinline__ void operator()(const f32x4 (&acc)[2][2][4][2], const Unit& u, int wr, int wc, int fr, int fq) const {
        const bool ctx = (u.pm % 17) == 0;
        const int jrow0 = u.pm * BM + wr * 64 + fr;
        const int t0 = ((u.pm % 17) - 1) * BM + wr * 64 + fr;
#pragma unroll
        for (int bj = 0; bj < 2; ++bj) {
            int kind;
            if (LAYER == 0) kind = (u.pn < 2) ? 0 : (bj == 0 ? 1 : 2); else kind = (u.pn < 4) ? 0 : (u.pn == 4 ? 1 : 2);
            const bool l0kv = (LAYER == 0 && u.pn == 2);
            const int half = l0kv ? (wc & 1) : bj;
            const int colb = l0kv ? (u.pn * BM + bj * HALF + wc * 32) : (u.pn * BM + wc * 64 + bj * 32);
#pragma unroll
            for (int ai = 0; ai < 2; ++ai)
#pragma unroll
                for (int m = 0; m < 4; ++m) {
                    f32x4 v0 = acc[ai][bj][m][0], v1 = acc[ai][bj][m][1];
                    const int roff = ai * HALF + m * 16;
                    if (LAYER == 1 && kind != 2) {
                        const f32x4 w0 = acc[ai][bj ^ 1][m][0], w1 = acc[ai][bj ^ 1][m][1];
                        float ss = (v0[0] * v0[0] + v0[1] * v0[1]) + (v0[2] * v0[2] + v0[3] * v0[3]) + (v1[0] * v1[0] + v1[1] * v1[1]) + (v1[2] * v1[2] + v1[3] * v1[3])
                                 + (w0[0] * w0[0] + w0[1] * w0[1]) + (w0[2] * w0[2] + w0[3] * w0[3]) + (w1[0] * w1[0] + w1[1] * w1[1]) + (w1[2] * w1[2] + w1[3] * w1[3]);
                        ss += __shfl_xor(ss, 16); ss += __shfl_xor(ss, 32);
                        const float rs = rsqrtf(ss * (1.f / 64.f) + NORM_EPS);
                        const float* g = (kind == 0 ? qg : kg) + 32 * bj;
                        const f32x4 g0 = *(const f32x4*)(g + 4 * fq), g1 = *(const f32x4*)(g + 16 + 4 * fq);
                        v0 = v0 * rs * g0; v1 = v1 * rs * g1;
                    }
                    if (kind != 2 && !ctx) {
                        const int t = t0 + roff; const int pos = half == 0 ? (t >> 6) : (t & 63);
                        const f32x2* rp = rope + pos * 16 + 4 * fq;
                        f32x4 a, b;
#pragma unroll
                        for (int i = 0; i < 4; ++i) { const f32x2 cs = rp[i]; a[i] = v0[i] * cs.x - v1[i] * cs.y; b[i] = v1[i] * cs.x + v0[i] * cs.y; }
                        v0 = a; v1 = b;
                    }
                    if (kind == 0) { v0 = v0 * QSCALE; v1 = v1 * QSCALE; }
                    u32x4 w; w.x = cvt_pk_bf16(v0[0], v0[1]); w.y = cvt_pk_bf16(v0[2], v0[3]); w.z = cvt_pk_bf16(v1[0], v1[1]); w.w = cvt_pk_bf16(v1[2], v1[3]);
                    *(u32x4*)(O + (size_t)(jrow0 + roff) * ldc + colb + 8 * fq) = w;
                }
        }
    }
};
struct EpiInProj {
    EpiBf16 e0; EpiQkv<0> e1;
    __device__ __forceinline__ void operator()(const f32x4 (&acc)[2][2][4][2], const Unit& u, int wr, int wc, int fr, int fq) const { if (u.e == 0) e0(acc, u, wr, wc, fr, fq); else e1(acc, u, wr, wc, fr, fq); }
};
struct EpiOut {
    bf16* Y; const float* mod  ;
    __device__ __forceinline__ void operator()(const f32x4 (&acc)[2][2][4][2], const Unit& u, int wr, int wc, int fr, int fq) const {
        const int b = u.pm / 17, j = u.pm % 17; const bool ctx = (j == 0);
        const float* g = mod + ((size_t)(ctx ? 16 : b) * NMOD + 2) * DM;
        const int row0 = u.pm * BM + wr * 64 + fr, col0 = u.pn * BM + wc * 32 + 8 * fq;
        f32x4 gv[2][2];
#pragma unroll
        for (int bj = 0; bj < 2; ++bj)
#pragma unroll
            for (int n = 0; n < 2; ++n) gv[bj][n] = *(const f32x4*)(g + col0 + bj * HALF + 4 * n);
#pragma unroll
        for (int ai = 0; ai < 2; ++ai)
#pragma unroll
            for (int m = 0; m < 4; ++m) { bf16* rowp = Y + (size_t)(row0 + ai * HALF + m * 16) * DM + col0;
#pragma unroll
                for (int bj = 0; bj < 2; ++bj) { const f32x4 v0 = acc[ai][bj][m][0] * gv[bj][0], v1 = acc[ai][bj][m][1] * gv[bj][1];
                    u32x4 w; w.x = cvt_pk_bf16(v0[0], v0[1]); w.y = cvt_pk_bf16(v0[2], v0[3]); w.z = cvt_pk_bf16(v1[0], v1[1]); w.w = cvt_pk_bf16(v1[2], v1[3]);
                    *(u32x4*)(rowp + bj * HALF) = w; } }
    }
};
struct EpiGateUp {
    bf16* HID;
    __device__ __forceinline__ void operator()(const f32x4 (&acc)[2][2][4][2], const Unit& u, int wr, int wc, int fr, int fq) const {
        const int row0 = u.pm * BM + wr * 64 + fr, col0 = u.pn * 128 + wc * 32 + 8 * fq;
#pragma unroll
        for (int ai = 0; ai < 2; ++ai)
#pragma unroll
            for (int m = 0; m < 4; ++m) {
                const f32x4 g0 = acc[ai][0][m][0], g1 = acc[ai][0][m][1], u0 = acc[ai][1][m][0], u1 = acc[ai][1][m][1];
                float h[8];
#pragma unroll
                for (int i = 0; i < 4; ++i) { h[i] = g0[i] / (1.f + __expf(-g0[i])) * u0[i]; h[4 + i] = g1[i] / (1.f + __expf(-g1[i])) * u1[i]; }
                u32x4 w; w.x = cvt_pk_bf16(h[0], h[1]); w.y = cvt_pk_bf16(h[2], h[3]); w.z = cvt_pk_bf16(h[4], h[5]); w.w = cvt_pk_bf16(h[6], h[7]);
                *(u32x4*)(HID + (size_t)(row0 + ai * HALF + m * 16) * DEXP + col0) = w; }
    }
};
struct EpiDown {
    bf16* MOUT; const float* gate; const LAS int* tab;
    __device__ __forceinline__ void operator()(const f32x4 (&acc)[2][2][4][2], const Unit& u, int wr, int wc, int fr, int fq) const {
        const int r0 = wr * 64 + fr, col0 = u.pn * BM + wc * 32 + 8 * fq; const int cnt = tab[64 + u.e]; const float* gp = gate + (size_t)u.e * CAP;
#pragma unroll
        for (int ai = 0; ai < 2; ++ai)
#pragma unroll
            for (int m = 0; m < 4; ++m) { const int r = r0 + ai * HALF + m * 16; const int pos = u.aux * BM + r; const float gt = pos < cnt ? gp[pos] : 0.f;
                bf16* rowp = MOUT + (size_t)(u.pm * BM + r) * DM + col0;
#pragma unroll
                for (int bj = 0; bj < 2; ++bj) { const f32x4 v0 = acc[ai][bj][m][0] * gt, v1 = acc[ai][bj][m][1] * gt;
                    u32x4 w; w.x = cvt_pk_bf16(v0[0], v0[1]); w.y = cvt_pk_bf16(v0[2], v0[3]); w.z = cvt_pk_bf16(v1[0], v1[1]); w.w = cvt_pk_bf16(v1[2], v1[3]);
                    *(u32x4*)(rowp + bj * HALF) = w; } }
    }
};
}
namespace attn_body {
using bf16=__hip_bfloat16;
using bf16x8=__attribute__((ext_vector_type(8)))short;
using s16x4=__attribute__((ext_vector_type(4)))short;
using f32x16=__attribute__((ext_vector_type(16)))float;
using u32x4=__attribute__((ext_vector_type(4)))unsigned;
constexpr int D=64;
constexpr int NW=8,QBLK=32,QB=QBLK*NW,KVBLK=64;
__device__ __forceinline__ int crow(int r,int hi){return (r&3)+8*(r>>2)+4*hi;}
#define SBAR() __builtin_amdgcn_sched_barrier(0)
__device__ __forceinline__ void swamask(f32x16&p0,f32x16&p1,int d0){
  const float NEG=-INFINITY;
  #pragma unroll
  for(int r=0;r<16;++r){const int d=d0+(r&3)+8*(r>>2); if((unsigned)(d+128)>256u)p0[r]=NEG; if((unsigned)(d+160)>256u)p1[r]=NEG;}
}

constexpr int NSLOT=3, SLOTB=8192;
constexpr int LDS_K=0, LDS_V=NSLOT*SLOTB, LDS_WS=2*NSLOT*SLOTB, LDS_OST=LDS_WS+NW*64*4, LDS_BYTES=LDS_OST+NW*4096;
constexpr float C2=0.125f*1.4426950408889634f;
__device__ __forceinline__ void glds16(const void*gsrc,unsigned lds_dst){unsigned keep;
  asm volatile("s_mov_b32 %0, m0\n\ts_mov_b32 m0, %2\n\ts_nop 0\n\tglobal_load_lds_dwordx4 %1, off\n\ts_mov_b32 m0, %0":"=&s"(keep):"v"(gsrc),"s"(lds_dst):"memory");}
__device__ __forceinline__ float max3f(float a,float b,float c){float r;asm("v_max3_f32 %0, %1, %2, %3":"=v"(r):"v"(a),"v"(b),"v"(c));return r;}
__device__ __forceinline__ float max2f(float a,float b){float r;asm("v_max_f32_e32 %0, %1, %2":"=v"(r):"v"(a),"v"(b));return r;}
__device__ __forceinline__ float fadd_s(float a,float b){float r;asm("v_add_f32_e32 %0, %1, %2":"=v"(r):"v"(a),"v"(b));return r;}
__device__ __forceinline__ float fsub_s(float a,float b){float r;asm("v_sub_f32_e32 %0, %1, %2":"=v"(r):"v"(a),"v"(b));return r;}
typedef float f32x2_t __attribute__((ext_vector_type(2))); typedef __bf16 bf16x2_t __attribute__((ext_vector_type(2)));
__device__ __forceinline__ unsigned cvtpk_s(float lo,float hi){f32x2_t v={lo,hi};bf16x2_t b=__builtin_convertvector(v,bf16x2_t);return __builtin_bit_cast(unsigned,b);}
#define WAIT_BAR(N) asm volatile("s_waitcnt vmcnt(" #N ") lgkmcnt(0)\n\ts_barrier":::"memory")

__device__ __forceinline__ void qkt(f32x16&p0,f32x16&p1,const char*Kslot,const bf16x8*qr,const f32x16&negm,int r32,int hi){
  const char*kb=Kslot+hi*1024+r32*16;
  #pragma unroll
  for(int d0=0;d0<4;++d0){
    const bf16x8 b0=*reinterpret_cast<const bf16x8*>(kb+d0*2048);
    const bf16x8 b1=*reinterpret_cast<const bf16x8*>(kb+d0*2048+512);
    if(d0==0){p0=__builtin_amdgcn_mfma_f32_32x32x16_bf16(b0,qr[0],negm,0,0,0);p1=__builtin_amdgcn_mfma_f32_32x32x16_bf16(b1,qr[0],negm,0,0,0);}
    else{p0=__builtin_amdgcn_mfma_f32_32x32x16_bf16(b0,qr[d0],p0,0,0,0);p1=__builtin_amdgcn_mfma_f32_32x32x16_bf16(b1,qr[d0],p1,0,0,0);}}
}
typedef __attribute__((address_space(3))) const char* lds_cptr;
typedef short v4i16_t __attribute__((ext_vector_type(4)));
__device__ __forceinline__ void kload8(bf16x8*kf,lds_cptr kp){
  kf[0]=*(const __attribute__((address_space(3))) bf16x8*)(kp);      kf[1]=*(const __attribute__((address_space(3))) bf16x8*)(kp+512);
  kf[2]=*(const __attribute__((address_space(3))) bf16x8*)(kp+2048); kf[3]=*(const __attribute__((address_space(3))) bf16x8*)(kp+2560);
  kf[4]=*(const __attribute__((address_space(3))) bf16x8*)(kp+4096); kf[5]=*(const __attribute__((address_space(3))) bf16x8*)(kp+4608);
  kf[6]=*(const __attribute__((address_space(3))) bf16x8*)(kp+6144); kf[7]=*(const __attribute__((address_space(3))) bf16x8*)(kp+6656);
}
__device__ __forceinline__ void kload2(bf16x8*kf,lds_cptr kp,int j){ kf[2*j]=*(const __attribute__((address_space(3))) bf16x8*)(kp+j*2048); kf[2*j+1]=*(const __attribute__((address_space(3))) bf16x8*)(kp+j*2048+512); }
__device__ __forceinline__ s16x4 vtr(lds_cptr p){ return __builtin_bit_cast(s16x4,__builtin_amdgcn_ds_read_tr16_b64_v4i16((__attribute__((address_space(3))) v4i16_t*)p)); }
__device__ __forceinline__ float rowmax(const f32x16&p0,const f32x16&p1){
  float a=max3f(p0[0],p0[1],p1[0]),b=max3f(p0[2],p0[3],p1[1]);a=max3f(a,p1[2],p1[3]);
  #pragma unroll
  for(int r=4;r<16;r+=4){a=max3f(a,p0[r],p0[r+1]);b=max3f(b,p0[r+2],p0[r+3]);a=max3f(a,p1[r],p1[r+1]);b=max3f(b,p1[r+2],p1[r+3]);}
  const float m=max2f(a,b);
  auto rr=__builtin_amdgcn_permlane32_swap(__float_as_uint(m),__float_as_uint(m),false,false);
  return max2f(__uint_as_float(rr[0]),__uint_as_float(rr[1]));
}
__device__ __forceinline__ void pv(f32x16*o,int vb,bf16x8 pa0,bf16x8 pa1,bf16x8 pa2,bf16x8 pa3){
  #pragma unroll
  for(int d0=0;d0<2;++d0){s16x4 lo[4],hi[4];
    #pragma unroll
    for(int ks=0;ks<4;++ks){
      asm volatile("ds_read_b64_tr_b16 %0,%1 offset:%c2":"=&v"(lo[ks]):"v"(vb),"i"(d0*4096+ks*1024):"memory");
      asm volatile("ds_read_b64_tr_b16 %0,%1 offset:%c2":"=&v"(hi[ks]):"v"(vb),"i"(d0*4096+ks*1024+512):"memory");}
    asm volatile("s_waitcnt lgkmcnt(0)":::"memory");SBAR();
    #define PK(k) (bf16x8){lo[k][0],lo[k][1],lo[k][2],lo[k][3],hi[k][0],hi[k][1],hi[k][2],hi[k][3]}
    o[d0]=__builtin_amdgcn_mfma_f32_32x32x16_bf16(pa0,PK(0),o[d0],0,0,0);
    o[d0]=__builtin_amdgcn_mfma_f32_32x32x16_bf16(pa1,PK(1),o[d0],0,0,0);
    o[d0]=__builtin_amdgcn_mfma_f32_32x32x16_bf16(pa2,PK(2),o[d0],0,0,0);
    o[d0]=__builtin_amdgcn_mfma_f32_32x32x16_bf16(pa3,PK(3),o[d0],0,0,0);
    #undef PK
  }
}

#ifndef ATTN_STORE16
#define ATTN_STORE16(p,v) (*(u32x4*)(p)=(v))
#endif
template<int MODE,int QP,int KP,int OP,int THRL,bool FIXM=false> __device__ __forceinline__ void attn_unit(const bf16*Qu,const bf16*__restrict__ Kh,const bf16*__restrict__ Vh,bf16*Ou,int NT,int lat0,int tq0,float sinkl2,char*shm,const int wave_id,const float m0fix=0.f){
  const int wid=wave_id,lane=lane_id(),r32=lane&31,hi=lane>>5;
  const bf16*Qw=Qu+(long)(wid*QBLK)*QP;
  const unsigned lds0=(unsigned)(uintptr_t)shm;
  float*wsf=(float*)(shm+LDS_WS)+wid*64;
  const bf16*ksrc=Kh+(long)lane*KP+wid*8;
  const bf16*vsrc=Vh+(long)(16*(wid&3)+(lane>>2))*KP+(wid>>2)*32+(lane&3)*8;
  #define KROW(t) ((long)(64*(t)+(((t)>=4)?lat0:0)))
  const unsigned kdst=lds0+LDS_K+wid*1024, vdst=lds0+LDS_V+wid*1024;
  #define DMA_K(t,slot) glds16(ksrc+KROW(t)*KP,(unsigned)__builtin_amdgcn_readfirstlane(kdst+(slot)))
  #define DMA_V(t,slot) glds16(vsrc+KROW(t)*KP,(unsigned)__builtin_amdgcn_readfirstlane(vdst+(slot)))
  const int vb0=(int)(lds0+LDS_V)+((lane>>4)&1)*32+(lane&3)*8+(4*hi+((lane&15)>>2))*64;
  const char*Kbase=shm+LDS_K; bf16x8 kf[8];
  const lds_cptr shm3=(lds_cptr)shm; const lds_cptr kp0=shm3+LDS_K+hi*1024+r32*16; const lds_cptr vp0=shm3+LDS_V+((lane>>4)&1)*32+(lane&3)*8+(4*hi+((lane&15)>>2))*64;
  DMA_K(0,0);DMA_V(0,0);DMA_K(1,SLOTB);
  bf16x8 qr[4];
  #pragma unroll
  for(int d0=0;d0<4;++d0)qr[d0]=*reinterpret_cast<const bf16x8*>(&Qw[(long)r32*QP+d0*16+hi*8]);
  float mhat=0.f,l_reg=0.f;f32x16 o[2];o[0]=f32x16{};o[1]=f32x16{};f32x16 negm=f32x16{};
  if(FIXM){mhat=m0fix;
    #pragma unroll
    for(int r=0;r<16;++r)negm[r]=-m0fix;}
  asm volatile("":"+v"(negm));
  const int qrel=wid*QBLK+r32;
  const int mq=4*hi-(tq0+qrel)+lat0-256;
  #define CMASK(P0,P1,t) do{ if(MODE==1 && (t)>=4) swamask(P0,P1,mq+64*(t)); }while(0)
  bool resc=false;
  #define START(P0,P1) do{ resc=false; \
    if(!FIXM){ const float rm=rowmax(P0,P1); const float dl=rm; mhat=fadd_s(mhat,dl); \
      _Pragma("unroll") for(int r=0;r<16;++r){P0[r]=fsub_s(P0[r],dl);P1[r]=fsub_s(P1[r],dl);} \
      _Pragma("unroll") for(int r=0;r<16;++r)negm[r]=-mhat; asm volatile("":"+v"(negm)); } \
    _Pragma("unroll") for(int r=0;r<16;++r)P0[r]=__builtin_amdgcn_exp2f(P0[r]); }while(0)
  #define RESC() do{ if(resc){ asm volatile("s_waitcnt lgkmcnt(0)":::"memory"); \
      _Pragma("unroll") for(int d_=0;d_<2;++d_) _Pragma("unroll") for(int r=0;r<16;++r)o[d_][r]*=wsf[crow(r,hi)]; } }while(0)
  f32x16 pA0,pA1,pB0,pB1;
  int sl_prev=0,sl_cur=0,sl_next=SLOTB;
  #define ROT() do{sl_prev=sl_cur;sl_cur=sl_next;sl_next=(sl_next==(NSLOT-1)*SLOTB)?0:sl_next+SLOTB;}while(0)
  DMA_K(2,2*SLOTB);
  WAIT_BAR(3);
  qkt(pA0,pA1,Kbase,qr,negm,r32,hi);asm volatile("s_nop 15\n\ts_nop 7":"+v"(pA0),"+v"(pA1));CMASK(pA0,pA1,0);
  START(pA0,pA1);
  _Pragma("unroll") for(int r=0;r<16;++r)pA1[r]=__builtin_amdgcn_exp2f(pA1[r]);
  WAIT_BAR(0);
  DMA_K(3,0);DMA_V(1,SLOTB);
  ROT();
  kload8(kf,kp0+sl_cur);
  WAIT_BAR(2);
  s16x4 vlo[8],vhi[8]; u32x4 pw0,pw1,pw2,pw3;
  #define PKW(P,B) cvtpk_s(P[B],P[B+1])
  #define PAF(k) __builtin_bit_cast(bf16x8,pw##k)
  #define VFR(i) (bf16x8){vlo[i][0],vlo[i][1],vlo[i][2],vlo[i][3],vhi[i][0],vhi[i][1],vhi[i][2],vhi[i][3]}
  #define PIN(x) asm volatile("":"+v"(x))
  #define MX3(a,b,c) __builtin_fmaxf(__builtin_fmaxf((a),(b)),(c))
  #define GAPA(MF,A0,A1,A2,A3,W0,W1,PW) do{ MF; sacc+=A0; sacc+=A1; sacc+=A2; sacc+=A3; PIN(sacc); W0; W1; PIN(PW); SBAR(); }while(0)
  #define EX(v) __builtin_amdgcn_exp2f(v)
  #define GAPB(MF,X,B) do{ MF; X[B]=EX(X[B]); X[B+1]=EX(X[B+1]); X[B+2]=EX(X[B+2]); X[B+3]=EX(X[B+3]); PIN(X); SBAR(); }while(0)
  #define VRD(i) do{ vlo[i]=vtr(vp_+(((i)>>2)*4096+((i)&3)*1024)); vhi[i]=vtr(vp_+(((i)>>2)*4096+((i)&3)*1024+512)); }while(0)
  #define KRD(G,j) do{ if(G){ kload2(kf,kp0+sl_next,j); SBAR(); } }while(0)
  #define STEP(C0,C1,P0,P1,t,GK,GV,GL) do{ SBAR(); \
    const lds_cptr vp_=vp0+sl_prev; \
    VRD(0); SBAR(); float sacc=(P0[0]+P0[1]); \
    GAPA(C0=__builtin_amdgcn_mfma_f32_32x32x16_bf16(kf[0],qr[0],negm,0,0,0), P0[2],P0[3],P0[4],P0[5],     pw0[0]=PKW(P0,0), pw0[1]=PKW(P0,2), pw0); \
    VRD(4); SBAR(); GAPA(C1=__builtin_amdgcn_mfma_f32_32x32x16_bf16(kf[1],qr[0],negm,0,0,0), P0[6],P0[7],P0[8],P0[9],     pw0[2]=PKW(P0,4), pw0[3]=PKW(P0,6), pw0); \
    VRD(1); SBAR(); GAPA(C0=__builtin_amdgcn_mfma_f32_32x32x16_bf16(kf[2],qr[1],C0,0,0,0),   P0[10],P0[11],P0[12],P0[13], pw1[0]=PKW(P0,8), pw1[1]=PKW(P0,10), pw1); \
    VRD(5); SBAR(); GAPA(C1=__builtin_amdgcn_mfma_f32_32x32x16_bf16(kf[3],qr[1],C1,0,0,0),   P0[14],P0[15],P1[0],P1[1],   pw1[2]=PKW(P0,12),pw1[3]=PKW(P0,14), pw1); \
    VRD(2); SBAR(); GAPA(C0=__builtin_amdgcn_mfma_f32_32x32x16_bf16(kf[4],qr[2],C0,0,0,0),   P1[2],P1[3],P1[4],P1[5],     pw2[0]=PKW(P1,0), pw2[1]=PKW(P1,2), pw2); \
    VRD(6); SBAR(); GAPA(C1=__builtin_amdgcn_mfma_f32_32x32x16_bf16(kf[5],qr[2],C1,0,0,0),   P1[6],P1[7],P1[8],P1[9],     pw2[2]=PKW(P1,4), pw2[3]=PKW(P1,6), pw2); \
    VRD(3); SBAR(); GAPA(C0=__builtin_amdgcn_mfma_f32_32x32x16_bf16(kf[6],qr[3],C0,0,0,0),   P1[10],P1[11],P1[12],P1[13], pw3[0]=PKW(P1,8), pw3[1]=PKW(P1,10), pw3); \
    VRD(7); SBAR(); GAPA(C1=__builtin_amdgcn_mfma_f32_32x32x16_bf16(kf[7],qr[3],C1,0,0,0),   P1[14],P1[15],0.f,0.f,       pw3[2]=PKW(P1,12),pw3[3]=PKW(P1,14), pw3); \
    l_reg+=sacc; \
    if(GK){DMA_K((t)+3,sl_cur);} if(GV){DMA_V((t)+1,sl_next);} \
    CMASK(C0,C1,t); \
    if(!FIXM){ float a=MX3(C0[0],C0[1],C1[0]),b=MX3(C0[2],C0[3],C1[1]); a=MX3(a,C1[2],C1[3]); \
      _Pragma("unroll") for(int r=4;r<16;r+=4){a=MX3(a,C0[r],C0[r+1]);b=MX3(b,C0[r+2],C0[r+3]);a=MX3(a,C1[r],C1[r+1]);b=MX3(b,C1[r+2],C1[r+3]);} \
      float rm=__builtin_fmaxf(a,b); { auto rr=__builtin_amdgcn_permlane32_swap(__float_as_uint(rm),__float_as_uint(rm),false,false); rm=__builtin_fmaxf(__uint_as_float(rr[0]),__uint_as_float(rr[1])); } \
      resc=false; \
      if(__builtin_expect(__any(rm>(float)THRL),0)){ const float dl=__builtin_fmaxf(rm,0.f); mhat+=dl; \
        _Pragma("unroll") for(int r=0;r<16;++r){C0[r]-=dl;C1[r]-=dl;} \
        _Pragma("unroll") for(int r=0;r<16;++r)negm[r]=-mhat; asm volatile("":"+v"(negm)); \
        const float f=__builtin_amdgcn_exp2f(-dl); l_reg*=f; if(hi==0)wsf[r32]=f; resc=true; } } \
    SBAR(); \
    GAPB(o[0]=__builtin_amdgcn_mfma_f32_32x32x16_bf16(PAF(0),VFR(0),o[0],0,0,0), C0,0); \
    GAPB(o[1]=__builtin_amdgcn_mfma_f32_32x32x16_bf16(PAF(0),VFR(4),o[1],0,0,0), C0,4); \
    KRD(GL,0); GAPB(o[0]=__builtin_amdgcn_mfma_f32_32x32x16_bf16(PAF(1),VFR(1),o[0],0,0,0), C0,8); \
    KRD(GL,1); GAPB(o[1]=__builtin_amdgcn_mfma_f32_32x32x16_bf16(PAF(1),VFR(5),o[1],0,0,0), C0,12); \
    KRD(GL,2); GAPB(o[0]=__builtin_amdgcn_mfma_f32_32x32x16_bf16(PAF(2),VFR(2),o[0],0,0,0), C1,0); \
    KRD(GL,3); GAPB(o[1]=__builtin_amdgcn_mfma_f32_32x32x16_bf16(PAF(2),VFR(6),o[1],0,0,0), C1,4); \
    GAPB(o[0]=__builtin_amdgcn_mfma_f32_32x32x16_bf16(PAF(3),VFR(3),o[0],0,0,0), C1,8); \
    GAPB(o[1]=__builtin_amdgcn_mfma_f32_32x32x16_bf16(PAF(3),VFR(7),o[1],0,0,0), C1,12); \
    }while(0)
  int t=1;
  for(;t+5<NT;t+=2){
    STEP(pB0,pB1,pA0,pA1,t,true,true,true);     WAIT_BAR(2); RESC(); ROT();
    STEP(pA0,pA1,pB0,pB1,t+1,true,true,true);   WAIT_BAR(2); RESC(); ROT();
  }
  #define ENDW(tt) do{ if((tt)+3<NT){WAIT_BAR(2);} else if((tt)+2<NT){WAIT_BAR(1);} else {WAIT_BAR(0);} }while(0)
  for(;t+1<NT;t+=2){
    STEP(pB0,pB1,pA0,pA1,t,(t+3<NT),(t+1<NT),(t+1<NT));       ENDW(t);   RESC(); ROT();
    STEP(pA0,pA1,pB0,pB1,t+1,(t+4<NT),(t+2<NT),(t+2<NT));     ENDW(t+1); RESC(); ROT();
  }
  STEP(pB0,pB1,pA0,pA1,NT-1,false,false,false); RESC();
  { float sacc=pB0[0]+pB0[1]; _Pragma("unroll") for(int r=2;r<16;++r)sacc+=pB0[r]; _Pragma("unroll") for(int r=0;r<16;++r)sacc+=pB1[r]; l_reg+=sacc;
    pw0=(u32x4){PKW(pB0,0),PKW(pB0,2),PKW(pB0,4),PKW(pB0,6)};pw1=(u32x4){PKW(pB0,8),PKW(pB0,10),PKW(pB0,12),PKW(pB0,14)};pw2=(u32x4){PKW(pB1,0),PKW(pB1,2),PKW(pB1,4),PKW(pB1,6)};pw3=(u32x4){PKW(pB1,8),PKW(pB1,10),PKW(pB1,12),PKW(pB1,14)};
    SBAR(); pv(o,vb0+sl_cur,PAF(0),PAF(1),PAF(2),PAF(3)); }
  #undef PKW
  #undef PAF
  #undef VFR
  #undef PIN
  #undef MX3
  #undef GAPA
  #undef GAPB
  #undef EX
  #undef VRD
  #undef KRD
  #undef STEP
  #undef ENDW
  {auto rr=__builtin_amdgcn_permlane32_swap(__float_as_uint(l_reg),__float_as_uint(l_reg),false,false);l_reg=__uint_as_float(rr[0])+__uint_as_float(rr[1]);}
  l_reg+=__builtin_amdgcn_exp2f(sinkl2-mhat);
  if(hi==0)wsf[32+r32]=l_reg;asm volatile("s_waitcnt lgkmcnt(0)":::"memory");
  float rli[16];
  #pragma unroll
  for(int r=0;r<16;++r)rli[r]=__builtin_amdgcn_rcpf(wsf[32+crow(r,hi)]);
  bf16*Ow=Ou+(long)(wid*QBLK)*OP;
  { bf16*stg=(bf16*)(shm+LDS_OST)+wid*2048;
    #pragma unroll
    for(int r=0;r<16;++r){const int orow=crow(r,hi);
      #pragma unroll
      for(int d0=0;d0<2;++d0)stg[orow*64+d0*32+r32]=__float2bfloat16(o[d0][r]*rli[r]);}
    asm volatile("s_waitcnt lgkmcnt(0)":::"memory");
    #pragma unroll
    for(int i=0;i<4;++i){const int row=i*8+(lane>>3),ch=lane&7; const u32x4 v=*(const u32x4*)(stg+row*64+ch*8); ATTN_STORE16(Ow+(long)row*OP+ch*8,v);} }
  asm volatile("s_waitcnt lgkmcnt(0)\n\ts_barrier":::"memory");
  #undef DMA_K
  #undef KROW
  #undef DMA_V
  #undef CMASK
  #undef START
  #undef RESC
  #undef ROT
}
constexpr int ATTN_LDS_BYTES=LDS_BYTES;
#undef SBAR
#undef WAIT_BAR
}
#define XB_TMO      128
#define XB_XCNT(j)  (256  + 64 * (j))
#define XB_XSUB(j)  (1280 + 64 * (j))
#define XB_XGEN(j)  (2304 + 64 * (j))
#define XB_TOP      3328
#define XB_TOPGEN   3392
#define XCD_BAR_WORDS 3456
#define XB_SPIN_CAP (1u << 18)

__device__ __forceinline__ unsigned xb_ld(unsigned* p)              { return __hip_atomic_load(p, __ATOMIC_RELAXED, __HIP_MEMORY_SCOPE_AGENT); }
__device__ __forceinline__ unsigned xb_add(unsigned* p, unsigned v) { return __hip_atomic_fetch_add(p, v, __ATOMIC_RELAXED, __HIP_MEMORY_SCOPE_AGENT); }
__device__ __forceinline__ unsigned xb_xcc_id() { return (unsigned)__builtin_amdgcn_s_getreg((3 << 11) | 20) & 0xFu; }
#define XB_SPIN(cond, bar) do { unsigned _sp = 0; while (cond) { __builtin_amdgcn_s_sleep(1); \
    if ((++_sp & 255u) == 0u) { if (xb_ld(&(bar)[XB_TMO])) break; if (_sp > XB_SPIN_CAP) { atomicAdd(&(bar)[XB_TMO], 1u); break; } } } } while (0)

struct XcdBarrier {
    unsigned* bar; unsigned x;
    volatile LAS unsigned* st;
};

__device__ __forceinline__ XcdBarrier xcd_barrier_post(unsigned* bar, volatile LAS unsigned* st, const bool t0) {
    XcdBarrier b; b.bar = bar; b.x = xb_xcc_id(); b.st = st;
    if (t0) (void)xb_add(&bar[XB_XCNT(b.x)], 1u);
    return b;
}
__device__ __forceinline__ void xcd_barrier_complete(unsigned* bar, unsigned x, unsigned& nloc, unsigned& nx) {
    const unsigned G = gridDim.x * gridDim.y * gridDim.z;
    unsigned sum, cnt, mine, sp = 0u;
    for (;;) {
        sum = 0u; cnt = 0u; mine = 0u;
#pragma unroll
        for (unsigned j = 0; j < 16; ++j) { const unsigned c = xb_ld(&bar[XB_XCNT(j)]); sum += c; cnt += (c > 0u) ? 1u : 0u; mine = (j == x) ? c : mine; }
        if (sum == G) break;
        __builtin_amdgcn_s_sleep(1);
        if ((++sp & 255u) == 0u) { if (xb_ld(&bar[XB_TMO])) break; if (sp > XB_SPIN_CAP) { atomicAdd(&bar[XB_TMO], 1u); break; } }
    }
    nloc = mine > 0u ? mine : 1u; nx = cnt > 0u ? cnt : 1u;
}

__device__ __forceinline__ void xcd_barrier(const XcdBarrier& b, const bool t0) {
    asm volatile("s_waitcnt vmcnt(0)" ::: "memory");
    __syncthreads();
    if (t0) {
        unsigned* bar = b.bar;
        __builtin_amdgcn_s_waitcnt(0);
        unsigned nloc = b.st[0], nx = b.st[1];
        if (nloc == 0u) { xcd_barrier_complete(bar, b.x, nloc, nx); b.st[0] = nloc; b.st[1] = nx; }
        const unsigned old = xb_add(&bar[XB_XSUB(b.x)], 1u);
        const unsigned gen = old / nloc;
        if (old + 1u == (gen + 1u) * nloc) {
            __builtin_amdgcn_fence(__ATOMIC_RELEASE, "agent");
            asm volatile("s_waitcnt vmcnt(0)" ::: "memory");
            const unsigned og = xb_add(&bar[XB_TOP], 1u);
            const unsigned tg = og / nx;
            if (og + 1u == (tg + 1u) * nx) xb_add(&bar[XB_TOPGEN], 1u);
            else XB_SPIN(xb_ld(&bar[XB_TOPGEN]) == tg, bar);
            __builtin_amdgcn_fence(__ATOMIC_ACQUIRE, "agent");
            xb_add(&bar[XB_XGEN(b.x)], 1u);
            asm volatile("s_waitcnt vmcnt(0)" ::: "memory");
        } else {
            XB_SPIN(xb_ld(&bar[XB_XGEN(b.x)]) == gen, bar);
            __builtin_amdgcn_fence(__ATOMIC_ACQUIRE, "agent");
            asm volatile("s_waitcnt vmcnt(0)" ::: "memory");
        }
    }
    __syncthreads();
}
constexpr int NWAVES = 8, NTHR = 512;
struct Args { const float* in[32]; float* out; unsigned char* ws; int ph_lo, ph_hi, one_launch, pad; };
enum InIdx { I_X = 0, I_C, I_CTX, I_CCTX, I_ADAW, I_ADAB, I_N1G, I_N2G, I_EVWIN, I_EVWOUT, I_HYCW, I_HYCB, I_HYW1, I_HYB1, I_HYW2, I_HYB2, I_HYW3, I_HYFREQ, I_HYSKIP, I_SINK,
             I_ODWQKV, I_ODWOUT, I_ODQG, I_ODKG, I_RTGW, I_RTGB, I_RTEW, I_RTEB, I_MOEG, I_MOEU, I_MOED, I_FNG };
struct Frame {
    LAS unsigned char* lds; int wave, G, bid;
    unsigned char* ws; gu32* ctl;
};
struct TItem { const float* src; int ldw; bf16* WT; int Kd, drow0, drow1, k0; bool perm; };
__device__ __forceinline__ int qkv_drow(int n) { const int pn = n >> 8, rem = n & 255; return 256 * pn + 128 * ((rem & 63) >> 5) + 32 * (rem >> 6); }
__device__ __forceinline__ TItem decode_item(const Args& a, unsigned char* ws, int it) {
    constexpr int S1 = 16 * 24, S2 = S1 + 16 * 12, S3 = S2 + 16 * 16, S4 = S3 + 16 * 24, S5 = S4 + 16 * 16;
    TItem t; t.perm = false;
    if (it < S1) { const int kb = it / 24, nb = it % 24, n = 64 * nb; t.src = a.in[I_EVWIN] + (size_t)(64 * kb) * D_IN_EVEN + n; t.ldw = D_IN_EVEN; t.WT = (bf16*)(ws + WS_WHY); t.Kd = 1024; t.drow0 = n; t.drow1 = n + 32; t.k0 = 64 * kb; }
    else if (it < S2) { const int r = it - S1, kb = r / 12, nb = r % 12, n = 64 * nb;
        if (n < 512) { t.drow0 = qkv_drow(n); t.drow1 = qkv_drow(n + 32); t.perm = true; } else { t.drow0 = n; t.drow1 = n + 32; t.perm = n < 640; }
        t.src = a.in[I_EVWIN] + (size_t)(64 * kb) * D_IN_EVEN + 1536 + n; t.ldw = D_IN_EVEN; t.WT = (bf16*)(ws + WS_WATT0); t.Kd = 1024; t.k0 = 64 * kb; }
    else if (it < S3) { const int r = it - S2, kb = r / 16, nb = r % 16, n = 64 * nb; t.src = a.in[I_EVWOUT] + (size_t)(64 * kb) * 1024 + n; t.ldw = 1024; t.WT = (bf16*)(ws + WS_WOUT0); t.Kd = 1024; t.drow0 = n; t.drow1 = n + 32; t.k0 = 64 * kb; }
    else if (it < S4) { const int r = it - S3, kb = r / 24, nb = r % 24, n = 64 * nb;
        t.src = a.in[I_ODWQKV] + (size_t)(64 * kb) * D_QKV1 + n; t.ldw = D_QKV1; t.WT = (bf16*)(ws + WS_WQKV1); t.Kd = 1024; t.drow0 = qkv_drow(n); t.drow1 = qkv_drow(n + 32); t.k0 = 64 * kb; t.perm = n < 1280; }
    else if (it < S5) { const int r = it - S4, kb = r / 16, nb = r % 16, n = 64 * nb; t.src = a.in[I_ODWOUT] + (size_t)(64 * kb) * 1024 + n; t.ldw = 1024; t.WT = (bf16*)(ws + WS_WOUT1); t.Kd = 1024; t.drow0 = n; t.drow1 = n + 32; t.k0 = 64 * kb; }
    else { const int r = it - S5, le = r / 384, sub = r % 384;
        if (sub < 256) { const int up = sub >> 7, s2 = sub & 127, kb = s2 >> 3, nb = s2 & 7, n = 64 * nb;
            t.src = a.in[up ? I_MOEU : I_MOEG] + (size_t)le * 1024 * 512 + (size_t)(64 * kb) * 512 + n; t.ldw = 512; t.WT = (bf16*)(ws + WS_WGU) + (size_t)le * 1024 * 1024; t.Kd = 1024;
            t.drow0 = 256 * (n >> 7) + (n & 127) + 128 * up; t.drow1 = t.drow0 + 32; t.k0 = 64 * kb; }
        else { const int s2 = sub - 256, kb = s2 >> 4, nb = s2 & 15, n = 64 * nb;
            t.src = a.in[I_MOED] + (size_t)le * 512 * 1024 + (size_t)(64 * kb) * 1024 + n; t.ldw = 1024; t.WT = (bf16*)(ws + WS_WDN) + (size_t)le * 1024 * 512; t.Kd = 512; t.drow0 = n; t.drow1 = n + 32; t.k0 = 64 * kb; } }
    return t;
}
__device__ __forceinline__ int pinv32(int j) { return j < 16 ? 8 * (j >> 2) + (j & 3) : 8 * ((j - 16) >> 2) + 4 + ((j - 16) & 3); }
struct TRegs { float v[64]; };
__device__ __forceinline__ TRegs titem_load(const TItem& t, int lane) { TRegs r; const float* p = t.src + lane;
#pragma unroll
    for (int i = 0; i < 64; ++i) r.v[i] = p[(size_t)i * t.ldw];
    return r; }
__device__ __forceinline__ void titem_store(const TItem& t, const TRegs& r, LAS float* scr, int lane) {
#pragma unroll
    for (int i = 0; i < 64; ++i) scr[i * 65 + lane] = r.v[i];
    LDS_WAIT(); asm volatile("" ::: "memory");
    const int c = lane & 7;
#pragma unroll
    for (int j = 0; j < 8; ++j) { const int n = (lane >> 3) + 8 * j; const LAS float* s = scr + (8 * c) * 65 + n;
        v4u o; o.x = pk2(s[0 * 65], s[1 * 65]); o.y = pk2(s[2 * 65], s[3 * 65]); o.z = pk2(s[4 * 65], s[5 * 65]); o.w = pk2(s[6 * 65], s[7 * 65]);
        const int nl = n & 31;
        *(GAS v4u*)(t.WT + (size_t)((j >= 4 ? t.drow1 : t.drow0) + (t.perm ? pinv32(nl) : nl)) * t.Kd + t.k0 + 8 * c) = o; }
    LDS_WAIT(); asm volatile("" ::: "memory");
}

constexpr int W_ITEMS_ALL = 16 * 24 + 16 * 12 + 16 * 16 + 16 * 24 + 16 * 16 + 64 * 384, W_ITEMS_L1MOE = W_ITEMS_ALL - 32 * 384;
__device__ __forceinline__ void weight_items(Frame& F, const Args& a, const int lo, const int hi, const int rank, const int nblk) {
    const int F_lane = lane_id();
    LAS float* scr = (LAS float*)(F.lds + F.wave * 16896);
    const int gw = lo + rank * NWAVES + F.wave, NGW = nblk * NWAVES;
    if (gw < hi) {
        TItem cur = decode_item(a, F.ws, gw); TRegs rc = titem_load(cur, F_lane);
        for (int it = gw; it < hi; it += NGW) {
            const int itn = it + NGW < hi ? it + NGW : it; const TItem nxt = decode_item(a, F.ws, itn); const TRegs rn = titem_load(nxt, F_lane);
            titem_store(cur, rc, scr, F_lane);
            cur = nxt; rc = rn;
        }
    }
}

__device__ __forceinline__ void p0_prologue(Frame& F, const Args& a) {
    const int F_lane = lane_id(), F_tid = F.wave * 64 + F_lane; (void)F_tid;
    unsigned char* ws = F.ws;
    {
        LAS float* sv = (LAS float*)F.lds; LAS float* red = (LAS float*)(F.lds + 17 * 1024 * 4);
        float* MOD = (float*)(ws + WS_MOD);
        for (int u = F.bid; u < 192; u += F.G) {
            const int l = u / 96, n0 = (u % 96) * 64;
            for (int idx = F_tid; idx < 17 * 1024; idx += NTHR) { const int b = idx >> 10, k = idx & 1023; const float v = b < 16 ? a.in[I_C][b * 1024 + k] : a.in[I_CCTX][k]; sv[idx] = silu_f(v); }
            __syncthreads();
            float acc[17];
#pragma unroll
            for (int b = 0; b < 17; ++b) acc[b] = 0.f;
            const float* Wp = a.in[I_ADAW] + (size_t)l * 1024 * 6144 + n0 + F_lane;
            for (int k0 = F.wave * 128; k0 < F.wave * 128 + 128; k0 += 16) { float wv[16];
#pragma unroll
                for (int kk = 0; kk < 16; ++kk) wv[kk] = Wp[(size_t)(k0 + kk) * 6144];
#pragma unroll
                for (int kk = 0; kk < 16; ++kk)
#pragma unroll
                    for (int b = 0; b < 17; ++b) acc[b] += sv[b * 1024 + k0 + kk] * wv[kk]; }
#pragma unroll
            for (int b = 0; b < 17; ++b) red[(F.wave * 17 + b) * 64 + F_lane] = acc[b];
            __syncthreads();
            for (int idx = F_tid; idx < 17 * 64; idx += NTHR) { const int b = idx >> 6, j = idx & 63; float s = a.in[I_ADAB][l * 6144 + n0 + j];
#pragma unroll
                for (int w = 0; w < 8; ++w) s += red[(w * 17 + b) * 64 + j];
                MOD[((size_t)l * 17 + b) * 6144 + n0 + j] = s; }
            __syncthreads();
        }
    }
    {
        const float* w1 = a.in[I_HYW1]; const float* b1 = a.in[I_HYB1]; const float* w2 = a.in[I_HYW2]; const float* b2 = a.in[I_HYB2]; const float* fr = a.in[I_HYFREQ];
        float* HD2 = (float*)(ws + WS_HD2);
        const int gw = F.bid * NWAVES + F.wave, NGW = F.G * NWAVES;
        if (gw < 4352) {
            float w1c[33], w2c[64];
#pragma unroll
            for (int i = 0; i < 33; ++i) w1c[i] = w1[i * 64 + F_lane];
#pragma unroll
            for (int i = 0; i < 64; ++i) w2c[i] = w2[i * 64 + F_lane];
            const float frl = fr[F_lane], b1l = b1[F_lane], b2l = b2[F_lane];
            for (int tt = gw; tt < 4352; tt += NGW) {
                const int n = tt < 4096 ? 4096 : 256, t = tt < 4096 ? tt : tt - 4096; const float tf = (float)t; const float tn = tf / (float)(n - 1);
                float z = 0.f;
                if (F_lane == 0) z = tn;
                else if (F_lane < 33) { const int m = (F_lane - 1) & 15; const float band = 1e-4f + (float)m * ((15.f - 1e-4f) / 15.f); const float ang = ((float)(2.0 * M_PI / (double)n) * tf) * band;
                    z = F_lane < 17 ? cosf(ang) : -sinf(ang); }
                float h1 = b1l;
#pragma unroll
                for (int i = 0; i < 33; ++i) h1 += __builtin_bit_cast(float, __builtin_amdgcn_readlane(__builtin_bit_cast(int, z), i)) * w1c[i];
                h1 = sinf(frl * h1);
                float h2 = b2l;
#pragma unroll
                for (int i = 0; i < 64; ++i) h2 += __builtin_bit_cast(float, __builtin_amdgcn_readlane(__builtin_bit_cast(int, h1), i)) * w2c[i];
                h2 = sinf(frl * h2);
                HD2[(size_t)tt * 64 + F_lane] = h2;
            }
        }
    }
    if (F.bid == 0) {
        f32x2* RT = (f32x2*)(ws + WS_ROPE);
        for (int idx = F_tid; idx < 1024; idx += NTHR) { const int pos = idx >> 4, i = idx & 15; const float inv = powf(10000.f, -(float)(2 * i) / 32.f); const float ang = (float)pos * inv; RT[idx] = (f32x2){cosf(ang), sinf(ang)}; }
    }
    weight_items(F, a, 0, W_ITEMS_L1MOE, F.bid, F.G);
    __syncthreads();
}

struct RowVec { f32x4 v[4]; };
__device__ __forceinline__ RowVec ld_row(const float* p, int lane) { RowVec r; const f32x4* q = (const f32x4*)p + lane;
#pragma unroll
    for (int j = 0; j < 4; ++j) r.v[j] = q[64 * j]; return r; }
__device__ __forceinline__ void st_row(float* p, int lane, const RowVec& r) { f32x4* q = (f32x4*)p + lane;
#pragma unroll
    for (int j = 0; j < 4; ++j) q[64 * j] = r.v[j]; }
__device__ __forceinline__ void st_row_bf16(bf16* p, int lane, const RowVec& r) { unsigned long long* o8 = (unsigned long long*)p + lane;
#pragma unroll
    for (int j = 0; j < 4; ++j) o8[64 * j] = (unsigned long long)pk2(r.v[j][0], r.v[j][1]) | ((unsigned long long)pk2(r.v[j][2], r.v[j][3]) << 32); }
__device__ __forceinline__ RowVec ld_row_bf16(const bf16* p, int lane) { RowVec r; const u32x2* q = (const u32x2*)p + lane;
#pragma unroll
    for (int j = 0; j < 4; ++j) { const u32x2 w = q[64 * j]; r.v[j] = (f32x4){bflo(w.x), bfhi(w.x), bflo(w.y), bfhi(w.y)}; } return r; }
struct RowRaw { u32x2 w[4]; };
__device__ __forceinline__ RowRaw ld_raw_bf16(const bf16* p, int lane) { RowRaw r; const u32x2* q = (const u32x2*)p + lane;
#pragma unroll
    for (int j = 0; j < 4; ++j) r.w[j] = q[64 * j]; return r; }
__device__ __forceinline__ RowVec norm_mod(const RowVec& x, const float* g, const float* scale, const float* shift, int lane) {
    float ss = 0.f;
#pragma unroll
    for (int j = 0; j < 4; ++j) ss += (x.v[j][0] * x.v[j][0] + x.v[j][1] * x.v[j][1]) + (x.v[j][2] * x.v[j][2] + x.v[j][3] * x.v[j][3]);
    const float rs = rsqrtf(wave_sum(ss) * (1.f / 1024.f) + NORM_EPS);
    const RowVec gv = ld_row(g, lane); RowVec y;
    if (scale) { const RowVec sc = ld_row(scale, lane), sf = ld_row(shift, lane);
#pragma unroll
        for (int j = 0; j < 4; ++j) y.v[j] = (x.v[j] * rs * gv.v[j]) * (sc.v[j] + 1.f) + sf.v[j];
    } else {
#pragma unroll
        for (int j = 0; j < 4; ++j) y.v[j] = x.v[j] * rs * gv.v[j];
    }
    return y;
}
__device__ __forceinline__ void jrow_split(int row, int& b, int& j) { b = row / RPB; j = row - b * RPB; }

__device__ __forceinline__ void split_hl(const float (&v)[8], bf16x8& hi, bf16x8& lo) {
#pragma unroll
    for (int j = 0; j < 8; ++j) { const unsigned hb = f2bf(v[j]); hi[j] = (short)hb; lo[j] = (short)f2bf(v[j] - __builtin_bit_cast(float, hb << 16)); }
}
__device__ __forceinline__ void p_filter_stage_b(Frame& F, const Args& a, const int rank, const int nblk) {
    const int F_lane = lane_id();
    const float* w3 = a.in[I_HYW3]; const float* HD2 = (const float*)(F.ws + WS_HD2);
    const int gw = rank * NWAVES + F.wave, NGW = nblk * NWAVES;
    const float mind = logf(1e-2f) / 1.5f, maxd = logf(1e-2f) / 0.3f;
    const int lr = F_lane & 15, lg = F_lane >> 4;
    for (int wu = gw; wu < 68 * 32; wu += NGW) {
        const int tc = wu >> 5, cchunk = wu & 31; const bool isc = tc >= 64; const int n = isc ? 256 : 4096; const int t0 = (isc ? tc - 64 : tc) * 64; const int tt0 = isc ? 4096 + t0 : t0;
        float* HR = (float*)(F.ws + (isc ? WS_HRAWC : WS_HRAW)); const int colb = cchunk * 64;
        bf16x8 Ahi[4][2], Alo[4][2];
#pragma unroll
        for (int tt = 0; tt < 4; ++tt)
#pragma unroll
            for (int ks = 0; ks < 2; ++ks) { const float* hp = HD2 + (size_t)(tt0 + 16 * tt + lr) * 64 + 32 * ks + 8 * lg; const f32x4 h0 = *(const f32x4*)hp, h1 = *(const f32x4*)(hp + 4);
                const float v[8] = {h0[0], h0[1], h0[2], h0[3], h1[0], h1[1], h1[2], h1[3]}; split_hl(v, Ahi[tt][ks], Alo[tt][ks]); }
        const float rn1 = 1.f / (float)(n - 1);
#pragma unroll 1
        for (int ct = 0; ct < 4; ++ct) {
            const int col = colb + 16 * ct + lr;
            bf16x8 Bhi[2], Blo[2];
#pragma unroll
            for (int ks = 0; ks < 2; ++ks) { float v[8];
#pragma unroll
                for (int j = 0; j < 8; ++j) v[j] = w3[(size_t)(32 * ks + 8 * lg + j) * 2048 + col];
                split_hl(v, Bhi[ks], Blo[ks]); }
            const float ad = fabsf(mind + (float)(col & 511) * ((maxd - mind) / 511.f)) * LOG2E;
#pragma unroll
            for (int tt = 0; tt < 4; ++tt) { f32x4 acc = (f32x4){0.f, 0.f, 0.f, 0.f};
#pragma unroll
                for (int ks = 0; ks < 2; ++ks) { acc = __builtin_amdgcn_mfma_f32_16x16x32_bf16(Ahi[tt][ks], Bhi[ks], acc, 0, 0, 0); acc = __builtin_amdgcn_mfma_f32_16x16x32_bf16(Alo[tt][ks], Bhi[ks], acc, 0, 0, 0);
                    acc = __builtin_amdgcn_mfma_f32_16x16x32_bf16(Ahi[tt][ks], Blo[ks], acc, 0, 0, 0); }
                const int tb = t0 + 16 * tt + 4 * lg; f32x4 o;
#pragma unroll
                for (int r = 0; r < 4; ++r) o[r] = acc[r] * __builtin_amdgcn_exp2f(-((float)(tb + r) * rn1) * ad);
                *(f32x4*)(HR + (size_t)col * n + tb) = o; }
        }
    }
}

__device__ __forceinline__ bf16* x2b_row(unsigned char* ws, int b, int t) {
    const size_t base = b < 8 ? WS_WGU + (size_t)b * (8 * MiB) : (b < 12 ? WS_WDN + (size_t)(b - 8) * (8 * MiB) : WS_HRAW + (size_t)(b - 12) * (8 * MiB));
    return (bf16*)(ws + base) + (size_t)t * DM;
}
__device__ __forceinline__ const float* p1_src(const Args& a, int row) { int b, j; jrow_split(row, b, j); return j < CTXL ? a.in[I_CTX] + ((size_t)b * CTXL + j) * DM : a.in[I_X] + ((size_t)b * SEQ + (j - CTXL)) * DM; }
__device__ __forceinline__ void p_norm1_l0(Frame& F, const Args& a) {
    const int F_lane = lane_id();
    const float* MOD = (const float*)(F.ws + WS_MOD); bf16* H = (bf16*)(F.ws + WS_BUF1);
    const int gw = F.bid * NWAVES + F.wave, NGW = F.G * NWAVES;
    RowVec xn = ld_row(p1_src(a, gw < NROWS ? gw : 0), F_lane);
    for (int row = gw; row < NROWS; row += NGW) { int b, j; jrow_split(row, b, j);
        const RowVec x = xn; const int rn = row + NGW < NROWS ? row + NGW : row; xn = ld_row(p1_src(a, rn), F_lane);
        const float* md = MOD + (size_t)(j < CTXL ? 16 : b) * 6144;
        const RowVec y = norm_mod(x, a.in[I_N1G], md + 1024, md, F_lane);
        st_row_bf16(H + (size_t)row * DM, F_lane, y); }
}

__device__ __forceinline__ void moe_tab(Frame& F, LAS int* tab, int layer) {
    const int F_lane = lane_id(), F_tid = F.wave * 64 + F_lane; (void)F_tid;
    if (F_tid < 32) tab[64 + F_tid] = (int)__hip_atomic_load(F.ctl + CW_CNT + 64 * layer + F_tid, RLX_AGENT);
    __syncthreads();
    if (F_tid == 0) { int s = 0; for (int e = 0; e < 32; ++e) { tab[e] = s; s += (tab[64 + e] + 255) >> 8; } tab[32] = s; for (int e = 33; e < 64; ++e) tab[e] = 0x7fffffff; }
    __syncthreads();
}

constexpr int RT_HPITCH = 2064;
constexpr int RT_PART_OFF = 2 * 16 * RT_HPITCH, RT_LGS_OFF = RT_PART_OFF + 8 * 48 * 16 * 4, RT_CNT_OFF = RT_LGS_OFF + 16 * 48 * 4, RT_REC_OFF = RT_CNT_OFF + 256, RT_MAXROWS = 288;
static_assert(RT_REC_OFF + 3 * 2 * RT_MAXROWS * 4 <= MISC_OFF, "router LDS map");
template <int LAYER>
__device__ __forceinline__ void p_norm2_route(Frame& F, const Args& a) {
    const int F_lane = lane_id(), F_tid = F.wave * 64 + F_lane;
    const float* MOD = (const float*)(F.ws + WS_MOD) + (size_t)LAYER * 17 * 6144; bf16* H2 = (bf16*)(F.ws + WS_BUF1);
    LAS unsigned char* hbuf = F.lds; LAS unsigned char* hbuf_lo = F.lds + 16 * RT_HPITCH; LAS float* part = (LAS float*)(F.lds + RT_PART_OFF); LAS float* lgs = (LAS float*)(F.lds + RT_LGS_OFF);
    LAS int* lcnt = (LAS int*)(F.lds + RT_CNT_OFF); LAS int* lbase = lcnt + 32;
    LAS int* recE = (LAS int*)(F.lds + RT_REC_OFF); LAS int* recP = recE + 2 * RT_MAXROWS; LAS float* recG = (LAS float*)(recP + 2 * RT_MAXROWS);
    const float* wg = a.in[I_RTGW] + (size_t)LAYER * 1024 * 4; const float* we = a.in[I_RTEW] + (size_t)LAYER * 1024 * 32;
    const float* gb = a.in[I_RTGB] + LAYER * 4; const float* eb = a.in[I_RTEB] + LAYER * 32;
    bf16x8 Whi[3][4], Wlo[3][4];
#pragma unroll
    for (int nt = 0; nt < 3; ++nt)
#pragma unroll
        for (int ks = 0; ks < 4; ++ks) { const int o = 16 * nt + (F_lane & 15); const int k0 = 128 * F.wave + 32 * ks + 8 * (F_lane >> 4);
#pragma unroll
            for (int j = 0; j < 8; ++j) { float wv = 0.f; if (o < 4) wv = wg[(size_t)(k0 + j) * 4 + o]; else if (o < 36) wv = we[(size_t)(k0 + j) * 32 + (o - 4)];
                const unsigned hb = f2bf(wv); const float hf = __builtin_bit_cast(float, hb << 16); Whi[nt][ks][j] = (short)hb; Wlo[nt][ks][j] = (short)f2bf(wv - hf); }
            asm volatile("" : "+v"(Whi[nt][ks]), "+v"(Wlo[nt][ks]) :: "memory"); }
    if (F_tid < 64) lcnt[F_tid] = 0;
    __syncthreads();
    const int nrows = LAYER == 0 ? NROWS : NB * SEQ; const int chunk = (nrows + F.G - 1) / F.G;
    const int i0 = F.bid * chunk, i1 = (i0 + chunk < nrows) ? i0 + chunk : nrows;
    const bf16* YB = (const bf16*)(F.ws + WS_Y);
#define RT_LDX(i_) ({ RowVec xr_; if (LAYER == 0) { int b_, j_; jrow_split((i_), b_, j_); xr_ = ld_row(j_ < CTXL ? a.in[I_CTX] + ((size_t)b_ * CTXL + j_) * DM : a.in[I_X] + ((size_t)b_ * SEQ + (j_ - CTXL)) * DM, F_lane); } \
    else xr_ = ld_row_bf16(x2b_row(F.ws, (i_) >> 12, (i_) & 4095), F_lane); xr_; })
#define RT_YROW(i_) (LAYER == 0 ? (i_) : ((i_) >> 12) * RPB + CTXL + ((i_) & 4095))
    RowVec xq[2]; RowRaw yq[2];
#pragma unroll
    for (int r = 0; r < 2; ++r) { const int i = (i0 + 2 * F.wave + r < i1) ? i0 + 2 * F.wave + r : i1 - 1; xq[r] = RT_LDX(i); yq[r] = ld_raw_bf16(YB + (size_t)RT_YROW(i) * DM, F_lane); }
    for (int ig = i0; ig < i1; ig += 16) {
#pragma unroll
        for (int r = 0; r < 2; ++r) {
            const int rl = 2 * F.wave + r; const bool valid = ig + rl < i1; const int i = valid ? ig + rl : i1 - 1; int row, b, j;
            if (LAYER == 0) { row = i; jrow_split(row, b, j); } else { b = i >> 12; j = CTXL + (i & 4095); row = b * RPB + j; }
            const float* md = MOD + (size_t)(j < CTXL ? 16 : b) * 6144;
            RowVec x1 = xq[r];
#pragma unroll
            for (int q = 0; q < 4; ++q) x1.v[q] = x1.v[q] + (f32x4){bflo(yq[r].w[q].x), bfhi(yq[r].w[q].x), bflo(yq[r].w[q].y), bfhi(yq[r].w[q].y)};
            const RowVec y = norm_mod(x1, a.in[I_N2G] + LAYER * 1024, md + 4 * 1024, md + 3 * 1024, F_lane);
            unsigned long long pk[4], pl[4];
#pragma unroll
            for (int q = 0; q < 4; ++q) { const unsigned h0 = f2bf(y.v[q][0]), h1 = f2bf(y.v[q][1]), h2_ = f2bf(y.v[q][2]), h3 = f2bf(y.v[q][3]);
                pk[q] = (unsigned long long)(h0 | (h1 << 16)) | ((unsigned long long)(h2_ | (h3 << 16)) << 32);
                const float l0 = y.v[q][0] - __builtin_bit_cast(float, h0 << 16), l1 = y.v[q][1] - __builtin_bit_cast(float, h1 << 16), l2 = y.v[q][2] - __builtin_bit_cast(float, h2_ << 16), l3 = y.v[q][3] - __builtin_bit_cast(float, h3 << 16);
                pl[q] = (unsigned long long)pk2(l0, l1) | ((unsigned long long)pk2(l2, l3) << 32); }
            if (valid) { unsigned long long* o8 = (unsigned long long*)(H2 + (size_t)row * DM) + F_lane;
#pragma unroll
                for (int q = 0; q < 4; ++q) o8[64 * q] = pk[q]; }
#pragma unroll
            for (int q = 0; q < 4; ++q) { *(LAS unsigned long long*)(hbuf + rl * RT_HPITCH + (4 * F_lane + 256 * q) * 2) = pk[q]; *(LAS unsigned long long*)(hbuf_lo + rl * RT_HPITCH + (4 * F_lane + 256 * q) * 2) = pl[q]; }
        }
        {   const int ign = ig + 16;
#pragma unroll
            for (int r = 0; r < 2; ++r) { const int i = (ign + 2 * F.wave + r < i1) ? ign + 2 * F.wave + r : i1 - 1; xq[r] = RT_LDX(i); yq[r] = ld_raw_bf16(YB + (size_t)RT_YROW(i) * DM, F_lane); } }
        __syncthreads();
        {   f32x4 acc[3];
#pragma unroll
            for (int nt = 0; nt < 3; ++nt) acc[nt] = (f32x4){0.f, 0.f, 0.f, 0.f};
#pragma unroll
            for (int ks = 0; ks < 4; ++ks) { const int bo = (F_lane & 15) * RT_HPITCH + (128 * F.wave + 32 * ks + 8 * (F_lane >> 4)) * 2;
                const bf16x8 bfr = *(const LAS bf16x8*)(hbuf + bo), bfl = *(const LAS bf16x8*)(hbuf_lo + bo);
#pragma unroll
                for (int nt = 0; nt < 3; ++nt) { acc[nt] = __builtin_amdgcn_mfma_f32_16x16x32_bf16(Whi[nt][ks], bfr, acc[nt], 0, 0, 0); acc[nt] = __builtin_amdgcn_mfma_f32_16x16x32_bf16(Wlo[nt][ks], bfr, acc[nt], 0, 0, 0);
                    acc[nt] = __builtin_amdgcn_mfma_f32_16x16x32_bf16(Whi[nt][ks], bfl, acc[nt], 0, 0, 0); } }
#pragma unroll
            for (int nt = 0; nt < 3; ++nt)
#pragma unroll
                for (int rg = 0; rg < 4; ++rg) part[(F.wave * 48 + 16 * nt + 4 * (F_lane >> 4) + rg) * 16 + (F_lane & 15)] = acc[nt][rg]; }
        __syncthreads();
        for (int idx = F_tid; idx < 36 * 16; idx += NTHR) { const int o = idx >> 4, r = idx & 15; float sacc = o < 4 ? gb[o] : eb[o - 4];
#pragma unroll
            for (int w = 0; w < 8; ++w) sacc += part[(w * 48 + o) * 16 + r];
            lgs[r * 48 + o] = sacc; }
        __syncthreads();
        if (F_tid < 16 && ig + F_tid < i1) {
            float lg[36];
#pragma unroll
            for (int o4 = 0; o4 < 9; ++o4) { const f32x4 t4 = *(const LAS f32x4*)(lgs + F_tid * 48 + 4 * o4); lg[4 * o4] = t4[0]; lg[4 * o4 + 1] = t4[1]; lg[4 * o4 + 2] = t4[2]; lg[4 * o4 + 3] = t4[3]; }
            int grp = 0; float gmax = lg[0];
#pragma unroll
            for (int q = 1; q < 4; ++q) if (lg[q] > gmax) { gmax = lg[q]; grp = q; }
            float den = 0.f;
#pragma unroll
            for (int q = 0; q < 4; ++q) den += __expf(lg[q] - gmax);
            const float pg = 1.f / den;
            float el[8];
#pragma unroll
            for (int q = 0; q < 8; ++q) { float v = 0.f;
#pragma unroll
                for (int g2 = 0; g2 < 4; ++g2) v = (grp == g2) ? lg[4 + 8 * g2 + q] : v;
                el[q] = v; }
            int i0e = 0; float m0 = el[0];
#pragma unroll
            for (int q = 1; q < 8; ++q) if (el[q] > m0) { m0 = el[q]; i0e = q; }
            int i1e = -1; float m1 = -INFINITY;
#pragma unroll
            for (int q = 0; q < 8; ++q) if (q != i0e && el[q] > m1) { m1 = el[q]; i1e = q; }
            const float ex = __expf(m1 - m0); const float g0 = pg / (1.f + ex), g1 = pg * ex / (1.f + ex);
            const int e0 = grp * 8 + i0e, e1 = grp * 8 + i1e; const int li = ig + F_tid - i0;
            recE[2 * li] = e0; recE[2 * li + 1] = e1; recG[2 * li] = g0; recG[2 * li + 1] = g1;
            recP[2 * li] = atomicAdd((int*)&lcnt[e0], 1); recP[2 * li + 1] = atomicAdd((int*)&lcnt[e1], 1);
        }
    }
    __syncthreads();
    const int tid2 = F.wave * 64 + lane_id();
    if (tid2 < 32) { const int c = lcnt[tid2]; lbase[tid2] = c > 0 ? (int)__hip_atomic_fetch_add(F.ctl + CW_CNT + 64 * LAYER + tid2, (unsigned)c, RLX_AGENT) : 0; }
    __syncthreads();
    int* TOK = (int*)(F.ws + WS_TOKIDX); float* GT = (float*)(F.ws + WS_GATE); int* RT = (int*)(F.ws + WS_ROUTE);
    for (int idx = tid2; idx < 2 * (i1 - i0); idx += NTHR) { const int li = idx >> 1, i = i0 + li; int row;
        if (LAYER == 0) row = i; else row = (i >> 12) * RPB + CTXL + (i & 4095);
        const int e = recE[idx], pos = lbase[e] + recP[idx];
        TOK[(size_t)e * CAP + pos] = row; GT[(size_t)e * CAP + pos] = recG[idx]; RT[(size_t)row * 4 + 2 * (idx & 1)] = e; RT[(size_t)row * 4 + 2 * (idx & 1) + 1] = pos; }
#undef RT_LDX
#undef RT_YROW
}

template <int LAYER> __device__ __forceinline__ int cmb_row(int i) { return LAYER == 0 ? i : (i >> 12) * RPB + CTXL + (i & 4095); }
template <int LAYER>
__device__ __forceinline__ void p_combine(Frame& F, const Args& a) {
    const int F_lane = lane_id(), F_tid = F.wave * 64 + F_lane; (void)F_tid;
    const float* MOD = (const float*)(F.ws + WS_MOD) + (size_t)LAYER * 17 * 6144; const float* MOD1 = (const float*)(F.ws + WS_MOD) + (size_t)17 * 6144;
    float* XC = (float*)(F.ws + WS_XC); bf16* H = (bf16*)(F.ws + WS_BUF1); const bf16* MOUT = (const bf16*)(F.ws + WS_BUF2); const int* RT = (const int*)(F.ws + WS_ROUTE); const bf16* YB = (const bf16*)(F.ws + WS_Y);
    LAS int* tab = (LAS int*)F.lds; moe_tab(F, tab, LAYER);
    const int gw = F.bid * NWAVES + F.wave, NGW = F.G * NWAVES; const int nrows = LAYER == 0 ? NROWS : NB * SEQ;
    if (gw >= nrows) return;
    typedef int i32x4 __attribute__((ext_vector_type(4)));
#define CMB_XP(row_) ({ int b_, j_; jrow_split((row_), b_, j_); j_ < CTXL ? XC + ((size_t)b_ * CTXL + j_) * DM : a.out + ((size_t)b_ * SEQ + (j_ - CTXL)) * DM; })
#define CMB_LDX(row_) ({ RowVec xr_; int b_, j_; jrow_split((row_), b_, j_); if (LAYER == 0) xr_ = ld_row(j_ < CTXL ? a.in[I_CTX] + ((size_t)b_ * CTXL + j_) * DM : a.in[I_X] + ((size_t)b_ * SEQ + (j_ - CTXL)) * DM, F_lane); else xr_ = ld_row_bf16(x2b_row(F.ws, b_, j_ - CTXL), F_lane); xr_; })
    int i = gw; int row = cmb_row<LAYER>(i);
    i32x4 rt = *(const i32x4*)(RT + (size_t)row * 4);
    int i_n = i + NGW < nrows ? i + NGW : i; int row_n = cmb_row<LAYER>(i_n);
    i32x4 rt_n = *(const i32x4*)(RT + (size_t)row_n * 4);
    RowVec x = CMB_LDX(row); RowRaw yr = ld_raw_bf16(YB + (size_t)row * DM, F_lane);
    RowRaw m0 = ld_raw_bf16(MOUT + ((size_t)tab[rt[0]] * 256 + rt[1]) * DM, F_lane), m1 = ld_raw_bf16(MOUT + ((size_t)tab[rt[2]] * 256 + rt[3]) * DM, F_lane);
    for (; i < nrows; ) {
        const int i_nn = i_n + NGW < nrows ? i_n + NGW : i_n; const int row_nn = cmb_row<LAYER>(i_nn);
        const i32x4 rt_nn = *(const i32x4*)(RT + (size_t)row_nn * 4);
        const RowVec x_n = CMB_LDX(row_n); const RowRaw yr_n = ld_raw_bf16(YB + (size_t)row_n * DM, F_lane);
        const RowRaw m0_n = ld_raw_bf16(MOUT + ((size_t)tab[rt_n[0]] * 256 + rt_n[1]) * DM, F_lane), m1_n = ld_raw_bf16(MOUT + ((size_t)tab[rt_n[2]] * 256 + rt_n[3]) * DM, F_lane);
        int b, j; jrow_split(row, b, j); float* xp = CMB_XP(row); const int mb = j < CTXL ? 16 : b;
        const RowVec g5 = ld_row(MOD + (size_t)mb * 6144 + 5 * 1024, F_lane);
#pragma unroll
        for (int q = 0; q < 4; ++q) { const f32x4 a0 = (f32x4){bflo(m0.w[q].x), bfhi(m0.w[q].x), bflo(m0.w[q].y), bfhi(m0.w[q].y)}, a1 = (f32x4){bflo(m1.w[q].x), bfhi(m1.w[q].x), bflo(m1.w[q].y), bfhi(m1.w[q].y)};
            x.v[q] = (x.v[q] + (f32x4){bflo(yr.w[q].x), bfhi(yr.w[q].x), bflo(yr.w[q].y), bfhi(yr.w[q].y)}) + g5.v[q] * (a0 + a1); }
        if (LAYER == 0) { if (j >= CTXL) st_row_bf16(x2b_row(F.ws, b, j - CTXL), F_lane, x); const float* md = MOD1 + (size_t)mb * 6144; const RowVec y = norm_mod(x, a.in[I_N1G] + 1024, md + 1024, md, F_lane); st_row_bf16(H + (size_t)row * DM, F_lane, y); }
        else { const RowVec y = norm_mod(x, a.in[I_FNG], nullptr, nullptr, F_lane); st_row(xp, F_lane, y); }
        if (i + NGW >= nrows) break;
        i = i_n; row = row_n; x = x_n; yr = yr_n; m0 = m0_n; m1 = m1_n; i_n = i_nn; row_n = row_nn; rt_n = rt_nn;
    }
#undef CMB_XP
#undef CMB_LDX
}

__device__ __forceinline__ void p_transpose_y(Frame& F) {
    const int F_lane = lane_id();
    const bf16* YT = (const bf16*)(F.ws + WS_BUF4); bf16* YM = (bf16*)(F.ws + WS_BUF1);
    LAS unsigned short* t = (LAS unsigned short*)(F.lds + F.wave * 9216);
    const int gw = F.bid * NWAVES + F.wave, NGW = F.G * NWAVES; const int NT_R = NROWS / 64; const int NTILES = 8 * NT_R;
    if (gw >= NTILES) return;
    u32x4 cur[8], nxt[8];
#define TY_LOAD(dst, tile_) do { const int cb_ = (tile_) / NT_R, rb_ = (tile_) % NT_R; _Pragma("unroll") for (int i = 0; i < 8; ++i) dst[i] = *(const u32x4*)(YT + (size_t)(cb_ * 64 + 8 * i + (F_lane >> 3)) * NROWS + rb_ * 64 + 8 * (F_lane & 7)); } while (0)
    TY_LOAD(cur, gw);
    for (int tile = gw; tile < NTILES; tile += NGW) { const int cb = tile / NT_R, rb = tile % NT_R; const int c0 = cb * 64, r0 = rb * 64;
        const int tn = tile + NGW < NTILES ? tile + NGW : tile; TY_LOAD(nxt, tn);
#pragma unroll
        for (int i = 0; i < 8; ++i) *(LAS u32x4*)(t + (8 * i + (F_lane >> 3)) * 72 + 8 * (F_lane & 7)) = cur[i];
        LDS_WAIT(); asm volatile("" ::: "memory");
#pragma unroll
        for (int i = 0; i < 8; ++i) { const int r = 8 * i + (F_lane >> 3), cc = F_lane & 7; unsigned short e[8];
#pragma unroll
            for (int k = 0; k < 8; ++k) e[k] = t[(8 * cc + k) * 72 + r];
            u32x4 w; w.x = e[0] | ((unsigned)e[1] << 16); w.y = e[2] | ((unsigned)e[3] << 16); w.z = e[4] | ((unsigned)e[5] << 16); w.w = e[6] | ((unsigned)e[7] << 16);
            *(u32x4*)(YM + (size_t)(r0 + r) * DM + c0 + 8 * cc) = w; }
        LDS_WAIT(); asm volatile("" ::: "memory");
#pragma unroll
        for (int i = 0; i < 8; ++i) cur[i] = nxt[i];
    }
#undef TY_LOAD
}
constexpr int HY_UP = 8208;
constexpr int HY_G_OFF = 16 * HY_UP, HY_G_BYTES = 8192 * 2 + 32, HY_RED_OFF = HY_G_OFF + HY_G_BYTES;

#define LAUNDER(x) asm volatile("" : "+v"(x))
__device__ __forceinline__ void hy_load_filter(Frame& F, const float* HR, int order, int c, LAS unsigned short* GR, LAS float* red) {
    const int lane_ = lane_id();
    float v[16]; float s = 0.f; int tid = F.wave * 64 + lane_; LAUNDER(tid);
#pragma unroll
    for (int k = 0; k < 16; ++k) { const int i = tid + 512 * k; const int lag = 4096 - i; float val = 0.f;
        if (i >= 1) val = lag >= 0 ? HR[(size_t)(order * 512 + c) * 4096 + lag] : HR[(size_t)(1024 + order * 512 + c) * 4096 - lag];
        v[k] = val; s += fabsf(val); }
    s = wave_sum(s); if (lane_ == 0) red[F.wave] = s;
    __syncthreads();
    float S = 0.f;
#pragma unroll
    for (int w = 0; w < 8; ++w) S += red[w];
    const float inv = 1.f / (S + 1e-6f);
#pragma unroll
    for (int k = 0; k < 16; ++k) GR[tid + 512 * k] = (unsigned short)f2bf(v[k] * inv);
    __syncthreads();
}
__device__ __forceinline__ f32x4 sconv4(const bf16* up, int tb, int n, float w0, float w1, float w2, float bias) {
    const u32x2 w = *(const u32x2*)up; const float pv = tb > 0 ? bf2f(up[tb > 0 ? -1 : 0]) : 0.f, nx = tb + 4 < n ? bf2f(up[tb + 4 < n ? 4 : 0]) : 0.f;
    const float u0 = bflo(w.x), u1 = bfhi(w.x), u2 = bflo(w.y), u3 = bfhi(w.y);
    return (f32x4){w0 * pv + w1 * u0 + w2 * u1 + bias, w0 * u0 + w1 * u1 + w2 * u2 + bias, w0 * u1 + w1 * u2 + w2 * u3 + bias, w0 * u2 + w1 * u3 + w2 * nx + bias};
}
__device__ __forceinline__ void hy_half(f32x4 (&acc)[16], bf16x8 (&Bw)[8], unsigned (&x)[5], bf16x8& Btmp, const LAS unsigned char* xbase, const int xoff, const LAS unsigned char* bbase, const int boff, const unsigned sh,
                                        const int u, const int qlo, const int qhi, const int par, const bool binstall, const bool bprefetch, const bool xprefetch) {
    if (par == 0 && binstall) Bw[(8 - u) & 7] = Btmp;
    u32x4 w;
#pragma unroll
    for (int k = 0; k < 4; ++k) w[k] = __builtin_amdgcn_alignbit(x[k + 1], x[k], sh);
    const bf16x8 a = __builtin_bit_cast(bf16x8, w);
    if (xprefetch) {
#pragma unroll
        for (int k = 0; k < 5; ++k) x[k] = *(const LAS unsigned*)(xbase + xoff + 4 * k); }
    if (par == 0 && bprefetch) Btmp = *(const LAS bf16x8*)(bbase + boff);
    __builtin_amdgcn_sched_barrier(0);
#pragma unroll
    for (int q = 0; q < 8; ++q) if (q >= qlo && q <= qhi) { const int sl = (q - u) & 7;
        acc[2 * q + par] = __builtin_amdgcn_mfma_f32_16x16x32_bf16(a, Bw[sl], acc[2 * q + par], 0, 0, 0); }
    __builtin_amdgcn_sched_barrier(0);
}
__device__ __forceinline__ void hy_step(f32x4 (&acc)[16], bf16x8 (&Bw)[8], unsigned (&x)[5], bf16x8& Btmp, const LAS unsigned char* xbase, const int xoff, const LAS unsigned char* bbase, const int boff, const unsigned sh,
                                        const int u, const int qlo, const int qhi, const bool binstall, const bool bprefetch, const bool last) {
    hy_half(acc, Bw, x, Btmp, xbase, xoff - 32, bbase, boff, sh, u, qlo, qhi, 0, binstall, bprefetch, true);
    hy_half(acc, Bw, x, Btmp, xbase, xoff - 64, bbase, boff, sh, u, qlo, qhi, 1, false, false, !last);
}
template <int NJ, int UPITCH>
__device__ __forceinline__ void hy_conv_pass(f32x4 (&acc)[16], const LAS unsigned char* U, const LAS unsigned short* GR, int v, int lane_in) {
    int lane = lane_in; LAUNDER(lane); const int row = lane & 15, g = lane >> 4, r = row & 1;
    const unsigned sh = 16u * (unsigned)r;
    const LAS unsigned char* ub = U + row * UPITCH + g * 16;
    const LAS unsigned char* xa = (const LAS unsigned char*)GR + 2 * (32 * NJ - row + 8 * g - r) - 64 * (8 * v - (NJ - 1));
    const LAS unsigned char* bn = ub + (NJ - 2) * 64;
    bf16x8 Bw[8]; bf16x8 Btmp = *(const LAS bf16x8*)(ub + (NJ - 1) * 64); unsigned x[5];
#pragma unroll
    for (int i = 0; i < 8; ++i) Bw[i] = (bf16x8){0, 0, 0, 0, 0, 0, 0, 0};
#pragma unroll
    for (int k = 0; k < 5; ++k) x[k] = *(const LAS unsigned*)(xa + 4 * k);
    { const LAS unsigned char* xl = xa - 64 * 8; const LAS unsigned char* bl = bn - 64 * 7; asm volatile("" : "+v"(xl), "+v"(bl));
#pragma unroll
      for (int s = 0; s < 7; ++s) hy_step(acc, Bw, x, Btmp, xl, 64 * (8 - s), bl, 64 * (7 - s), sh, s + 1, 0, s, true, true, false);
      xa -= 64 * 7; bn -= 64 * 7; }
#pragma unroll 1
    for (int it = 0; it < (NJ - 8) / 8; ++it) {
        const LAS unsigned char* xl = xa - 64 * 8; const LAS unsigned char* bl = bn - 64 * 7; asm volatile("" : "+v"(xl), "+v"(bl));
#pragma unroll
        for (int u = 0; u < 8; ++u) hy_step(acc, Bw, x, Btmp, xl, 64 * (8 - u), bl, 64 * (7 - u), sh, u, 0, 7, true, true, false);
        xa -= 512; bn -= 512;
    }
    { const LAS unsigned char* xl = xa - 64 * 8; asm volatile("" : "+v"(xl));
      hy_step(acc, Bw, x, Btmp, xl, 64 * 8, ub, 0, sh, 0, 0, 7, true, false, false);
#pragma unroll
      for (int m = 1; m < 8; ++m) hy_step(acc, Bw, x, Btmp, xl, 64 * (8 - m), ub, 0, sh, m, m, 7, false, false, m == 7); }
}
__device__ __forceinline__ void hyena_latent_unit(Frame& F, const Args& a, int c) {
    const bf16* UT = (const bf16*)(F.ws + WS_BUF2); bf16* YT = (bf16*)(F.ws + WS_BUF4); const float* HR = (const float*)(F.ws + WS_HRAW);
    const int lane_ = lane_id(); const int tid_ = F.wave * 64 + lane_;
    LAS unsigned char* U = F.lds; LAS unsigned short* GR = (LAS unsigned short*)(F.lds + HY_G_OFF); LAS float* red = (LAS float*)(F.lds + HY_RED_OFF);
    const float* cw = a.in[I_HYCW]; const float* cb = a.in[I_HYCB]; const float* sk = a.in[I_HYSKIP];
#ifndef HYP
#define HYP 0
#endif
    hy_load_filter(F, HR, 0, c, GR, red);
    if (HYP == 1) { hy_load_filter(F, HR, 1, c, GR, red); hy_load_filter(F, HR, 0, c, GR, red); }
    for (int hyrep = 0; hyrep < (HYP == 2 ? 2 : 1); ++hyrep)
    {
        const float w0 = cw[c], w1 = cw[1536 + c], w2 = cw[3072 + c], bs = cb[c]; int tid = tid_; LAUNDER(tid);
        const int t8 = (tid & 511) * 8; const bf16* up0 = UT + (size_t)c * NROWS + CTXL + t8;
        u32x4 uw[16]; unsigned short upv[16], unx[16];
#pragma unroll
        for (int k = 0; k < 16; ++k) { const bf16* up = up0 + (size_t)k * RPB; uw[k] = *(const u32x4*)up; upv[k] = up[-1]; unx[k] = up[8]; }
#pragma unroll
        for (int k = 0; k < 16; ++k) {
            const float e0 = t8 > 0 ? bf2f(upv[k]) : 0.f, e9 = t8 + 8 < 4096 ? bf2f(unx[k]) : 0.f;
            const float e1 = bflo(uw[k].x), e2 = bfhi(uw[k].x), e3 = bflo(uw[k].y), e4 = bfhi(uw[k].y), e5 = bflo(uw[k].z), e6 = bfhi(uw[k].z), e7 = bflo(uw[k].w), e8 = bfhi(uw[k].w);
            u32x4 w; w.x = pk2(w0 * e0 + w1 * e1 + w2 * e2 + bs, w0 * e1 + w1 * e2 + w2 * e3 + bs); w.y = pk2(w0 * e2 + w1 * e3 + w2 * e4 + bs, w0 * e3 + w1 * e4 + w2 * e5 + bs);
            w.z = pk2(w0 * e4 + w1 * e5 + w2 * e6 + bs, w0 * e5 + w1 * e6 + w2 * e7 + bs); w.w = pk2(w0 * e6 + w1 * e7 + w2 * e8 + bs, w0 * e7 + w1 * e8 + w2 * e9 + bs);
            *(LAS u32x4*)(U + k * HY_UP + t8 * 2) = w; }
    }
    __syncthreads();
    u32x2 keep[2][16];
#pragma unroll
    for (int pass = 0; pass < 2; ++pass) {
        const int xoff = pass == 0 ? 512 : 1024;
        const float w0 = cw[xoff + c], w1 = cw[1536 + xoff + c], w2 = cw[3072 + xoff + c], bs = cb[xoff + c], skip = sk[pass * 512 + c];
#pragma unroll
        for (int sp = 0; sp < 2; ++sp) {
            const int v = 2 * F.wave + sp;
            unsigned pf0, pf1;
            { int lp = lane_; LAUNDER(lp); const bf16* pfp = UT + (size_t)(xoff + c) * NROWS + (lp & 15) * RPB + CTXL + 256 * v + (lp >> 4) * 32;
              pf0 = *(const unsigned*)pfp; pf1 = *(const unsigned*)(pfp + 128); }
            f32x4 acc[16];
#pragma unroll
            for (int i = 0; i < 16; ++i) acc[i] = (f32x4){0.f, 0.f, 0.f, 0.f};
#ifdef HY_DUP
            { hy_conv_pass<128, HY_UP>(acc, U, GR, v, lane_); f32x4 d = acc[0];
#pragma unroll
              for (int i = 1; i < 16; ++i) d = d + acc[i];
              asm volatile("" : "+v"(d) :: "memory");
#pragma unroll
              for (int i = 0; i < 16; ++i) acc[i] = d * 0.f; }
#endif
            hy_conv_pass<128, HY_UP>(acc, U, GR, v, lane_);
            asm volatile("" :: "v"(pf0), "v"(pf1) : "memory"); __builtin_amdgcn_sched_barrier(0);
            int ln = lane_; LAUNDER(ln); const int b = ln & 15, g = ln >> 4;
            const bf16* ux = UT + (size_t)(xoff + c) * NROWS + b * RPB + CTXL + 256 * v + 4 * g;
            for (int eprep = 0; eprep < (HYP == 3 ? 2 : 1); ++eprep)
#pragma unroll
            for (int tg = 0; tg < 4; ++tg) {
                u32x2 xw[4]; unsigned short xp[4], xn[4];
#pragma unroll
                for (int j = 0; j < 4; ++j) { const bf16* up = ux + 16 * (4 * tg + j); xw[j] = *(const u32x2*)up; xp[j] = up[-1]; xn[j] = up[4]; }
#pragma unroll
                for (int j = 0; j < 4; ++j) { const int ti = 4 * tg + j; const int tb = 256 * v + 16 * ti + 4 * g;
                    const float pv = tb > 0 ? bf2f(xp[j]) : 0.f, nx = tb + 4 < 4096 ? bf2f(xn[j]) : 0.f; const float u0 = bflo(xw[j].x), u1 = bfhi(xw[j].x), u2 = bflo(xw[j].y), u3 = bfhi(xw[j].y);
                    const f32x4 xx = (f32x4){w0 * pv + w1 * u0 + w2 * u1 + bs, w0 * u0 + w1 * u1 + w2 * u2 + bs, w0 * u1 + w1 * u2 + w2 * u3 + bs, w0 * u2 + w1 * u3 + w2 * nx + bs};
                    const u32x2 vw = *(const LAS u32x2*)(U + b * HY_UP + tb * 2); const f32x4 vv = (f32x4){bflo(vw.x), bfhi(vw.x), bflo(vw.y), bfhi(vw.y)};
                    const f32x4 res = xx * (acc[ti] + vv * skip); u32x2 w; w.x = pk2(res[0], res[1]); w.y = pk2(res[2], res[3]); keep[sp][ti] = w; }
                asm volatile("" : "+v"(keep[sp][4 * tg]), "+v"(keep[sp][4 * tg + 1]), "+v"(keep[sp][4 * tg + 2]), "+v"(keep[sp][4 * tg + 3]) :: "memory");
            }
        }
        __syncthreads();
        {   int ln = lane_; LAUNDER(ln); const int b = ln & 15, g = ln >> 4;
#pragma unroll
            for (int sp = 0; sp < 2; ++sp)
#pragma unroll
                for (int ti = 0; ti < 16; ++ti) { const int tb = 256 * (2 * F.wave + sp) + 16 * ti + 4 * g; *(LAS u32x2*)(U + b * HY_UP + tb * 2) = keep[sp][ti]; } }
        if (pass == 0) hy_load_filter(F, HR, 1, c, GR, red);
        else __syncthreads();
    }
    int tid3 = tid_; LAUNDER(tid3);
#pragma unroll 2
    for (int k = 0; k < 16; ++k) { const int q = tid3 + 512 * k, bb = q >> 9, t8 = (q & 511) * 8; const u32x4 w = *(const LAS u32x4*)(U + bb * HY_UP + t8 * 2);
        *(u32x4*)(YT + (size_t)c * NROWS + bb * RPB + CTXL + t8) = w; }
    __syncthreads();
}
constexpr int HC_UP = 528, HC_G_OFF = 16 * HC_UP, HC_WAVE_BYTES = HC_G_OFF + 1024 + 64;
__device__ __forceinline__ void hc_load_filter(const float* HR, int order, int c, LAS unsigned short* GR, int lane) {
    float v[8]; float s = 0.f;
#pragma unroll
    for (int k = 0; k < 8; ++k) { const int i = lane + 64 * k; const int lag = 256 - i; float val = 0.f;
        if (i >= 1) val = lag >= 0 ? HR[(size_t)(order * 512 + c) * 256 + lag] : HR[(size_t)(1024 + order * 512 + c) * 256 - lag];
        v[k] = val; s += fabsf(val); }
    const float inv = 1.f / (wave_sum(s) + 1e-6f);
#pragma unroll
    for (int k = 0; k < 8; ++k) GR[lane + 64 * k] = (unsigned short)f2bf(v[k] * inv);
    LDS_WAIT(); asm volatile("" ::: "memory");
}
__device__ __forceinline__ void hyena_ctx_wave(Frame& F, const Args& a, int c) {
    const bf16* UT = (const bf16*)(F.ws + WS_BUF2); bf16* YT = (bf16*)(F.ws + WS_BUF4); const float* HR = (const float*)(F.ws + WS_HRAWC);
    const int lane = lane_id();
    LAS unsigned char* U = F.lds + F.wave * HC_WAVE_BYTES; LAS unsigned short* GR = (LAS unsigned short*)(U + HC_G_OFF);
    const float* cw = a.in[I_HYCW]; const float* cb = a.in[I_HYCB]; const float* sk = a.in[I_HYSKIP];
    hc_load_filter(HR, 0, c, GR, lane);
    {   const float w0 = cw[c], w1 = cw[1536 + c], w2 = cw[3072 + c], bs = cb[c];
#pragma unroll 2
        for (int k = 0; k < 8; ++k) { const int q = lane + 64 * k, b = q >> 5, t8 = (q & 31) * 8; const bf16* up = UT + (size_t)c * NROWS + b * RPB + t8;
            const u32x4 uw = *(const u32x4*)up; const float e0 = t8 > 0 ? bf2f(up[-1]) : 0.f, e9 = t8 + 8 < 256 ? bf2f(up[8]) : 0.f;
            const float e1 = bflo(uw.x), e2 = bfhi(uw.x), e3 = bflo(uw.y), e4 = bfhi(uw.y), e5 = bflo(uw.z), e6 = bfhi(uw.z), e7 = bflo(uw.w), e8 = bfhi(uw.w);
            u32x4 w; w.x = pk2(w0 * e0 + w1 * e1 + w2 * e2 + bs, w0 * e1 + w1 * e2 + w2 * e3 + bs); w.y = pk2(w0 * e2 + w1 * e3 + w2 * e4 + bs, w0 * e3 + w1 * e4 + w2 * e5 + bs);
            w.z = pk2(w0 * e4 + w1 * e5 + w2 * e6 + bs, w0 * e5 + w1 * e6 + w2 * e7 + bs); w.w = pk2(w0 * e6 + w1 * e7 + w2 * e8 + bs, w0 * e7 + w1 * e8 + w2 * e9 + bs);
            *(LAS u32x4*)(U + b * HC_UP + t8 * 2) = w; }
        LDS_WAIT(); asm volatile("" ::: "memory");
    }
    const int b = lane & 15, g = lane >> 4;
#pragma unroll
    for (int pass = 0; pass < 2; ++pass) {
        const int xoff = pass == 0 ? 512 : 1024;
        const float w0 = cw[xoff + c], w1 = cw[1536 + xoff + c], w2 = cw[3072 + xoff + c], bs = cb[xoff + c], skip = sk[pass * 512 + c];
        f32x4 acc[16];
#pragma unroll
        for (int i = 0; i < 16; ++i) acc[i] = (f32x4){0.f, 0.f, 0.f, 0.f};
        hy_conv_pass<8, HC_UP>(acc, U, GR, 0, lane);
        const bf16* ux = UT + (size_t)(xoff + c) * NROWS + b * RPB + 4 * g;
        u32x2 keep[16];
#pragma unroll
        for (int ti = 0; ti < 16; ++ti) { const int tb = 16 * ti + 4 * g; const bf16* up = ux + 16 * ti; const u32x2 xw = *(const u32x2*)up;
            const float pv = tb > 0 ? bf2f(up[-1]) : 0.f, nx = tb + 4 < 256 ? bf2f(up[4]) : 0.f; const float u0 = bflo(xw.x), u1 = bfhi(xw.x), u2 = bflo(xw.y), u3 = bfhi(xw.y);
            const f32x4 xx = (f32x4){w0 * pv + w1 * u0 + w2 * u1 + bs, w0 * u0 + w1 * u1 + w2 * u2 + bs, w0 * u1 + w1 * u2 + w2 * u3 + bs, w0 * u2 + w1 * u3 + w2 * nx + bs};
            const u32x2 vw = *(const LAS u32x2*)(U + b * HC_UP + tb * 2); const f32x4 vv = (f32x4){bflo(vw.x), bfhi(vw.x), bflo(vw.y), bfhi(vw.y)};
            const f32x4 res = xx * (acc[ti] + vv * skip); keep[ti].x = pk2(res[0], res[1]); keep[ti].y = pk2(res[2], res[3]); }
        if (pass == 0) {
            LDS_WAIT(); asm volatile("" ::: "memory");
#pragma unroll
            for (int ti = 0; ti < 16; ++ti) *(LAS u32x2*)(U + b * HC_UP + (16 * ti + 4 * g) * 2) = keep[ti];
            hc_load_filter(HR, 1, c, GR, lane);
        } else {
#pragma unroll
            for (int ti = 0; ti < 16; ++ti) *(u32x2*)(YT + (size_t)c * NROWS + b * RPB + 16 * ti + 4 * g) = keep[ti];
        }
    }
    LDS_WAIT(); asm volatile("" ::: "memory");
}

__global__ void __launch_bounds__(NTHR, 2) fwd_kernel(Args args) {
    extern __shared__ __attribute__((aligned(16))) unsigned char lds_raw[];
    Frame F; F.lds = (LAS unsigned char*)lds_raw; F.wave = __builtin_amdgcn_readfirstlane((int)threadIdx.x >> 6); F.G = gridDim.x; F.bid = blockIdx.x;
    F.ws = args.ws; F.ctl = (gu32*)(args.ws + WS_CTL);
    unsigned char* ws = args.ws;
    volatile LAS unsigned* MISC = (volatile LAS unsigned*)(F.lds + MISC_OFF);
    { const int l0 = lane_id(); if (F.wave == 0) MISC[l0] = 0u; }
    __syncthreads();
    XcdBarrier bar; bar.bar = (unsigned*)(F.ctl + CW_BAR); bar.x = 0; bar.st = nullptr;
    if (args.one_launch) bar = xcd_barrier_post((unsigned*)(F.ctl + CW_BAR), MISC + 8, F.wave == 0 && lane_id() == 0);
    const int lo = args.ph_lo, hi = args.ph_hi;
#ifndef PHASE_MASK
#define PHASE_MASK 0xFFFFFFFFu
#endif
#define IN(k) ((((PHASE_MASK) >> (k)) & 1u) && lo <= (k) && (k) < hi)
#ifndef REP_PHASE
#define REP_PHASE -1
#endif
#ifndef REP_PART
#define REP_PART 3
#endif
#define PH(k, ...) if (IN(k)) { __VA_ARGS__ } if (REP_PHASE == (k) && IN(k)) { __VA_ARGS__ }
#define SEAM(k) do { if (IN(k) && IN((k) + 1)) xcd_barrier(bar, F.wave == 0 && lane_id() == 0); } while (0)
    const float* MOD0 = (const float*)(ws + WS_MOD); const float* MOD1 = MOD0 + 17 * 6144;
    LAS unsigned char* ring = F.lds;

    PH(0,  p0_prologue(F, args);) SEAM(0);
    PH(1,  p_norm1_l0(F, args);) SEAM(1);
    PH(2,
        { pg8::SchedInProj S{(const char*)(ws + WS_BUF1), (const char*)(ws + WS_WHY), (const char*)(ws + WS_WATT0), F.G, F.bid};
          pg8::EpiInProj E{pg8::EpiBf16{(bf16*)(ws + WS_BUF2), NROWS}, pg8::EpiQkv<0>{(bf16*)(ws + WS_BUF3), D_ATT0, (const f32x2*)(ws + WS_ROPE), nullptr, nullptr}};
          pg8::gemm_phase<pg8::EpiInProj, pg8::SchedInProj, true>(ring, 1024, S, E, F.wave);
          { const int busy = 9 * 272 - (9 * 272 / F.G) * F.G; if (busy > 0 && busy < F.G && F.bid >= busy) p_filter_stage_b(F, args, F.bid - busy, F.G - busy); else if (busy == 0 || busy >= F.G) p_filter_stage_b(F, args, F.bid, F.G); __syncthreads(); } }
    ) SEAM(2);
#define P3_HY do { for (int c = F.bid; c < HYC; c += F.G) hyena_latent_unit(F, args, c); for (int c = F.bid + F.G * F.wave; c < HYC; c += F.G * NWAVES) hyena_ctx_wave(F, args, c); __syncthreads(); } while (0)
#define P3_AT do { const attn_body::bf16* QKV = (const attn_body::bf16*)(ws + WS_BUF3); attn_body::bf16* YM = (attn_body::bf16*)(ws + WS_BUF1); \
        for (int L = F.bid; L < 2048 + 128; L += F.G) { \
            if (L < 2048) { const int b = L >> 7, h = (L >> 4) & 7, qb = L & 15, q0 = qb * 256; const int lat0 = q0 >= 128 ? q0 - 128 : 0; const int lend = q0 + 384 < SEQ ? q0 + 384 : SEQ; const int NT = 4 + (lend - lat0) / 64; \
                const attn_body::bf16* base = QKV + (size_t)b * RPB * D_ATT0; \
                attn_body::attn_unit<1, D_ATT0, D_ATT0, DM, 8>(base + (size_t)(CTXL + q0) * D_ATT0 + h * 64, base + 512 + (h >> 2) * 64, base + 640 + (h >> 2) * 64, \
                    YM + ((size_t)b * RPB + CTXL + q0) * DM + 512 + h * 64, NT, lat0, q0, args.in[I_SINK][h] * LOG2E, (char*)lds_raw, F.wave); } \
            else { const int r = L - 2048, b = r >> 3, h = r & 7; const attn_body::bf16* base = QKV + (size_t)b * RPB * D_ATT0; \
                attn_body::attn_unit<0, D_ATT0, D_ATT0, DM, 8>(base + h * 64, base + 512 + (h >> 2) * 64, base + 640 + (h >> 2) * 64, \
                    YM + (size_t)b * RPB * DM + 512 + h * 64, 4, 0, 0, args.in[I_SINK][h] * LOG2E, (char*)lds_raw, F.wave); } } } while (0)
    if (IN(3)) {
        P3_HY; if (REP_PHASE == 3 && (REP_PART & 1)) { P3_HY; }
    } SEAM(3);
    if (IN(4)) { if (F.bid & 1) { p_transpose_y(F); __syncthreads(); } P3_AT; if (REP_PHASE == 4) { P3_AT; } if (!(F.bid & 1)) { __syncthreads(); p_transpose_y(F); } } SEAM(4);
    PH(5,
        pg8::SchedDense S; S.init(ws + WS_BUF1, ws + WS_WOUT0, NROWS, 1024, 1024, F.G, F.bid);
        pg8::EpiOut E{(bf16*)(ws + WS_Y), MOD0};
        pg8::gemm_phase<pg8::EpiOut, pg8::SchedDense, true>(ring, 1024, S, E, F.wave);
        { const int nu = 272 * 4; const int busy = nu - (nu / F.G) * F.G; if (busy > 0 && F.bid >= busy) weight_items(F, args, W_ITEMS_L1MOE, W_ITEMS_L1MOE + (W_ITEMS_ALL - W_ITEMS_L1MOE) / 3, F.bid - busy, F.G - busy); else if (busy == 0) weight_items(F, args, W_ITEMS_L1MOE, W_ITEMS_L1MOE + (W_ITEMS_ALL - W_ITEMS_L1MOE) / 3, F.bid, F.G); __syncthreads(); }) SEAM(5);
    PH(6,  p_norm2_route<0>(F, args);) SEAM(6);
    PH(7,
        LAS int* tab = (LAS int*)(F.lds + pg8::STAGE_BYTES); moe_tab(F, tab, 0);
        pg8::SchedMoe<true> S{(const char*)(ws + WS_BUF1), (const char*)(ws + WS_WGU), (size_t)1024 * 1024 * 2, 1024, tab, (const int*)(ws + WS_TOKIDX), F.G, F.bid};
        pg8::EpiGateUp E{(bf16*)(ws + WS_BUF5)};
        pg8::gemm_phase<pg8::EpiGateUp, pg8::SchedMoe<true>, true>(ring, 1024, S, E, F.wave);) SEAM(7);
    PH(8,
        LAS int* tab = (LAS int*)(F.lds + pg8::STAGE_BYTES); moe_tab(F, tab, 0);
        pg8::SchedMoe<false> S{(const char*)(ws + WS_BUF5), (const char*)(ws + WS_WDN), (size_t)1024 * 512 * 2, 512, tab, nullptr, F.G, F.bid};
        pg8::EpiDown E{(bf16*)(ws + WS_BUF2), (const float*)(ws + WS_GATE), tab};
        pg8::gemm_phase<pg8::EpiDown, pg8::SchedMoe<false>, true>(ring, 512, S, E, F.wave);) SEAM(8);
    PH(9,  p_combine<0>(F, args);) SEAM(9);
    PH(10,
        pg8::SchedQkv1 S{(const char*)(ws + WS_BUF1), (const char*)(ws + WS_WQKV1), 1024, F.G, F.bid};
        pg8::EpiQkv<1> E{(bf16*)(ws + WS_BUF2), D_QKV1, (const f32x2*)(ws + WS_ROPE), args.in[I_ODQG], args.in[I_ODKG]};
        pg8::gemm_phase<pg8::EpiQkv<1>, pg8::SchedQkv1, true>(ring, 1024, S, E, F.wave);
        { const int nu = 256 * 6 + 32; const int busy = nu - (nu / F.G) * F.G; if (busy > 0 && F.bid >= busy) weight_items(F, args, W_ITEMS_L1MOE + (W_ITEMS_ALL - W_ITEMS_L1MOE) / 3, W_ITEMS_ALL, F.bid - busy, F.G - busy); else if (busy == 0) weight_items(F, args, W_ITEMS_L1MOE + (W_ITEMS_ALL - W_ITEMS_L1MOE) / 3, W_ITEMS_ALL, F.bid, F.G); __syncthreads(); }) SEAM(10);
    PH(11,
        const attn_body::bf16* QKV = (const attn_body::bf16*)(ws + WS_BUF2); attn_body::bf16* AO = (attn_body::bf16*)(ws + WS_BUF1);
        float gqm = 0.f, gkm = 0.f; for (int d = 0; d < 64; ++d) { gqm = fmaxf(gqm, fabsf(args.in[I_ODQG][d])); gkm = fmaxf(gkm, fabsf(args.in[I_ODKG][d])); }
        const float m0 = 64.f * gqm * gkm * QSCALE * 1.02f;
        if (m0 <= 40.f) {
        for (int L = F.bid; L < 4096; L += F.G) { const int b = L >> 8, h = (L >> 4) & 15, qb = L & 15, q0 = qb * 256; const attn_body::bf16* base = QKV + (size_t)b * RPB * D_QKV1;
            attn_body::attn_unit<0, D_QKV1, D_QKV1, DM, 8, true>(base + (size_t)(CTXL + q0) * D_QKV1 + h * 64, base + 1024 + (h >> 2) * 64, base + 1280 + (h >> 2) * 64,
                AO + ((size_t)b * RPB + CTXL + q0) * DM + h * 64, 68, 0, 0, -INFINITY, (char*)lds_raw, F.wave, m0); }
        } else {
        for (int L = F.bid; L < 4096; L += F.G) { const int b = L >> 8, h = (L >> 4) & 15, qb = L & 15, q0 = qb * 256; const attn_body::bf16* base = QKV + (size_t)b * RPB * D_QKV1;
            attn_body::attn_unit<0, D_QKV1, D_QKV1, DM, 8, false>(base + (size_t)(CTXL + q0) * D_QKV1 + h * 64, base + 1024 + (h >> 2) * 64, base + 1280 + (h >> 2) * 64,
                AO + ((size_t)b * RPB + CTXL + q0) * DM + h * 64, 68, 0, 0, -INFINITY, (char*)lds_raw, F.wave); }
        }
    ) SEAM(11);
    PH(12,
        pg8::SchedLat S{(const char*)(ws + WS_BUF1), (const char*)(ws + WS_WOUT1), 1024, 4, F.G, F.bid};
        pg8::EpiOut E{(bf16*)(ws + WS_Y), MOD1};
        pg8::gemm_phase<pg8::EpiOut, pg8::SchedLat, true>(ring, 1024, S, E, F.wave);) SEAM(12);
    PH(13,  p_norm2_route<1>(F, args);) SEAM(13);
    PH(14,
        LAS int* tab = (LAS int*)(F.lds + pg8::STAGE_BYTES); moe_tab(F, tab, 1);
        pg8::SchedMoe<true> S{(const char*)(ws + WS_BUF1), (const char*)(ws + WS_WGU) + (size_t)32 * 1024 * 1024 * 2, (size_t)1024 * 1024 * 2, 1024, tab, (const int*)(ws + WS_TOKIDX), F.G, F.bid};
        pg8::EpiGateUp E{(bf16*)(ws + WS_BUF5)};
        pg8::gemm_phase<pg8::EpiGateUp, pg8::SchedMoe<true>, true>(ring, 1024, S, E, F.wave);) SEAM(14);
    PH(15,
        LAS int* tab = (LAS int*)(F.lds + pg8::STAGE_BYTES); moe_tab(F, tab, 1);
        pg8::SchedMoe<false> S{(const char*)(ws + WS_BUF5), (const char*)(ws + WS_WDN) + (size_t)32 * 1024 * 512 * 2, (size_t)1024 * 512 * 2, 512, tab, nullptr, F.G, F.bid};
        pg8::EpiDown E{(bf16*)(ws + WS_BUF2), (const float*)(ws + WS_GATE), tab};
        pg8::gemm_phase<pg8::EpiDown, pg8::SchedMoe<false>, true>(ring, 512, S, E, F.wave);) SEAM(15);
    PH(16, p_combine<1>(F, args);)

#undef IN
#undef SEAM
}

constexpr int N_PHASES = 17;
#ifndef MK_ONE_LAUNCH
#define MK_ONE_LAUNCH 1
#endif
extern "C" void kernel_launch(void* const* d_in, const int* in_sizes, int n_in, void* d_out, int out_size, void* d_ws, size_t ws_size, hipStream_t stream) {
    static int grid = 0;
    if (grid == 0) {
        if (n_in != 32 || out_size != NB * SEQ * DM || ws_size < WS_END) { fprintf(stderr, "kernel_launch: unexpected problem (n_in %d out %d ws %zu, need ws %zu)\n", n_in, out_size, ws_size, (size_t)WS_END); grid = -1; return; }
        int dev = 0, cus = 0, per_cu = 0;
        if (hipGetDevice(&dev) != hipSuccess || hipDeviceGetAttribute(&cus, hipDeviceAttributeMultiprocessorCount, dev) != hipSuccess) { grid = -1; return; }
        if (hipFuncSetAttribute((const void*)fwd_kernel, hipFuncAttributeMaxDynamicSharedMemorySize, LDS_BYTES) != hipSuccess) { fprintf(stderr, "kernel_launch: hipFuncSetAttribute failed\n"); grid = -1; return; }
        if (hipOccupancyMaxActiveBlocksPerMultiprocessor(&per_cu, (const void*)fwd_kernel, NTHR, LDS_BYTES) != hipSuccess || per_cu < 1) fprintf(stderr, "kernel_launch: occupancy query says %d\n", per_cu);
        (void)hipGetLastError();
        grid = cus;
    }
    if (grid < 0) return;
    (void)hipMemsetAsync((char*)d_ws + WS_CTL, 0, CTL_ZERO_BYTES, stream);
    Args a{};
    for (int i = 0; i < 32; ++i) a.in[i] = (const float*)d_in[i];
    a.out = (float*)d_out; a.ws = (unsigned char*)d_ws; a.pad = 0;
    if (MK_ONE_LAUNCH) { a.ph_lo = 0; a.ph_hi = N_PHASES; a.one_launch = 1; hipLaunchKernelGGL(fwd_kernel, dim3(grid), dim3(NTHR), LDS_BYTES, stream, a); }
    else for (int p = 0; p < N_PHASES; ++p) { a.ph_lo = p; a.ph_hi = p + 1; a.one_launch = 0; hipLaunchKernelGGL(fwd_kernel, dim3(grid), dim3(NTHR), LDS_BYTES, stream, a); }
}
```

```cpp
#include <hip/hip_runtime.h>
#include <hip/hip_bf16.h>
#include <cstdio>
#include <cstdint>
#include <cmath>

#define GAS __attribute__((address_space(1)))
#define LAS __attribute__((address_space(3)))
typedef unsigned short bf16;
typedef unsigned short bf16_t;
typedef short bf16x8 __attribute__((ext_vector_type(8)));
typedef short s16x4 __attribute__((ext_vector_type(4)));
typedef float f32x2 __attribute__((ext_vector_type(2)));
typedef float f32x4 __attribute__((ext_vector_type(4)));
typedef float f32x16 __attribute__((ext_vector_type(16)));
typedef unsigned u32x2 __attribute__((ext_vector_type(2)));
typedef unsigned u32x4 __attribute__((ext_vector_type(4)));
typedef unsigned v4u __attribute__((ext_vector_type(4)));
typedef GAS unsigned gu32;

constexpr int NB = 16, SEQ = 4096, CTXL = 256, DM = 1024, RPB = SEQ + CTXL  , NROWS = NB * RPB  ;
constexpr int HYC = 512, HD = 64, NEXP = 32, DEXP = 512, NMOD = 6;
constexpr int D_IN_EVEN = 2304, D_ATT0 = 768, D_QKV1 = 1536;
constexpr float NORM_EPS = 1e-6f;
constexpr float LOG2E = 1.4426950408889634f;
constexpr float QSCALE = 0.125f * 1.4426950408889634f;
constexpr int CAP = NROWS;
constexpr int MAXSLOTS = 147456;

constexpr size_t MiB = 1u << 20;
constexpr size_t WS_CTL = 0, CTL_ZERO_BYTES = 1 * MiB;
constexpr size_t WS_MOD = 1 * MiB;
constexpr size_t WS_ROPE = 2 * MiB;
constexpr size_t WS_HD2 = 2 * MiB + 65536;
constexpr size_t WS_ROUTE = 3 * MiB + 512 * 1024;
constexpr size_t WS_TOKIDX = 5 * MiB;
constexpr size_t WS_GATE = 14 * MiB;
constexpr size_t WS_HRAW = 23 * MiB;
constexpr size_t WS_HRAWC = 55 * MiB;
constexpr size_t WS_WHY = 57 * MiB;
constexpr size_t WS_WATT0 = 60 * MiB;
constexpr size_t WS_WOUT0 = 62 * MiB;
constexpr size_t WS_WQKV1 = 64 * MiB;
constexpr size_t WS_WOUT1 = 67 * MiB;
constexpr size_t WS_WGU = 69 * MiB;
constexpr size_t WS_WDN = 197 * MiB;
constexpr size_t WS_XC = 261 * MiB;
constexpr size_t WS_BUF1 = 277 * MiB;
constexpr size_t WS_BUF2 = 413 * MiB;
constexpr size_t WS_BUF3 = 617 * MiB;
constexpr size_t WS_BUF5 = 719 * MiB;
constexpr size_t WS_BUF4 = 863 * MiB;
constexpr size_t WS_Y = 863 * MiB;
constexpr size_t WS_END = 999 * MiB;
static_assert(WS_BUF2 + (size_t)MAXSLOTS * 1024 * 2 <= WS_BUF5, "MOUT fits BUF2+BUF3");
constexpr int CW_TMO = 0, CW_CODE = 1;
constexpr int CW_CNT = 1024;
constexpr int CW_BAR = 4096;

constexpr int LDS_BYTES = 160 * 1024 - 256;
constexpr int MISC_OFF = LDS_BYTES - 256;

#define RLX_AGENT __ATOMIC_RELAXED, __HIP_MEMORY_SCOPE_AGENT
#define LDS_WAIT() asm volatile("s_waitcnt lgkmcnt(0)" ::: "memory")
#define VM_WAIT() asm volatile("s_waitcnt vmcnt(0)" ::: "memory")
__device__ __forceinline__ unsigned f2bf(float f) { unsigned u = __builtin_bit_cast(unsigned, f); return (u + 0x7fffu + ((u >> 16) & 1u)) >> 16; }
typedef float f32x2_t_ __attribute__((ext_vector_type(2))); typedef __bf16 bf16x2_t_ __attribute__((ext_vector_type(2)));
__device__ __forceinline__ unsigned pk2(float lo, float hi) { f32x2_t_ v = {lo, hi}; bf16x2_t_ b = __builtin_convertvector(v, bf16x2_t_); return __builtin_bit_cast(unsigned, b); }
__device__ __forceinline__ float bf2f(unsigned short b) { return __builtin_bit_cast(float, (unsigned)b << 16); }
__device__ __forceinline__ float bflo(unsigned w) { return __builtin_bit_cast(float, w << 16); }
__device__ __forceinline__ float bfhi(unsigned w) { return __builtin_bit_cast(float, w & 0xffff0000u); }
__device__ __forceinline__ unsigned cvt_pk_bf16(float lo, float hi) { unsigned r; asm volatile("v_cvt_pk_bf16_f32 %0, %1, %2" : "=v"(r) : "v"(lo), "v"(hi)); return r; }
__device__ __forceinline__ float wave_sum(float v) {
#pragma unroll
    for (int o = 1; o < 64; o <<= 1) v += __shfl_xor(v, o);
    return v;
}
__device__ __forceinline__ int lane_id() { unsigned z = 0u; asm volatile("" : "+s"(z)); return (int)__builtin_amdgcn_mbcnt_hi(~0u, __builtin_amdgcn_mbcnt_lo(~0u, z)); }
__device__ __forceinline__ float silu_f(float x) { return x / (1.f + __expf(-x)); }
namespace pg8 {
constexpr int BM = 256, BK = 64, HALF = 128, HTB = HALF * BK * 2  , STAGE_BYTES = 8 * HTB, NXCD = 8, WGM = 8;
__host__ __device__ __forceinline__ int lds_byte(int r, int c) { const int st = (r >> 4) * 2 + (c >> 5), rr = r & 15, cc = c & 31, ob = rr * 64 + cc * 2; return st * 1024 + (ob ^ (((ob >> 9) & 1) << 5)); }
__host__ __device__ __forceinline__ void stage_rc(int b, int& R, int& C) { const int st = b / 1024, sb = b % 1024, swz = sb ^ (((sb >> 9) & 1) << 5); R = (st >> 1) * 16 + swz / 64; C = (st & 1) * 32 + (swz % 64) / 2; }
__host__ __device__ __forceinline__ int perm32(int rho) { const int n = rho >> 4, i = rho & 15; return 8 * (i >> 2) + 4 * n + (i & 3); }

struct Unit { int pm, pn, e, aux; };

template <class Epi, class Sched, bool ALIGN_EPI = false>
__device__ __forceinline__ void gemm_phase(LAS unsigned char* lds, const int K, const Sched& S, const Epi& E, const int wave_id) {
    const int wid = wave_id, lane = lane_id(), tid = wid * 64 + lane, wr = wid >> 2, wc = wid & 3, fr = lane & 15, fq = lane >> 4;
    const int nt = K / BK;
    int R0, C0, R1, C1; stage_rc(tid * 16, R0, C0); stage_rc(tid * 16 + 8192, R1, C1);
    unsigned voffB[2];
    voffB[0] = (unsigned)(((R0 & ~31) + perm32(R0 & 31)) * K + C0) * 2u; voffB[1] = (unsigned)(((R1 & ~31) + perm32(R1 & 31)) * K + C1) * 2u;
    const size_t kstep = (size_t)(BK * 2);
    const size_t hstep = (size_t)HALF * K * 2;
    const unsigned ldsw = (unsigned)wid * 1024u;
    const int aoff = lds_byte(wr * 64 + fr, fq * 8), boff = lds_byte(wc * 32 + fr, fq * 8);
#define PG8_SA(b, h) (((b) * 2 + (h)) * HTB)
#define PG8_SB(b, h) ((4 + (b) * 2 + (h)) * HTB)
#define PG8_STAGE2(bufoff, gbase, v0, v1) do { \
        __builtin_amdgcn_global_load_lds((const unsigned*)((const char*)(gbase) + (v0)), (LAS unsigned*)(lds + (bufoff) + ldsw), 16, 0, 0); \
        __builtin_amdgcn_global_load_lds((const unsigned*)((const char*)(gbase) + (v1)), (LAS unsigned*)(lds + (bufoff) + ldsw + 8192), 16, 0, 0); } while (0)
#define PG8_STAGEB(bufoff, gbase) PG8_STAGE2(bufoff, gbase, voffB[0], voffB[1])
#define PG8_LDA(dst, b, h) do { _Pragma("unroll") for (int m = 0; m < 4; ++m) _Pragma("unroll") for (int k = 0; k < 2; ++k) dst[m][k] = *(const LAS bf16x8*)(lds + PG8_SA(b, h) + aoff + m * 2048 + k * 1024); } while (0)
#define PG8_LDB(dst, b, h) do { _Pragma("unroll") for (int n = 0; n < 2; ++n) _Pragma("unroll") for (int k = 0; k < 2; ++k) dst[n][k] = *(const LAS bf16x8*)(lds + PG8_SB(b, h) + boff + n * 2048 + k * 1024); } while (0)
#define PG8_MMA(ai, bj, At, Bt) do { __builtin_amdgcn_s_setprio(1); _Pragma("unroll") for (int m = 0; m < 4; ++m) _Pragma("unroll") for (int n = 0; n < 2; ++n) _Pragma("unroll") for (int k = 0; k < 2; ++k) \
        acc[ai][bj][m][n] = __builtin_amdgcn_mfma_f32_16x16x32_bf16(Bt[n][k], At[m][k], acc[ai][bj][m][n], 0, 0, 0); __builtin_amdgcn_s_setprio(0); } while (0)
#define PG8_WAIT_V(n) asm volatile("s_waitcnt vmcnt(" #n ")" ::: "memory")
#define PG8_WAIT_L(n) asm volatile("s_waitcnt lgkmcnt(" #n ")" ::: "memory")
#define PG8_BAR __builtin_amdgcn_s_barrier()
#define PG8_SCHED __builtin_amdgcn_sched_barrier(0)
    Unit cur, nxt; int ui = 0;
    if (!S.next(0, cur)) return;
    f32x4 acc[2][2][4][2];
#pragma unroll
    for (int a = 0; a < 2; ++a)
#pragma unroll
        for (int b = 0; b < 2; ++b)
#pragma unroll
            for (int m = 0; m < 4; ++m)
#pragma unroll
                for (int n = 0; n < 2; ++n) acc[a][b][m][n] = (f32x4){0.f, 0.f, 0.f, 0.f};
    bf16x8 At[4][2], B0[2][2], B1[2][2];
    unsigned cv00, cv01, cv10, cv11, nv00, nv01, nv10, nv11;
    if constexpr (Sched::GATHER) { int r0, r1, r2, r3; S.a_rows(cur, R0, R1, r0, r1, r2, r3);
        cv00 = (unsigned)(r0 * K + C0) * 2u; cv01 = (unsigned)(r1 * K + C1) * 2u; cv10 = (unsigned)(r2 * K + C0) * 2u; cv11 = (unsigned)(r3 * K + C1) * 2u;
    } else { cv00 = (unsigned)(R0 * K + C0) * 2u; cv01 = (unsigned)(R1 * K + C1) * 2u; cv10 = cv00 + (unsigned)hstep; cv11 = cv01 + (unsigned)hstep; }
    nv00 = cv00; nv01 = cv01; nv10 = cv10; nv11 = cv11;
    const char* cA = S.a_base(cur); const char* cB = S.b_base(cur);
    PG8_STAGEB(PG8_SB(0, 0), cB); PG8_STAGEB(PG8_SB(0, 1), cB + hstep); PG8_STAGE2(PG8_SA(0, 0), cA, cv00, cv01); PG8_STAGE2(PG8_SA(0, 1), cA, cv10, cv11);
    if (wr == 1) PG8_BAR;
    PG8_WAIT_V(2); PG8_BAR;
    PG8_STAGEB(PG8_SB(1, 0), cB + kstep); PG8_STAGE2(PG8_SA(1, 0), cA + kstep, cv00, cv01); PG8_STAGEB(PG8_SB(1, 1), cB + hstep + kstep);
    PG8_WAIT_V(6); PG8_BAR;
    for (;;) {
        const bool has_next = S.next(ui + 1, nxt);
        const char* nA = has_next ? S.a_base(nxt) : cA; const char* nB = has_next ? S.b_base(nxt) : cB;
        if constexpr (Sched::GATHER) { if (has_next) { int r0, r1, r2, r3; S.a_rows(nxt, R0, R1, r0, r1, r2, r3);
            nv00 = (unsigned)(r0 * K + C0) * 2u; nv01 = (unsigned)(r1 * K + C1) * 2u; nv10 = (unsigned)(r2 * K + C0) * 2u; nv11 = (unsigned)(r3 * K + C1) * 2u; } else { nv00 = cv00; nv01 = cv01; nv10 = cv10; nv11 = cv11; } }
        for (int t = 0; t < nt; t += 2) {
            const bool last = (t == nt - 2);
            const char* a1 = cA + (size_t)(t + 1) * kstep;
            const char* a2 = last ? nA : cA + (size_t)(t + 2) * kstep; const char* b2 = last ? nB : cB + (size_t)(t + 2) * kstep;
            const char* a3 = a2 + kstep; const char* b3 = b2 + kstep;
            unsigned s00 = cv00, s01 = cv01, s10 = cv10, s11 = cv11;
            if constexpr (Sched::GATHER) { if (last) { s00 = nv00; s01 = nv01; s10 = nv10; s11 = nv11; } }
            PG8_LDB(B0, 0, 0); PG8_LDB(B1, 0, 1); PG8_SCHED; PG8_LDA(At, 0, 0); PG8_STAGE2(PG8_SA(1, 1), a1, cv10, cv11);
            PG8_WAIT_V(8); PG8_WAIT_L(0); PG8_BAR; PG8_MMA(0, 0, At, B0); PG8_MMA(0, 1, At, B1); PG8_BAR; PG8_SCHED;
            PG8_LDA(At, 0, 1); PG8_STAGEB(PG8_SB(0, 0), b2); PG8_STAGEB(PG8_SB(0, 1), b2 + hstep); PG8_STAGE2(PG8_SA(0, 0), a2, s00, s01);
            PG8_WAIT_V(8); PG8_WAIT_L(0); PG8_BAR; PG8_MMA(1, 0, At, B0); PG8_MMA(1, 1, At, B1); PG8_BAR; PG8_SCHED;
            PG8_LDB(B0, 1, 0); PG8_LDB(B1, 1, 1); PG8_SCHED; PG8_LDA(At, 1, 0); PG8_STAGE2(PG8_SA(0, 1), a2, s10, s11);
            PG8_WAIT_V(8); PG8_WAIT_L(0); PG8_BAR; PG8_MMA(0, 0, At, B0); PG8_MMA(0, 1, At, B1); PG8_BAR; PG8_SCHED;
            PG8_LDA(At, 1, 1); PG8_STAGEB(PG8_SB(1, 0), b3); PG8_STAGEB(PG8_SB(1, 1), b3 + hstep); PG8_STAGE2(PG8_SA(1, 0), a3, s00, s01);
            PG8_WAIT_V(8); PG8_WAIT_L(0); PG8_BAR; PG8_MMA(1, 0, At, B0); PG8_MMA(1, 1, At, B1); PG8_BAR; PG8_SCHED;
        }
        if constexpr (ALIGN_EPI) { if (wr == 0) PG8_BAR; }
        E(acc, cur, wr, wc, fr, fq);
        if (!has_next) break;
#pragma unroll
        for (int a = 0; a < 2; ++a)
#pragma unroll
            for (int b = 0; b < 2; ++b)
#pragma unroll
                for (int m = 0; m < 4; ++m)
#pragma unroll
                    for (int n = 0; n < 2; ++n) acc[a][b][m][n] = (f32x4){0.f, 0.f, 0.f, 0.f};
        cur = nxt; cA = nA; cB = nB; ++ui; cv00 = nv00; cv01 = nv01; cv10 = nv10; cv11 = nv11;
        if constexpr (ALIGN_EPI) { if (wr == 1) PG8_BAR; }
    }
    PG8_WAIT_V(0);
    if constexpr (!ALIGN_EPI) { if (wr == 0) PG8_BAR; }
    PG8_BAR;
#undef PG8_SA
#undef PG8_SB
#undef PG8_STAGE2
#undef PG8_STAGEB
#undef PG8_LDA
#undef PG8_LDB
#undef PG8_MMA
#undef PG8_WAIT_V
#undef PG8_WAIT_L
#undef PG8_BAR
#undef PG8_SCHED
}
}
namespace pg8 {
__device__ __forceinline__ int xcd_remap(int L, int n) { const int q = n / NXCD, r = n % NXCD, xcd = L % NXCD, off = L / NXCD; return (xcd < r ? xcd * (q + 1) : r * (q + 1) + (xcd - r) * q) + off; }
struct SchedDense {
    static constexpr bool GATHER = false;
    const char* A; const char* Bt; int K; int nM, nN, nwg, G, c;
    __device__ __forceinline__ void init(const void* A_, const void* Bt_, int M, int N, int K_, int G_, int c_) { A = (const char*)A_; Bt = (const char*)Bt_; K = K_; nM = M / BM; nN = N / BM; nwg = nM * nN; G = G_; c = c_; }
    __device__ __forceinline__ bool next(int i, Unit& u) const {
        const long L = (long)i * G + c; if (L >= nwg) return false;
        int wgid = (int)L; { const int q = nwg / NXCD, r = nwg % NXCD, xcd = wgid % NXCD, off = wgid / NXCD; wgid = (xcd < r ? xcd * (q + 1) : r * (q + 1) + (xcd - r) * q) + off; }
        const int nig = WGM * nN, gid = wgid / nig, fm = gid * WGM, gsz = (nM - fm) < WGM ? (nM - fm) : WGM;
        u.pm = fm + ((wgid % nig) % gsz); u.pn = (wgid % nig) / gsz; u.e = 0; u.aux = 0; return true;
    }
    __device__ __forceinline__ const char* a_base(const Unit& u) const { return A + (size_t)u.pm * BM * K * 2; }
    __device__ __forceinline__ const char* b_base(const Unit& u) const { return Bt + (size_t)u.pn * BM * K * 2; }
    __device__ __forceinline__ void a_rows(const Unit&, int, int, int&, int&, int&, int&) const {}
};
struct SchedQkv1 {
    static constexpr bool GATHER = false;
    const char* A; const char* Bt; int K; int G, c;
    __device__ __forceinline__ bool next(int i, Unit& u) const {
        const int L0 = i * G + c; if (L0 >= 256 * 6 + 32) return false; const int L = xcd_remap(L0, 256 * 6 + 32); const int NL = 256 * 6;
        if (L < NL) { const int g = L / 48, w = L % 48; const int lt = g * 8 + (w % 8); u.pn = w / 8; u.pm = (lt / 16) * 17 + 1 + (lt % 16); u.e = 0; u.aux = 0; return true; }
        const int r = L - NL; if (r >= 32) return false;
        u.pm = (r >> 1) * 17; u.pn = 4 + (r & 1); u.e = 0; u.aux = 0; return true;
    }
    __device__ __forceinline__ const char* a_base(const Unit& u) const { return A + (size_t)u.pm * BM * K * 2; }
    __device__ __forceinline__ const char* b_base(const Unit& u) const { return Bt + (size_t)u.pn * BM * K * 2; }
    __device__ __forceinline__ void a_rows(const Unit&, int, int, int&, int&, int&, int&) const {}
};
struct SchedInProj {
    static constexpr bool GATHER = false;
    const char* H; const char* Why; const char* Watt; int G, c;
    __device__ __forceinline__ bool next(int i, Unit& u) const {
        const int L0 = i * G + c; if (L0 >= 9 * 272) return false; const int L = xcd_remap(L0, 9 * 272); const int N0 = 6 * 272;
        if (L < N0) { u.e = 0; u.pn = L / 6; u.pm = L % 6; u.aux = 0; return true; }
        const int r = L - N0; if (r >= 3 * 272) return false;
        u.e = 1; const int g = r / 24, w = r % 24; u.pm = g * 8 + (w % 8); u.pn = w / 8; u.aux = 0; return true;
    }
    __device__ __forceinline__ const char* a_base(const Unit& u) const { return (u.e == 0 ? Why : H) + (size_t)u.pm * BM * 1024 * 2; }
    __device__ __forceinline__ const char* b_base(const Unit& u) const { return (u.e == 0 ? H : Watt) + (size_t)u.pn * BM * 1024 * 2; }
    __device__ __forceinline__ void a_rows(const Unit&, int, int, int&, int&, int&, int&) const {}
};
struct SchedLat {
    static constexpr bool GATHER = false;
    const char* A; const char* Bt; int K; int nN; int G, c;
    __device__ __forceinline__ bool next(int i, Unit& u) const {
        const int L0 = i * G + c; if (L0 >= 256 * nN) return false; const int L = xcd_remap(L0, 256 * nN);
        const int per = 8 * nN; const int g = L / per, w = L % per; const int lt = g * 8 + (w % 8); u.pn = w / 8; u.pm = (lt / 16) * 17 + 1 + (lt % 16); u.e = 0; u.aux = 0; return true;
    }
    __device__ __forceinline__ const char* a_base(const Unit& u) const { return A + (size_t)u.pm * BM * K * 2; }
    __device__ __forceinline__ const char* b_base(const Unit& u) const { return Bt + (size_t)u.pn * BM * K * 2; }
    __device__ __forceinline__ void a_rows(const Unit&, int, int, int&, int&, int&, int&) const {}
};
template <bool GATH>
struct SchedMoe {
    static constexpr bool GATHER = GATH;
    const char* A; const char* W; size_t wstride; int K; const LAS int* tab; const int* tokidx; int G, c;
    __device__ __forceinline__ bool next(int i, Unit& u) const {
        const int L0 = i * G + c; const int nu = tab[32] * 4; if (L0 >= nu) return false; const int L = xcd_remap(L0, nu); const int tau = L >> 2;
        int e = 0;
#pragma unroll 1
        for (int s = 16; s >= 1; s >>= 1) if (tab[e + s] <= tau) e += s;
        u.pm = tau; u.pn = L & 3; u.e = e; u.aux = tau - tab[e]; return true;
    }
    __device__ __forceinline__ const char* a_base(const Unit& u) const { return GATH ? A : A + (size_t)u.pm * BM * K * 2; }
    __device__ __forceinline__ const char* b_base(const Unit& u) const { return W + (size_t)u.e * wstride + (size_t)u.pn * BM * K * 2; }
    __device__ __forceinline__ void a_rows(const Unit& u, int R0, int R1, int& r0, int& r1, int& r2, int& r3) const {
        const int cnt = tab[64 + u.e]; const int* ti = tokidx + (size_t)u.e * CAP; const int p = u.aux * BM;
        int p0 = p + R0, p1 = p + R1, p2 = p + 128 + R0, p3 = p + 128 + R1;
        p0 = p0 < cnt ? p0 : 0; p1 = p1 < cnt ? p1 : 0; p2 = p2 < cnt ? p2 : 0; p3 = p3 < cnt ? p3 : 0;
        r0 = ti[p0]; r1 = ti[p1]; r2 = ti[p2]; r3 = ti[p3];
    }
};

struct EpiBf16 {
    bf16* O; int ldc;
    __device__ __forceinline__ void operator()(const f32x4 (&acc)[2][2][4][2], const Unit& u, int wr, int wc, int fr, int fq) const {
        const int row0 = u.pm * BM + wr * 64 + fr, col0 = u.pn * BM + wc * 32 + 8 * fq;
#pragma unroll
        for (int ai = 0; ai < 2; ++ai)
#pragma unroll
            for (int m = 0; m < 4; ++m) { bf16* rowp = O + (size_t)(row0 + ai * HALF + m * 16) * ldc + col0;
#pragma unroll
                for (int bj = 0; bj < 2; ++bj) { const f32x4 v0 = acc[ai][bj][m][0], v1 = acc[ai][bj][m][1];
                    u32x4 w; w.x = cvt_pk_bf16(v0[0], v0[1]); w.y = cvt_pk_bf16(v0[2], v0[3]); w.z = cvt_pk_bf16(v1[0], v1[1]); w.w = cvt_pk_bf16(v1[2], v1[3]);
                    *(u32x4*)(rowp + bj * HALF) = w; } }
    }
};
template <int LAYER>
struct EpiQkv {
    bf16* O; int ldc; const f32x2* rope  ; const float* qg; const float* kg;
    __device__ __forceinline__ void operator()(const f32x4 (&acc)[2][2][4][2], const Unit& u, int wr, int wc, int fr, int fq) const {
        const bool ctx = (u.pm % 17) == 0;
        const int jrow0 = u.pm * BM + wr * 64 + fr;
        const int t0 = ((u.pm % 17) - 1) * BM + wr * 64 + fr;
#pragma unroll
        for (int bj = 0; bj < 2; ++bj) {
            int kind;
            if (LAYER == 0) kind = (u.pn < 2) ? 0 : (bj == 0 ? 1 : 2); else kind = (u.pn < 4) ? 0 : (u.pn == 4 ? 1 : 2);
            const bool l0kv = (LAYER == 0 && u.pn == 2);
            const int half = l0kv ? (wc & 1) : bj;
            const int colb = l0kv ? (u.pn * BM + bj * HALF + wc * 32) : (u.pn * BM + wc * 64 + bj * 32);
#pragma unroll
            for (int ai = 0; ai < 2; ++ai)
#pragma unroll
                for (int m = 0; m < 4; ++m) {
                    f32x4 v0 = acc[ai][bj][m][0], v1 = acc[ai][bj][m][1];
                    const int roff = ai * HALF + m * 16;
                    if (LAYER == 1 && kind != 2) {
                        const f32x4 w0 = acc[ai][bj ^ 1][m][0], w1 = acc[ai][bj ^ 1][m][1];
                        float ss = (v0[0] * v0[0] + v0[1] * v0[1]) + (v0[2] * v0[2] + v0[3] * v0[3]) + (v1[0] * v1[0] + v1[1] * v1[1]) + (v1[2] * v1[2] + v1[3] * v1[3])
                                 + (w0[0] * w0[0] + w0[1] * w0[1]) + (w0[2] * w0[2] + w0[3] * w0[3]) + (w1[0] * w1[0] + w1[1] * w1[1]) + (w1[2] * w1[2] + w1[3] * w1[3]);
                        ss += __shfl_xor(ss, 16); ss += __shfl_xor(ss, 32);
                        const float rs = rsqrtf(ss * (1.f / 64.f) + NORM_EPS);
                        const float* g = (kind == 0 ? qg : kg) + 32 * bj;
                        const f32x4 g0 = *(const f32x4*)(g + 4 * fq), g1 = *(const f32x4*)(g + 16 + 4 * fq);
                        v0 = v0 * rs * g0; v1 = v1 * rs * g1;
                    }
                    if (kind != 2 && !ctx) {
                        const int t = t0 + roff; const int pos = half == 0 ? (t >> 6) : (t & 63);
                        const f32x2* rp = rope + pos * 16 + 4 * fq;
                        f32x4 a, b;
#pragma unroll
                        for (int i = 0; i < 4; ++i) { const f32x2 cs = rp[i]; a[i] = v0[i] * cs.x - v1[i] * cs.y; b[i] = v1[i] * cs.x + v0[i] * cs.y; }
                        v0 = a; v1 = b;
                    }
                    if (kind == 0) { v0 = v0 * QSCALE; v1 = v1 * QSCALE; }
                    u32x4 w; w.x = cvt_pk_bf16(v0[0], v0[1]); w.y = cvt_pk_bf16(v0[2], v0[3]); w.z = cvt_pk_bf16(v1[0], v1[1]); w.w = cvt_pk_bf16(v1[2], v1[3]);
                    *(u32x4*)(O + (size_t)(jrow0 + roff) * ldc + colb + 8 * fq) = w;
                }
        }
    }
};
struct EpiInProj {
    EpiBf16 e0; EpiQkv<0> e1;
    __device__ __forceinline__ void operator()(const f32x4 (&acc)[2][2][4][2], const Unit& u, int wr, int wc, int fr, int fq) const { if (u.e == 0) e0(acc, u, wr, wc, fr, fq); else e1(acc, u, wr, wc, fr, fq); }
};
struct EpiOut {
    bf16* Y; const float* mod  ;
    __device__ __forceinline__ void operator()(const f32x4 (&acc)[2][2][4][2], const Unit& u, int wr, int wc, int fr, int fq) const {
        const int b = u.pm / 17, j = u.pm % 17; const bool ctx = (j == 0);
        const float* g = mod + ((size_t)(ctx ? 16 : b) * NMOD + 2) * DM;
        const int row0 = u.pm * BM + wr * 64 + fr, col0 = u.pn * BM + wc * 32 + 8 * fq;
        f32x4 gv[2][2];
#pragma unroll
        for (int bj = 0; bj < 2; ++bj)
#pragma unroll
            for (int n = 0; n < 2; ++n) gv[bj][n] = *(const f32x4*)(g + col0 + bj * HALF + 4 * n);
#pragma unroll
        for (int ai = 0; ai < 2; ++ai)
#pragma unroll
            for (int m = 0; m < 4; ++m) { bf16* rowp = Y + (size_t)(row0 + ai * HALF + m * 16) * DM + col0;
#pragma unroll
                for (int bj = 0; bj < 2; ++bj) { const f32x4 v0 = acc[ai][bj][m][0] * gv[bj][0], v1 = acc[ai][bj][m][1] * gv[bj][1];
                    u32x4 w; w.x = cvt_pk_bf16(v0[0], v0[1]); w.y = cvt_pk_bf16(v0[2], v0[3]); w.z = cvt_pk_bf16(v1[0], v1[1]); w.w = cvt_pk_bf16(v1[2], v1[3]);
                    *(u32x4*)(rowp + bj * HALF) = w; } }
    }
};
struct EpiGateUp {
    bf16* HID;
    __device__ __forceinline__ void operator()(const f32x4 (&acc)[2][2][4][2], const Unit& u, int wr, int wc, int fr, int fq) const {
        const int row0 = u.pm * BM + wr * 64 + fr, col0 = u.pn * 128 + wc * 32 + 8 * fq;
#pragma unroll
        for (int ai = 0; ai < 2; ++ai)
#pragma unroll
            for (int m = 0; m < 4; ++m) {
                const f32x4 g0 = acc[ai][0][m][0], g1 = acc[ai][0][m][1], u0 = acc[ai][1][m][0], u1 = acc[ai][1][m][1];
                float h[8];
#pragma unroll
                for (int i = 0; i < 4; ++i) { h[i] = g0[i] / (1.f + __expf(-g0[i])) * u0[i]; h[4 + i] = g1[i] / (1.f + __expf(-g1[i])) * u1[i]; }
                u32x4 w; w.x = cvt_pk_bf16(h[0], h[1]); w.y = cvt_pk_bf16(h[2], h[3]); w.z = cvt_pk_bf16(h[4], h[5]); w.w = cvt_pk_bf16(h[6], h[7]);
                *(u32x4*)(HID + (size_t)(row0 + ai * HALF + m * 16) * DEXP + col0) = w; }
    }
};
struct EpiDown {
    bf16* MOUT; const float* gate; const LAS int* tab;
    __device__ __forceinline__ void operator()(const f32x4 (&acc)[2][2][4][2], const Unit& u, int wr, int wc, int fr, int fq) const {
        const int r0 = wr * 64 + fr, col0 = u.pn * BM + wc * 32 + 8 * fq; const int cnt = tab[64 + u.e]; const float* gp = gate + (size_t)u.e * CAP;
#pragma unroll
        for (int ai = 0; ai < 2; ++ai)
#pragma unroll
            for (int m = 0; m < 4; ++m) { const int r = r0 + ai * HALF + m * 16; const int pos = u.aux * BM + r; const float gt = pos < cnt ? gp[pos] : 0.f;
                bf16* rowp = MOUT + (size_t)(u.pm * BM + r) * DM + col0;
#pragma unroll
                for (int bj = 0; bj < 2; ++bj) { const f32x4 v0 = acc[ai][bj][m][0] * gt, v1 = acc[ai][bj][m][1] * gt;
                    u32x4 w; w.x = cvt_pk_bf16(v0[0], v0[1]); w.y = cvt_pk_bf16(v0[2], v0[3]); w.z = cvt_pk_bf16(v1[0], v1[1]); w.w = cvt_pk_bf16(v1[2], v1[3]);
                    *(u32x4*)(rowp + bj * HALF) = w; } }
    }
};
}
namespace attn_body {
using bf16=__hip_bfloat16;
using bf16x8=__attribute__((ext_vector_type(8)))short;
using s16x4=__attribute__((ext_vector_type(4)))short;
using f32x16=__attribute__((ext_vector_type(16)))float;
using u32x4=__attribute__((ext_vector_type(4)))unsigned;
constexpr int D=64;
constexpr int NW=8,QBLK=32,QB=QBLK*NW,KVBLK=64;
__device__ __forceinline__ int crow(int r,int hi){return (r&3)+8*(r>>2)+4*hi;}
#define SBAR() __builtin_amdgcn_sched_barrier(0)
__device__ __forceinline__ void swamask(f32x16&p0,f32x16&p1,int d0){
  const float NEG=-INFINITY;
  #pragma unroll
  for(int r=0;r<16;++r){const int d=d0+(r&3)+8*(r>>2); if((unsigned)(d+128)>256u)p0[r]=NEG; if((unsigned)(d+160)>256u)p1[r]=NEG;}
}

constexpr int NSLOT=3, SLOTB=8192;
constexpr int LDS_K=0, LDS_V=NSLOT*SLOTB, LDS_WS=2*NSLOT*SLOTB, LDS_OST=LDS_WS+NW*64*4, LDS_BYTES=LDS_OST+NW*4096;
constexpr float C2=0.125f*1.4426950408889634f;
__device__ __forceinline__ void glds16(const void*gsrc,unsigned lds_dst){unsigned keep;
  asm volatile("s_mov_b32 %0, m0\n\ts_mov_b32 m0, %2\n\ts_nop 0\n\tglobal_load_lds_dwordx4 %1, off\n\ts_mov_b32 m0, %0":"=&s"(keep):"v"(gsrc),"s"(lds_dst):"memory");}
__device__ __forceinline__ float max3f(float a,float b,float c){float r;asm("v_max3_f32 %0, %1, %2, %3":"=v"(r):"v"(a),"v"(b),"v"(c));return r;}
__device__ __forceinline__ float max2f(float a,float b){float r;asm("v_max_f32_e32 %0, %1, %2":"=v"(r):"v"(a),"v"(b));return r;}
__device__ __forceinline__ float fadd_s(float a,float b){float r;asm("v_add_f32_e32 %0, %1, %2":"=v"(r):"v"(a),"v"(b));return r;}
__device__ __forceinline__ float fsub_s(float a,float b){float r;asm("v_sub_f32_e32 %0, %1, %2":"=v"(r):"v"(a),"v"(b));return r;}
typedef float f32x2_t __attribute__((ext_vector_type(2))); typedef __bf16 bf16x2_t __attribute__((ext_vector_type(2)));
__device__ __forceinline__ unsigned cvtpk_s(float lo,float hi){f32x2_t v={lo,hi};bf16x2_t b=__builtin_convertvector(v,bf16x2_t);return __builtin_bit_cast(unsigned,b);}
#define WAIT_BAR(N) asm volatile("s_waitcnt vmcnt(" #N ") lgkmcnt(0)\n\ts_barrier":::"memory")

__device__ __forceinline__ void qkt(f32x16&p0,f32x16&p1,const char*Kslot,const bf16x8*qr,const f32x16&negm,int r32,int hi){
  const char*kb=Kslot+hi*1024+r32*16;
  #pragma unroll
  for(int d0=0;d0<4;++d0){
    const bf16x8 b0=*reinterpret_cast<const bf16x8*>(kb+d0*2048);
    const bf16x8 b1=*reinterpret_cast<const bf16x8*>(kb+d0*2048+512);
    if(d0==0){p0=__builtin_amdgcn_mfma_f32_32x32x16_bf16(b0,qr[0],negm,0,0,0);p1=__builtin_amdgcn_mfma_f32_32x32x16_bf16(b1,qr[0],negm,0,0,0);}
    else{p0=__builtin_amdgcn_mfma_f32_32x32x16_bf16(b0,qr[d0],p0,0,0,0);p1=__builtin_amdgcn_mfma_f32_32x32x16_bf16(b1,qr[d0],p1,0,0,0);}}
}
typedef __attribute__((address_space(3))) const char* lds_cptr;
typedef short v4i16_t __attribute__((ext_vector_type(4)));
__device__ __forceinline__ void kload8(bf16x8*kf,lds_cptr kp){
  kf[0]=*(const __attribute__((address_space(3))) bf16x8*)(kp);      kf[1]=*(const __attribute__((address_space(3))) bf16x8*)(kp+512);
  kf[2]=*(const __attribute__((address_space(3))) bf16x8*)(kp+2048); kf[3]=*(const __attribute__((address_space(3))) bf16x8*)(kp+2560);
  kf[4]=*(const __attribute__((address_space(3))) bf16x8*)(kp+4096); kf[5]=*(const __attribute__((address_space(3))) bf16x8*)(kp+4608);
  kf[6]=*(const __attribute__((address_space(3))) bf16x8*)(kp+6144); kf[7]=*(const __attribute__((address_space(3))) bf16x8*)(kp+6656);
}
__device__ __forceinline__ void kload2(bf16x8*kf,lds_cptr kp,int j){ kf[2*j]=*(const __attribute__((address_space(3))) bf16x8*)(kp+j*2048); kf[2*j+1]=*(const __attribute__((address_space(3))) bf16x8*)(kp+j*2048+512); }
__device__ __forceinline__ s16x4 vtr(lds_cptr p){ return __builtin_bit_cast(s16x4,__builtin_amdgcn_ds_read_tr16_b64_v4i16((__attribute__((address_space(3))) v4i16_t*)p)); }
__device__ __forceinline__ float rowmax(const f32x16&p0,const f32x16&p1){
  float a=max3f(p0[0],p0[1],p1[0]),b=max3f(p0[2],p0[3],p1[1]);a=max3f(a,p1[2],p1[3]);
  #pragma unroll
  for(int r=4;r<16;r+=4){a=max3f(a,p0[r],p0[r+1]);b=max3f(b,p0[r+2],p0[r+3]);a=max3f(a,p1[r],p1[r+1]);b=max3f(b,p1[r+2],p1[r+3]);}
  const float m=max2f(a,b);
  auto rr=__builtin_amdgcn_permlane32_swap(__float_as_uint(m),__float_as_uint(m),false,false);
  return max2f(__uint_as_float(rr[0]),__uint_as_float(rr[1]));
}
__device__ __forceinline__ void pv(f32x16*o,int vb,bf16x8 pa0,bf16x8 pa1,bf16x8 pa2,bf16x8 pa3){
  #pragma unroll
  for(int d0=0;d0<2;++d0){s16x4 lo[4],hi[4];
    #pragma unroll
    for(int ks=0;ks<4;++ks){
      asm volatile("ds_read_b64_tr_b16 %0,%1 offset:%c2":"=&v"(lo[ks]):"v"(vb),"i"(d0*4096+ks*1024):"memory");
      asm volatile("ds_read_b64_tr_b16 %0,%1 offset:%c2":"=&v"(hi[ks]):"v"(vb),"i"(d0*4096+ks*1024+512):"memory");}
    asm volatile("s_waitcnt lgkmcnt(0)":::"memory");SBAR();
    #define PK(k) (bf16x8){lo[k][0],lo[k][1],lo[k][2],lo[k][3],hi[k][0],hi[k][1],hi[k][2],hi[k][3]}
    o[d0]=__builtin_amdgcn_mfma_f32_32x32x16_bf16(pa0,PK(0),o[d0],0,0,0);
    o[d0]=__builtin_amdgcn_mfma_f32_32x32x16_bf16(pa1,PK(1),o[d0],0,0,0);
    o[d0]=__builtin_amdgcn_mfma_f32_32x32x16_bf16(pa2,PK(2),o[d0],0,0,0);
    o[d0]=__builtin_amdgcn_mfma_f32_32x32x16_bf16(pa3,PK(3),o[d0],0,0,0);
    #undef PK
  }
}

#ifndef ATTN_STORE16
#define ATTN_STORE16(p,v) (*(u32x4*)(p)=(v))
#endif
template<int MODE,int QP,int KP,int OP,int THRL,bool FIXM=false> __device__ __forceinline__ void attn_unit(const bf16*Qu,const bf16*__restrict__ Kh,const bf16*__restrict__ Vh,bf16*Ou,int NT,int lat0,int tq0,float sinkl2,char*shm,const int wave_id,const float m0fix,const bool pre,const bool has_next,const bf16*__restrict__ Kh_n,const bf16*__restrict__ Vh_n,const bool unused_=false){
  const int wid=wave_id,lane=lane_id(),r32=lane&31,hi=lane>>5;
  const bf16*Qw=Qu+(long)(wid*QBLK)*QP;
  const unsigned lds0=(unsigned)(uintptr_t)shm;
  float*wsf=(float*)(shm+LDS_WS)+wid*64;
  const bf16*ksrc=Kh+(long)lane*KP+wid*8;
  const bf16*vsrc=Vh+(long)(16*(wid&3)+(lane>>2))*KP+(wid>>2)*32+(lane&3)*8;
  #define KROW(t) ((long)(64*(t)+(((t)>=4)?lat0:0)))
  const unsigned kdst=lds0+LDS_K+wid*1024, vdst=lds0+LDS_V+wid*1024;
  #define DMA_K(t,slot) glds16(ksrc+KROW(t)*KP,(unsigned)__builtin_amdgcn_readfirstlane(kdst+(slot)))
  #define DMA_V(t,slot) glds16(vsrc+KROW(t)*KP,(unsigned)__builtin_amdgcn_readfirstlane(vdst+(slot)))
  const int vb0=(int)(lds0+LDS_V)+((lane>>4)&1)*32+(lane&3)*8+(4*hi+((lane&15)>>2))*64;
  const char*Kbase=shm+LDS_K; bf16x8 kf[8];
  const lds_cptr shm3=(lds_cptr)shm; const lds_cptr kp0=shm3+LDS_K+hi*1024+r32*16; const lds_cptr vp0=shm3+LDS_V+((lane>>4)&1)*32+(lane&3)*8+(4*hi+((lane&15)>>2))*64;
  if(!pre){DMA_K(0,0);DMA_V(0,0);DMA_K(1,SLOTB);}
  bf16x8 qr[4];
  #pragma unroll
  for(int d0=0;d0<4;++d0)qr[d0]=*reinterpret_cast<const bf16x8*>(&Qw[(long)r32*QP+d0*16+hi*8]);
  float mhat=0.f,l_reg=0.f;f32x16 o[2];o[0]=f32x16{};o[1]=f32x16{};f32x16 negm=f32x16{};
  if(FIXM){mhat=m0fix;
    #pragma unroll
    for(int r=0;r<16;++r)negm[r]=-m0fix;}
  asm volatile("":"+v"(negm));
  const int qrel=wid*QBLK+r32;
  const int mq=4*hi-(tq0+qrel)+lat0-256;
  #define CMASK(P0,P1,t) do{ if(MODE==1 && (t)>=4) swamask(P0,P1,mq+64*(t)); }while(0)
  bool resc=false;
  #define START(P0,P1) do{ resc=false; \
    if(!FIXM){ const float rm=rowmax(P0,P1); const float dl=rm; mhat=fadd_s(mhat,dl); \
      _Pragma("unroll") for(int r=0;r<16;++r){P0[r]=fsub_s(P0[r],dl);P1[r]=fsub_s(P1[r],dl);} \
      _Pragma("unroll") for(int r=0;r<16;++r)negm[r]=-mhat; asm volatile("":"+v"(negm)); } \
    _Pragma("unroll") for(int r=0;r<16;++r)P0[r]=__builtin_amdgcn_exp2f(P0[r]); }while(0)
  #define RESC() do{ if(resc){ asm volatile("s_waitcnt lgkmcnt(0)":::"memory"); \
      _Pragma("unroll") for(int d_=0;d_<2;++d_) _Pragma("unroll") for(int r=0;r<16;++r)o[d_][r]*=wsf[crow(r,hi)]; } }while(0)
  f32x16 pA0,pA1,pB0,pB1;
  int sl_prev=0,sl_cur=0,sl_next=SLOTB;
  #define ROT() do{sl_prev=sl_cur;sl_cur=sl_next;sl_next=(sl_next==(NSLOT-1)*SLOTB)?0:sl_next+SLOTB;}while(0)
  DMA_K(2,2*SLOTB);
  WAIT_BAR(3);
  qkt(pA0,pA1,Kbase,qr,negm,r32,hi);asm volatile("s_nop 15\n\ts_nop 7":"+v"(pA0),"+v"(pA1));CMASK(pA0,pA1,0);
  START(pA0,pA1);
  _Pragma("unroll") for(int r=0;r<16;++r)pA1[r]=__builtin_amdgcn_exp2f(pA1[r]);
  WAIT_BAR(0);
  DMA_K(3,0);DMA_V(1,SLOTB);
  ROT();
  kload8(kf,kp0+sl_cur);
  WAIT_BAR(2);
  s16x4 vlo[8],vhi[8]; u32x4 pw0,pw1,pw2,pw3;
  #define PKW(P,B) cvtpk_s(P[B],P[B+1])
  #define PAF(k) __builtin_bit_cast(bf16x8,pw##k)
  #define VFR(i) (bf16x8){vlo[i][0],vlo[i][1],vlo[i][2],vlo[i][3],vhi[i][0],vhi[i][1],vhi[i][2],vhi[i][3]}
  #define PIN(x) asm volatile("":"+v"(x))
  #define MX3(a,b,c) __builtin_fmaxf(__builtin_fmaxf((a),(b)),(c))
  #define GAPA(MF,A0,A1,A2,A3,W0,W1,PW) do{ MF; sacc+=A0; sacc+=A1; sacc+=A2; sacc+=A3; PIN(sacc); W0; W1; PIN(PW); SBAR(); }while(0)
  #define EX(v) __builtin_amdgcn_exp2f(v)
  #define GAPB(MF,X,B) do{ MF; X[B]=EX(X[B]); X[B+1]=EX(X[B+1]); X[B+2]=EX(X[B+2]); X[B+3]=EX(X[B+3]); PIN(X); SBAR(); }while(0)
  #define VRD(i) do{ vlo[i]=vtr(vp_+(((i)>>2)*4096+((i)&3)*1024)); vhi[i]=vtr(vp_+(((i)>>2)*4096+((i)&3)*1024+512)); }while(0)
  #define KRD(G,j) do{ if(G){ kload2(kf,kp0+sl_next,j); SBAR(); } }while(0)
  #define STEP(C0,C1,P0,P1,t,GK,GV,GL) do{ SBAR(); \
    const lds_cptr vp_=vp0+sl_prev; \
    VRD(0); SBAR(); float sacc=(P0[0]+P0[1]); \
    GAPA(C0=__builtin_amdgcn_mfma_f32_32x32x16_bf16(kf[0],qr[0],negm,0,0,0), P0[2],P0[3],P0[4],P0[5],     pw0[0]=PKW(P0,0), pw0[1]=PKW(P0,2), pw0); \
    VRD(4); SBAR(); GAPA(C1=__builtin_amdgcn_mfma_f32_32x32x16_bf16(kf[1],qr[0],negm,0,0,0), P0[6],P0[7],P0[8],P0[9],     pw0[2]=PKW(P0,4), pw0[3]=PKW(P0,6), pw0); \
    VRD(1); SBAR(); GAPA(C0=__builtin_amdgcn_mfma_f32_32x32x16_bf16(kf[2],qr[1],C0,0,0,0),   P0[10],P0[11],P0[12],P0[13], pw1[0]=PKW(P0,8), pw1[1]=PKW(P0,10), pw1); \
    VRD(5); SBAR(); GAPA(C1=__builtin_amdgcn_mfma_f32_32x32x16_bf16(kf[3],qr[1],C1,0,0,0),   P0[14],P0[15],P1[0],P1[1],   pw1[2]=PKW(P0,12),pw1[3]=PKW(P0,14), pw1); \
    VRD(2); SBAR(); GAPA(C0=__builtin_amdgcn_mfma_f32_32x32x16_bf16(kf[4],qr[2],C0,0,0,0),   P1[2],P1[3],P1[4],P1[5],     pw2[0]=PKW(P1,0), pw2[1]=PKW(P1,2), pw2); \
    VRD(6); SBAR(); GAPA(C1=__builtin_amdgcn_mfma_f32_32x32x16_bf16(kf[5],qr[2],C1,0,0,0),   P1[6],P1[7],P1[8],P1[9],     pw2[2]=PKW(P1,4), pw2[3]=PKW(P1,6), pw2); \
    VRD(3); SBAR(); GAPA(C0=__builtin_amdgcn_mfma_f32_32x32x16_bf16(kf[6],qr[3],C0,0,0,0),   P1[10],P1[11],P1[12],P1[13], pw3[0]=PKW(P1,8), pw3[1]=PKW(P1,10), pw3); \
    VRD(7); SBAR(); GAPA(C1=__builtin_amdgcn_mfma_f32_32x32x16_bf16(kf[7],qr[3],C1,0,0,0),   P1[14],P1[15],0.f,0.f,       pw3[2]=PKW(P1,12),pw3[3]=PKW(P1,14), pw3); \
    l_reg+=sacc; \
    if(GK){DMA_K((t)+3,sl_cur);} if(GV){DMA_V((t)+1,sl_next);} \
    CMASK(C0,C1,t); \
    if(!FIXM){ float a=MX3(C0[0],C0[1],C1[0]),b=MX3(C0[2],C0[3],C1[1]); a=MX3(a,C1[2],C1[3]); \
      _Pragma("unroll") for(int r=4;r<16;r+=4){a=MX3(a,C0[r],C0[r+1]);b=MX3(b,C0[r+2],C0[r+3]);a=MX3(a,C1[r],C1[r+1]);b=MX3(b,C1[r+2],C1[r+3]);} \
      float rm=__builtin_fmaxf(a,b); { auto rr=__builtin_amdgcn_permlane32_swap(__float_as_uint(rm),__float_as_uint(rm),false,false); rm=__builtin_fmaxf(__uint_as_float(rr[0]),__uint_as_float(rr[1])); } \
      resc=false; \
      if(__builtin_expect(__any(rm>(float)THRL),0)){ const float dl=__builtin_fmaxf(rm,0.f); mhat+=dl; \
        _Pragma("unroll") for(int r=0;r<16;++r){C0[r]-=dl;C1[r]-=dl;} \
        _Pragma("unroll") for(int r=0;r<16;++r)negm[r]=-mhat; asm volatile("":"+v"(negm)); \
        const float f=__builtin_amdgcn_exp2f(-dl); l_reg*=f; if(hi==0)wsf[r32]=f; resc=true; } } \
    SBAR(); \
    GAPB(o[0]=__builtin_amdgcn_mfma_f32_32x32x16_bf16(PAF(0),VFR(0),o[0],0,0,0), C0,0); \
    GAPB(o[1]=__builtin_amdgcn_mfma_f32_32x32x16_bf16(PAF(0),VFR(4),o[1],0,0,0), C0,4); \
    KRD(GL,0); GAPB(o[0]=__builtin_amdgcn_mfma_f32_32x32x16_bf16(PAF(1),VFR(1),o[0],0,0,0), C0,8); \
    KRD(GL,1); GAPB(o[1]=__builtin_amdgcn_mfma_f32_32x32x16_bf16(PAF(1),VFR(5),o[1],0,0,0), C0,12); \
    KRD(GL,2); GAPB(o[0]=__builtin_amdgcn_mfma_f32_32x32x16_bf16(PAF(2),VFR(2),o[0],0,0,0), C1,0); \
    KRD(GL,3); GAPB(o[1]=__builtin_amdgcn_mfma_f32_32x32x16_bf16(PAF(2),VFR(6),o[1],0,0,0), C1,4); \
    GAPB(o[0]=__builtin_amdgcn_mfma_f32_32x32x16_bf16(PAF(3),VFR(3),o[0],0,0,0), C1,8); \
    GAPB(o[1]=__builtin_amdgcn_mfma_f32_32x32x16_bf16(PAF(3),VFR(7),o[1],0,0,0), C1,12); \
    }while(0)
  int t=1;
  for(;t+5<NT;t+=2){
    STEP(pB0,pB1,pA0,pA1,t,true,true,true);     WAIT_BAR(2); RESC(); ROT();
    STEP(pA0,pA1,pB0,pB1,t+1,true,true,true);   WAIT_BAR(2); RESC(); ROT();
  }
  #define ENDW(tt) do{ if((tt)+3<NT){WAIT_BAR(2);} else if((tt)+2<NT){WAIT_BAR(1);} else {WAIT_BAR(0);} }while(0)
  for(;t+1<NT;t+=2){
    STEP(pB0,pB1,pA0,pA1,t,(t+3<NT),(t+1<NT),(t+1<NT));       ENDW(t);   RESC(); ROT();
    STEP(pA0,pA1,pB0,pB1,t+1,(t+4<NT),(t+2<NT),(t+2<NT));     ENDW(t+1); RESC(); ROT();
  }
  STEP(pB0,pB1,pA0,pA1,NT-1,false,false,false); RESC();
  { float sacc=pB0[0]+pB0[1]; _Pragma("unroll") for(int r=2;r<16;++r)sacc+=pB0[r]; _Pragma("unroll") for(int r=0;r<16;++r)sacc+=pB1[r]; l_reg+=sacc;
    pw0=(u32x4){PKW(pB0,0),PKW(pB0,2),PKW(pB0,4),PKW(pB0,6)};pw1=(u32x4){PKW(pB0,8),PKW(pB0,10),PKW(pB0,12),PKW(pB0,14)};pw2=(u32x4){PKW(pB1,0),PKW(pB1,2),PKW(pB1,4),PKW(pB1,6)};pw3=(u32x4){PKW(pB1,8),PKW(pB1,10),PKW(pB1,12),PKW(pB1,14)};
    SBAR(); pv(o,vb0+sl_cur,PAF(0),PAF(1),PAF(2),PAF(3)); }
  #undef PKW
  #undef PAF
  #undef VFR
  #undef PIN
  #undef MX3
  #undef GAPA
  #undef GAPB
  #undef EX
  #undef VRD
  #undef KRD
  #undef STEP
  #undef ENDW
  asm volatile("s_waitcnt lgkmcnt(0)\n\ts_barrier":::"memory");
  if(has_next){ const bf16*ksn=Kh_n+(long)lane*KP+wid*8; const bf16*vsn=Vh_n+(long)(16*(wid&3)+(lane>>2))*KP+(wid>>2)*32+(lane&3)*8;
    glds16(ksn,(unsigned)__builtin_amdgcn_readfirstlane(kdst)); glds16(vsn,(unsigned)__builtin_amdgcn_readfirstlane(vdst)); glds16(ksn+(long)64*KP,(unsigned)__builtin_amdgcn_readfirstlane(kdst+SLOTB));
 }
  {auto rr=__builtin_amdgcn_permlane32_swap(__float_as_uint(l_reg),__float_as_uint(l_reg),false,false);l_reg=__uint_as_float(rr[0])+__uint_as_float(rr[1]);}
  l_reg+=__builtin_amdgcn_exp2f(sinkl2-mhat);
  if(hi==0)wsf[32+r32]=l_reg;asm volatile("s_waitcnt lgkmcnt(0)":::"memory");
  float rli[16];
  #pragma unroll
  for(int r=0;r<16;++r)rli[r]=__builtin_amdgcn_rcpf(wsf[32+crow(r,hi)]);
  bf16*Ow=Ou+(long)(wid*QBLK)*OP;
  { bf16*stg=(bf16*)(shm+LDS_OST)+wid*2048;
    #pragma unroll
    for(int r=0;r<16;++r){const int orow=crow(r,hi);
      #pragma unroll
      for(int d0=0;d0<2;++d0)stg[orow*64+d0*32+r32]=__float2bfloat16(o[d0][r]*rli[r]);}
    asm volatile("s_waitcnt lgkmcnt(0)":::"memory");
    #pragma unroll
    for(int i=0;i<4;++i){const int row=i*8+(lane>>3),ch=lane&7; const u32x4 v=*(const u32x4*)(stg+row*64+ch*8); ATTN_STORE16(Ow+(long)row*OP+ch*8,v);} }
  asm volatile("s_waitcnt lgkmcnt(0)":::"memory");
  #undef DMA_K
  #undef KROW
  #undef DMA_V
  #undef CMASK
  #undef START
  #undef RESC
  #undef ROT
}
constexpr int ATTN_LDS_BYTES=LDS_BYTES;
#undef SBAR
#undef WAIT_BAR
}
#define XB_TMO      128
#define XB_XCNT(j)  (256  + 64 * (j))
#define XB_XSUB(j)  (1280 + 64 * (j))
#define XB_XGEN(j)  (2304 + 64 * (j))
#define XB_TOP      3328
#define XB_TOPGEN   3392
#define XCD_BAR_WORDS 3456
#define XB_SPIN_CAP (1u << 18)

__device__ __forceinline__ unsigned xb_ld(unsigned* p)              { return __hip_atomic_load(p, __ATOMIC_RELAXED, __HIP_MEMORY_SCOPE_AGENT); }
__device__ __forceinline__ unsigned xb_add(unsigned* p, unsigned v) { return __hip_atomic_fetch_add(p, v, __ATOMIC_RELAXED, __HIP_MEMORY_SCOPE_AGENT); }
__device__ __forceinline__ unsigned xb_xcc_id() { return (unsigned)__builtin_amdgcn_s_getreg((3 << 11) | 20) & 0xFu; }
#define XB_SPIN(cond, bar) do { unsigned _sp = 0; while (cond) { __builtin_amdgcn_s_sleep(1); \
    if ((++_sp & 255u) == 0u) { if (xb_ld(&(bar)[XB_TMO])) break; if (_sp > XB_SPIN_CAP) { atomicAdd(&(bar)[XB_TMO], 1u); break; } } } } while (0)

struct XcdBarrier {
    unsigned* bar; unsigned x;
    volatile LAS unsigned* st;
};

__device__ __forceinline__ XcdBarrier xcd_barrier_post(unsigned* bar, volatile LAS unsigned* st, const bool t0) {
    XcdBarrier b; b.bar = bar; b.x = xb_xcc_id(); b.st = st;
    if (t0) (void)xb_add(&bar[XB_XCNT(b.x)], 1u);
    return b;
}
__device__ __forceinline__ void xcd_barrier_complete(unsigned* bar, unsigned x, unsigned& nloc, unsigned& nx) {
    const unsigned G = gridDim.x * gridDim.y * gridDim.z;
    unsigned sum, cnt, mine, sp = 0u;
    for (;;) {
        sum = 0u; cnt = 0u; mine = 0u;
#pragma unroll
        for (unsigned j = 0; j < 16; ++j) { const unsigned c = xb_ld(&bar[XB_XCNT(j)]); sum += c; cnt += (c > 0u) ? 1u : 0u; mine = (j == x) ? c : mine; }
        if (sum == G) break;
        __builtin_amdgcn_s_sleep(1);
        if ((++sp & 255u) == 0u) { if (xb_ld(&bar[XB_TMO])) break; if (sp > XB_SPIN_CAP) { atomicAdd(&bar[XB_TMO], 1u); break; } }
    }
    nloc = mine > 0u ? mine : 1u; nx = cnt > 0u ? cnt : 1u;
}

__device__ __forceinline__ void xcd_barrier(const XcdBarrier& b, const bool t0) {
    asm volatile("s_waitcnt vmcnt(0)" ::: "memory");
    __syncthreads();
    if (t0) {
        unsigned* bar = b.bar;
        __builtin_amdgcn_s_waitcnt(0);
        unsigned nloc = b.st[0], nx = b.st[1];
        if (nloc == 0u) { xcd_barrier_complete(bar, b.x, nloc, nx); b.st[0] = nloc; b.st[1] = nx; }
        const unsigned old = xb_add(&bar[XB_XSUB(b.x)], 1u);
        const unsigned gen = old / nloc;
        if (old + 1u == (gen + 1u) * nloc) {
            __builtin_amdgcn_fence(__ATOMIC_RELEASE, "agent");
            asm volatile("s_waitcnt vmcnt(0)" ::: "memory");
            const unsigned og = xb_add(&bar[XB_TOP], 1u);
            const unsigned tg = og / nx;
            if (og + 1u == (tg + 1u) * nx) xb_add(&bar[XB_TOPGEN], 1u);
            else XB_SPIN(xb_ld(&bar[XB_TOPGEN]) == tg, bar);
            __builtin_amdgcn_fence(__ATOMIC_ACQUIRE, "agent");
            xb_add(&bar[XB_XGEN(b.x)], 1u);
            asm volatile("s_waitcnt vmcnt(0)" ::: "memory");
        } else {
            XB_SPIN(xb_ld(&bar[XB_XGEN(b.x)]) == gen, bar);
            __builtin_amdgcn_fence(__ATOMIC_ACQUIRE, "agent");
            asm volatile("s_waitcnt vmcnt(0)" ::: "memory");
        }
    }
    __syncthreads();
}
constexpr int NWAVES = 8, NTHR = 512;
struct Args { const float* in[32]; float* out; unsigned char* ws; int ph_lo, ph_hi, one_launch, pad; };
enum InIdx { I_X = 0, I_C, I_CTX, I_CCTX, I_ADAW, I_ADAB, I_N1G, I_N2G, I_EVWIN, I_EVWOUT, I_HYCW, I_HYCB, I_HYW1, I_HYB1, I_HYW2, I_HYB2, I_HYW3, I_HYFREQ, I_HYSKIP, I_SINK,
             I_ODWQKV, I_ODWOUT, I_ODQG, I_ODKG, I_RTGW, I_RTGB, I_RTEW, I_RTEB, I_MOEG, I_MOEU, I_MOED, I_FNG };
struct Frame {
    LAS unsigned char* lds; int wave, G, bid;
    unsigned char* ws; gu32* ctl;
};
struct TItem { const float* src; int ldw; bf16* WT; int Kd, drow0, drow1, k0; bool perm; };
__device__ __forceinline__ int qkv_drow(int n) { const int pn = n >> 8, rem = n & 255; return 256 * pn + 128 * ((rem & 63) >> 5) + 32 * (rem >> 6); }
__device__ __forceinline__ TItem decode_item(const Args& a, unsigned char* ws, int it) {
    constexpr int S1 = 16 * 24, S2 = S1 + 16 * 12, S3 = S2 + 16 * 16, S4 = S3 + 16 * 24, S5 = S4 + 16 * 16;
    TItem t; t.perm = false;
    if (it < S1) { const int kb = it / 24, nb = it % 24, n = 64 * nb; t.src = a.in[I_EVWIN] + (size_t)(64 * kb) * D_IN_EVEN + n; t.ldw = D_IN_EVEN; t.WT = (bf16*)(ws + WS_WHY); t.Kd = 1024; t.drow0 = n; t.drow1 = n + 32; t.k0 = 64 * kb; }
    else if (it < S2) { const int r = it - S1, kb = r / 12, nb = r % 12, n = 64 * nb;
        if (n < 512) { t.drow0 = qkv_drow(n); t.drow1 = qkv_drow(n + 32); t.perm = true; } else { t.drow0 = n; t.drow1 = n + 32; t.perm = n < 640; }
        t.src = a.in[I_EVWIN] + (size_t)(64 * kb) * D_IN_EVEN + 1536 + n; t.ldw = D_IN_EVEN; t.WT = (bf16*)(ws + WS_WATT0); t.Kd = 1024; t.k0 = 64 * kb; }
    else if (it < S3) { const int r = it - S2, kb = r / 16, nb = r % 16, n = 64 * nb; t.src = a.in[I_EVWOUT] + (size_t)(64 * kb) * 1024 + n; t.ldw = 1024; t.WT = (bf16*)(ws + WS_WOUT0); t.Kd = 1024; t.drow0 = n; t.drow1 = n + 32; t.k0 = 64 * kb; }
    else if (it < S4) { const int r = it - S3, kb = r / 24, nb = r % 24, n = 64 * nb;
        t.src = a.in[I_ODWQKV] + (size_t)(64 * kb) * D_QKV1 + n; t.ldw = D_QKV1; t.WT = (bf16*)(ws + WS_WQKV1); t.Kd = 1024; t.drow0 = qkv_drow(n); t.drow1 = qkv_drow(n + 32); t.k0 = 64 * kb; t.perm = n < 1280; }
    else if (it < S5) { const int r = it - S4, kb = r / 16, nb = r % 16, n = 64 * nb; t.src = a.in[I_ODWOUT] + (size_t)(64 * kb) * 1024 + n; t.ldw = 1024; t.WT = (bf16*)(ws + WS_WOUT1); t.Kd = 1024; t.drow0 = n; t.drow1 = n + 32; t.k0 = 64 * kb; }
    else { const int r = it - S5, le = r / 384, sub = r % 384;
        if (sub < 256) { const int up = sub >> 7, s2 = sub & 127, kb = s2 >> 3, nb = s2 & 7, n = 64 * nb;
            t.src = a.in[up ? I_MOEU : I_MOEG] + (size_t)le * 1024 * 512 + (size_t)(64 * kb) * 512 + n; t.ldw = 512; t.WT = (bf16*)(ws + WS_WGU) + (size_t)le * 1024 * 1024; t.Kd = 1024;
            t.drow0 = 256 * (n >> 7) + (n & 127) + 128 * up; t.drow1 = t.drow0 + 32; t.k0 = 64 * kb; }
        else { const int s2 = sub - 256, kb = s2 >> 4, nb = s2 & 15, n = 64 * nb;
            t.src = a.in[I_MOED] + (size_t)le * 512 * 1024 + (size_t)(64 * kb) * 1024 + n; t.ldw = 1024; t.WT = (bf16*)(ws + WS_WDN) + (size_t)le * 1024 * 512; t.Kd = 512; t.drow0 = n; t.drow1 = n + 32; t.k0 = 64 * kb; } }
    return t;
}
__device__ __forceinline__ int pinv32(int j) { return j < 16 ? 8 * (j >> 2) + (j & 3) : 8 * ((j - 16) >> 2) + 4 + ((j - 16) & 3); }
struct TRegs { float v[64]; };
__device__ __forceinline__ TRegs titem_load(const TItem& t, int lane) { TRegs r; const float* p = t.src + lane;
#pragma unroll
    for (int i = 0; i < 64; ++i) r.v[i] = __builtin_nontemporal_load(p + (size_t)i * t.ldw);
    return r; }
__device__ __forceinline__ void titem_store(const TItem& t, const TRegs& r, LAS float* scr, int lane) {
#pragma unroll
    for (int i = 0; i < 64; ++i) scr[i * 65 + lane] = r.v[i];
    LDS_WAIT(); asm volatile("" ::: "memory");
    const int c = lane & 7;
#pragma unroll
    for (int j = 0; j < 8; ++j) { const int n = (lane >> 3) + 8 * j; const LAS float* s = scr + (8 * c) * 65 + n;
        v4u o; o.x = pk2(s[0 * 65], s[1 * 65]); o.y = pk2(s[2 * 65], s[3 * 65]); o.z = pk2(s[4 * 65], s[5 * 65]); o.w = pk2(s[6 * 65], s[7 * 65]);
        const int nl = n & 31;
        *(GAS v4u*)(t.WT + (size_t)((j >= 4 ? t.drow1 : t.drow0) + (t.perm ? pinv32(nl) : nl)) * t.Kd + t.k0 + 8 * c) = o; }
    LDS_WAIT(); asm volatile("" ::: "memory");
}

constexpr int W_ITEMS_ALL = 16 * 24 + 16 * 12 + 16 * 16 + 16 * 24 + 16 * 16 + 64 * 384, W_ITEMS_L1MOE = W_ITEMS_ALL - 32 * 384;
__device__ __forceinline__ void weight_items(Frame& F, const Args& a, const int lo, const int hi, const int rank, const int nblk) {
    const int F_lane = lane_id();
    LAS float* scr = (LAS float*)(F.lds + F.wave * 16896);
    const int gw = lo + rank * NWAVES + F.wave, NGW = nblk * NWAVES;
    if (gw < hi) {
        TItem cur = decode_item(a, F.ws, gw); TRegs rc = titem_load(cur, F_lane);
        for (int it = gw; it < hi; it += NGW) {
            const int itn = it + NGW < hi ? it + NGW : it; const TItem nxt = decode_item(a, F.ws, itn); const TRegs rn = titem_load(nxt, F_lane);
            titem_store(cur, rc, scr, F_lane);
            cur = nxt; rc = rn;
        }
    }
}

__device__ __forceinline__ void p0_prologue(Frame& F, const Args& a) {
    const int F_lane = lane_id(), F_tid = F.wave * 64 + F_lane; (void)F_tid;
    unsigned char* ws = F.ws;
    {
        LAS float* sv = (LAS float*)F.lds; LAS float* red = (LAS float*)(F.lds + 17 * 1024 * 4);
        float* MOD = (float*)(ws + WS_MOD);
        for (int u = F.bid; u < 192; u += F.G) {
            const int l = u / 96, n0 = (u % 96) * 64;
            for (int idx = F_tid; idx < 17 * 1024; idx += NTHR) { const int b = idx >> 10, k = idx & 1023; const float v = b < 16 ? a.in[I_C][b * 1024 + k] : a.in[I_CCTX][k]; sv[idx] = silu_f(v); }
            __syncthreads();
            float acc[17];
#pragma unroll
            for (int b = 0; b < 17; ++b) acc[b] = 0.f;
            const float* Wp = a.in[I_ADAW] + (size_t)l * 1024 * 6144 + n0 + F_lane;
            for (int k0 = F.wave * 128; k0 < F.wave * 128 + 128; k0 += 16) { float wv[16];
#pragma unroll
                for (int kk = 0; kk < 16; ++kk) wv[kk] = Wp[(size_t)(k0 + kk) * 6144];
#pragma unroll
                for (int kk = 0; kk < 16; ++kk)
#pragma unroll
                    for (int b = 0; b < 17; ++b) acc[b] += sv[b * 1024 + k0 + kk] * wv[kk]; }
#pragma unroll
            for (int b = 0; b < 17; ++b) red[(F.wave * 17 + b) * 64 + F_lane] = acc[b];
            __syncthreads();
            for (int idx = F_tid; idx < 17 * 64; idx += NTHR) { const int b = idx >> 6, j = idx & 63; float s = a.in[I_ADAB][l * 6144 + n0 + j];
#pragma unroll
                for (int w = 0; w < 8; ++w) s += red[(w * 17 + b) * 64 + j];
                MOD[((size_t)l * 17 + b) * 6144 + n0 + j] = s; }
            __syncthreads();
        }
    }
    {
        const float* w1 = a.in[I_HYW1]; const float* b1 = a.in[I_HYB1]; const float* w2 = a.in[I_HYW2]; const float* b2 = a.in[I_HYB2]; const float* fr = a.in[I_HYFREQ];
        float* HD2 = (float*)(ws + WS_HD2);
        const int gw = F.bid * NWAVES + F.wave, NGW = F.G * NWAVES;
        if (gw < 4352) {
            float w1c[33], w2c[64];
#pragma unroll
            for (int i = 0; i < 33; ++i) w1c[i] = w1[i * 64 + F_lane];
#pragma unroll
            for (int i = 0; i < 64; ++i) w2c[i] = w2[i * 64 + F_lane];
            const float frl = fr[F_lane], b1l = b1[F_lane], b2l = b2[F_lane];
            for (int tt = gw; tt < 4352; tt += NGW) {
                const int n = tt < 4096 ? 4096 : 256, t = tt < 4096 ? tt : tt - 4096; const float tf = (float)t; const float tn = tf / (float)(n - 1);
                float z = 0.f;
                if (F_lane == 0) z = tn;
                else if (F_lane < 33) { const int m = (F_lane - 1) & 15; const float band = 1e-4f + (float)m * ((15.f - 1e-4f) / 15.f); const float ang = ((float)(2.0 * M_PI / (double)n) * tf) * band;
                    z = F_lane < 17 ? cosf(ang) : -sinf(ang); }
                float h1 = b1l;
#pragma unroll
                for (int i = 0; i < 33; ++i) h1 += __builtin_bit_cast(float, __builtin_amdgcn_readlane(__builtin_bit_cast(int, z), i)) * w1c[i];
                h1 = sinf(frl * h1);
                float h2 = b2l;
#pragma unroll
                for (int i = 0; i < 64; ++i) h2 += __builtin_bit_cast(float, __builtin_amdgcn_readlane(__builtin_bit_cast(int, h1), i)) * w2c[i];
                h2 = sinf(frl * h2);
                HD2[(size_t)tt * 64 + F_lane] = h2;
            }
        }
    }
    if (F.bid == 0) {
        f32x2* RT = (f32x2*)(ws + WS_ROPE);
        for (int idx = F_tid; idx < 1024; idx += NTHR) { const int pos = idx >> 4, i = idx & 15; const float inv = powf(10000.f, -(float)(2 * i) / 32.f); const float ang = (float)pos * inv; RT[idx] = (f32x2){cosf(ang), sinf(ang)}; }
    }
    weight_items(F, a, 0, W_ITEMS_L1MOE, F.bid, F.G);
    __syncthreads();
}

struct RowVec { f32x4 v[4]; };
__device__ __forceinline__ RowVec ld_row(const float* p, int lane) { RowVec r; const f32x4* q = (const f32x4*)p + lane;
#pragma unroll
    for (int j = 0; j < 4; ++j) r.v[j] = q[64 * j]; return r; }
__device__ __forceinline__ RowVec ld_row_nt(const float* p, int lane) { RowVec r; const f32x4* q = (const f32x4*)p + lane;
#pragma unroll
    for (int j = 0; j < 4; ++j) r.v[j] = __builtin_nontemporal_load(q + 64 * j); return r; }
__device__ __forceinline__ void st_row(float* p, int lane, const RowVec& r) { f32x4* q = (f32x4*)p + lane;
#pragma unroll
    for (int j = 0; j < 4; ++j) q[64 * j] = r.v[j]; }
__device__ __forceinline__ void st_row_bf16_nt(bf16* p, int lane, const RowVec& r) { unsigned long long* o8 = (unsigned long long*)p + lane;
#pragma unroll
    for (int j = 0; j < 4; ++j) __builtin_nontemporal_store((unsigned long long)pk2(r.v[j][0], r.v[j][1]) | ((unsigned long long)pk2(r.v[j][2], r.v[j][3]) << 32), o8 + 64 * j); }
__device__ __forceinline__ void st_row_nt(float* p, int lane, const RowVec& r) { f32x4* q = (f32x4*)p + lane;
#pragma unroll
    for (int j = 0; j < 4; ++j) __builtin_nontemporal_store(r.v[j], q + 64 * j); }
__device__ __forceinline__ void st_row_bf16(bf16* p, int lane, const RowVec& r) { unsigned long long* o8 = (unsigned long long*)p + lane;
#pragma unroll
    for (int j = 0; j < 4; ++j) o8[64 * j] = (unsigned long long)pk2(r.v[j][0], r.v[j][1]) | ((unsigned long long)pk2(r.v[j][2], r.v[j][3]) << 32); }
__device__ __forceinline__ RowVec ld_row_bf16(const bf16* p, int lane) { RowVec r; const u32x2* q = (const u32x2*)p + lane;
#pragma unroll
    for (int j = 0; j < 4; ++j) { const u32x2 w = __builtin_nontemporal_load(q + 64 * j); r.v[j] = (f32x4){bflo(w.x), bfhi(w.x), bflo(w.y), bfhi(w.y)}; } return r; }
struct RowRaw { u32x2 w[4]; };
__device__ __forceinline__ RowRaw ld_raw_bf16(const bf16* p, int lane) { RowRaw r; const u32x2* q = (const u32x2*)p + lane;
#pragma unroll
    for (int j = 0; j < 4; ++j) r.w[j] = __builtin_nontemporal_load(q + 64 * j); return r; }
__device__ __forceinline__ RowVec norm_mod(const RowVec& x, const float* g, const float* scale, const float* shift, int lane) {
    float ss = 0.f;
#pragma unroll
    for (int j = 0; j < 4; ++j) ss += (x.v[j][0] * x.v[j][0] + x.v[j][1] * x.v[j][1]) + (x.v[j][2] * x.v[j][2] + x.v[j][3] * x.v[j][3]);
    const float rs = rsqrtf(wave_sum(ss) * (1.f / 1024.f) + NORM_EPS);
    const RowVec gv = ld_row(g, lane); RowVec y;
    if (scale) { const RowVec sc = ld_row(scale, lane), sf = ld_row(shift, lane);
#pragma unroll
        for (int j = 0; j < 4; ++j) y.v[j] = (x.v[j] * rs * gv.v[j]) * (sc.v[j] + 1.f) + sf.v[j];
    } else {
#pragma unroll
        for (int j = 0; j < 4; ++j) y.v[j] = x.v[j] * rs * gv.v[j];
    }
    return y;
}
__device__ __forceinline__ void jrow_split(int row, int& b, int& j) { b = row / RPB; j = row - b * RPB; }

__device__ __forceinline__ void split_hl(const float (&v)[8], bf16x8& hi, bf16x8& lo) {
#pragma unroll
    for (int j = 0; j < 8; ++j) { const unsigned hb = f2bf(v[j]); hi[j] = (short)hb; lo[j] = (short)f2bf(v[j] - __builtin_bit_cast(float, hb << 16)); }
}
__device__ __forceinline__ void p_filter_stage_b(Frame& F, const Args& a, const int rank, const int nblk) {
    const int F_lane = lane_id();
    const float* w3 = a.in[I_HYW3]; const float* HD2 = (const float*)(F.ws + WS_HD2);
    const int gw = rank * NWAVES + F.wave, NGW = nblk * NWAVES;
    const float mind = logf(1e-2f) / 1.5f, maxd = logf(1e-2f) / 0.3f;
    const int lr = F_lane & 15, lg = F_lane >> 4;
    for (int wu = gw; wu < 68 * 32; wu += NGW) {
        const int tc = wu >> 5, cchunk = wu & 31; const bool isc = tc >= 64; const int n = isc ? 256 : 4096; const int t0 = (isc ? tc - 64 : tc) * 64; const int tt0 = isc ? 4096 + t0 : t0;
        float* HR = (float*)(F.ws + (isc ? WS_HRAWC : WS_HRAW)); const int colb = cchunk * 64;
        bf16x8 Ahi[4][2], Alo[4][2];
#pragma unroll
        for (int tt = 0; tt < 4; ++tt)
#pragma unroll
            for (int ks = 0; ks < 2; ++ks) { const float* hp = HD2 + (size_t)(tt0 + 16 * tt + lr) * 64 + 32 * ks + 8 * lg; const f32x4 h0 = *(const f32x4*)hp, h1 = *(const f32x4*)(hp + 4);
                const float v[8] = {h0[0], h0[1], h0[2], h0[3], h1[0], h1[1], h1[2], h1[3]}; split_hl(v, Ahi[tt][ks], Alo[tt][ks]); }
        const float rn1 = 1.f / (float)(n - 1);
#pragma unroll 1
        for (int ct = 0; ct < 4; ++ct) {
            const int col = colb + 16 * ct + lr;
            bf16x8 Bhi[2], Blo[2];
#pragma unroll
            for (int ks = 0; ks < 2; ++ks) { float v[8];
#pragma unroll
                for (int j = 0; j < 8; ++j) v[j] = w3[(size_t)(32 * ks + 8 * lg + j) * 2048 + col];
                split_hl(v, Bhi[ks], Blo[ks]); }
            const float ad = fabsf(mind + (float)(col & 511) * ((maxd - mind) / 511.f)) * LOG2E;
#pragma unroll
            for (int tt = 0; tt < 4; ++tt) { f32x4 acc = (f32x4){0.f, 0.f, 0.f, 0.f};
#pragma unroll
                for (int ks = 0; ks < 2; ++ks) { acc = __builtin_amdgcn_mfma_f32_16x16x32_bf16(Ahi[tt][ks], Bhi[ks], acc, 0, 0, 0); acc = __builtin_amdgcn_mfma_f32_16x16x32_bf16(Alo[tt][ks], Bhi[ks], acc, 0, 0, 0);
                    acc = __builtin_amdgcn_mfma_f32_16x16x32_bf16(Ahi[tt][ks], Blo[ks], acc, 0, 0, 0); }
                const int tb = t0 + 16 * tt + 4 * lg; f32x4 o;
#pragma unroll
                for (int r = 0; r < 4; ++r) o[r] = acc[r] * __builtin_amdgcn_exp2f(-((float)(tb + r) * rn1) * ad);
                *(f32x4*)(HR + (size_t)col * n + tb) = o; }
        }
    }
}

__device__ __forceinline__ bf16* x2b_row(unsigned char* ws, int b, int t) {
    const size_t base = b < 8 ? WS_WGU + (size_t)b * (8 * MiB) : (b < 12 ? WS_WDN + (size_t)(b - 8) * (8 * MiB) : WS_HRAW + (size_t)(b - 12) * (8 * MiB));
    return (bf16*)(ws + base) + (size_t)t * DM;
}
__device__ __forceinline__ const float* p1_src(const Args& a, int row) { int b, j; jrow_split(row, b, j); return j < CTXL ? a.in[I_CTX] + ((size_t)b * CTXL + j) * DM : a.in[I_X] + ((size_t)b * SEQ + (j - CTXL)) * DM; }
__device__ __forceinline__ void p_norm1_l0(Frame& F, const Args& a) {
    const int F_lane = lane_id();
    const float* MOD = (const float*)(F.ws + WS_MOD); bf16* H = (bf16*)(F.ws + WS_BUF1);
    const int gw = F.bid * NWAVES + F.wave, NGW = F.G * NWAVES;
    RowVec xn = ld_row_nt(p1_src(a, gw < NROWS ? gw : 0), F_lane);
    for (int row = gw; row < NROWS; row += NGW) { int b, j; jrow_split(row, b, j);
        const RowVec x = xn; const int rn = row + NGW < NROWS ? row + NGW : row; xn = ld_row_nt(p1_src(a, rn), F_lane);
        const float* md = MOD + (size_t)(j < CTXL ? 16 : b) * 6144;
        const RowVec y = norm_mod(x, a.in[I_N1G], md + 1024, md, F_lane);
        st_row_bf16(H + (size_t)row * DM, F_lane, y); }
}

__device__ __forceinline__ void moe_tab(Frame& F, LAS int* tab, int layer) {
    const int F_lane = lane_id(), F_tid = F.wave * 64 + F_lane; (void)F_tid;
    if (F_tid < 32) tab[64 + F_tid] = (int)__hip_atomic_load(F.ctl + CW_CNT + 64 * layer + F_tid, RLX_AGENT);
    __syncthreads();
    if (F_tid == 0) { int s = 0; for (int e = 0; e < 32; ++e) { tab[e] = s; s += (tab[64 + e] + 255) >> 8; } tab[32] = s; for (int e = 33; e < 64; ++e) tab[e] = 0x7fffffff; }
    __syncthreads();
}

constexpr int RT_HPITCH = 2064;
constexpr int RT_PART_OFF = 2 * 16 * RT_HPITCH, RT_LGS_OFF = RT_PART_OFF + 8 * 48 * 16 * 4, RT_CNT_OFF = RT_LGS_OFF + 16 * 48 * 4, RT_REC_OFF = RT_CNT_OFF + 256, RT_MAXROWS = 288;
static_assert(RT_REC_OFF + 3 * 2 * RT_MAXROWS * 4 <= MISC_OFF, "router LDS map");
template <int LAYER>
__device__ __forceinline__ void p_norm2_route(Frame& F, const Args& a) {
    const int F_lane = lane_id(), F_tid = F.wave * 64 + F_lane;
    const float* MOD = (const float*)(F.ws + WS_MOD) + (size_t)LAYER * 17 * 6144; bf16* H2 = (bf16*)(F.ws + WS_BUF1);
    LAS unsigned char* hbuf = F.lds; LAS unsigned char* hbuf_lo = F.lds + 16 * RT_HPITCH; LAS float* part = (LAS float*)(F.lds + RT_PART_OFF); LAS float* lgs = (LAS float*)(F.lds + RT_LGS_OFF);
    LAS int* lcnt = (LAS int*)(F.lds + RT_CNT_OFF); LAS int* lbase = lcnt + 32;
    LAS int* recE = (LAS int*)(F.lds + RT_REC_OFF); LAS int* recP = recE + 2 * RT_MAXROWS; LAS float* recG = (LAS float*)(recP + 2 * RT_MAXROWS);
    const float* wg = a.in[I_RTGW] + (size_t)LAYER * 1024 * 4; const float* we = a.in[I_RTEW] + (size_t)LAYER * 1024 * 32;
    const float* gb = a.in[I_RTGB] + LAYER * 4; const float* eb = a.in[I_RTEB] + LAYER * 32;
    bf16x8 Whi[3][4], Wlo[3][4];
#pragma unroll
    for (int nt = 0; nt < 3; ++nt)
#pragma unroll
        for (int ks = 0; ks < 4; ++ks) { const int o = 16 * nt + (F_lane & 15); const int k0 = 128 * F.wave + 32 * ks + 8 * (F_lane >> 4);
#pragma unroll
            for (int j = 0; j < 8; ++j) { float wv = 0.f; if (o < 4) wv = wg[(size_t)(k0 + j) * 4 + o]; else if (o < 36) wv = we[(size_t)(k0 + j) * 32 + (o - 4)];
                const unsigned hb = f2bf(wv); const float hf = __builtin_bit_cast(float, hb << 16); Whi[nt][ks][j] = (short)hb; Wlo[nt][ks][j] = (short)f2bf(wv - hf); }
            asm volatile("" : "+v"(Whi[nt][ks]), "+v"(Wlo[nt][ks]) :: "memory"); }
    if (F_tid < 64) lcnt[F_tid] = 0;
    __syncthreads();
    const int nrows = LAYER == 0 ? NROWS : NB * SEQ; const int chunk = (nrows + F.G - 1) / F.G;
    const int i0 = F.bid * chunk, i1 = (i0 + chunk < nrows) ? i0 + chunk : nrows;
    const bf16* YB = (const bf16*)(F.ws + WS_Y);
#define RT_LDX(i_) ({ RowVec xr_; if (LAYER == 0) { int b_, j_; jrow_split((i_), b_, j_); xr_ = ld_row_nt(j_ < CTXL ? a.in[I_CTX] + ((size_t)b_ * CTXL + j_) * DM : a.in[I_X] + ((size_t)b_ * SEQ + (j_ - CTXL)) * DM, F_lane); } \
    else xr_ = ld_row_bf16(x2b_row(F.ws, (i_) >> 12, (i_) & 4095), F_lane); xr_; })
#define RT_YROW(i_) (LAYER == 0 ? (i_) : ((i_) >> 12) * RPB + CTXL + ((i_) & 4095))
    RowVec xq[2]; RowRaw yq[2];
#pragma unroll
    for (int r = 0; r < 2; ++r) { const int i = (i0 + 2 * F.wave + r < i1) ? i0 + 2 * F.wave + r : i1 - 1; xq[r] = RT_LDX(i); yq[r] = ld_raw_bf16(YB + (size_t)RT_YROW(i) * DM, F_lane); }
    for (int ig = i0; ig < i1; ig += 16) {
#pragma unroll
        for (int r = 0; r < 2; ++r) {
            const int rl = 2 * F.wave + r; const bool valid = ig + rl < i1; const int i = valid ? ig + rl : i1 - 1; int row, b, j;
            if (LAYER == 0) { row = i; jrow_split(row, b, j); } else { b = i >> 12; j = CTXL + (i & 4095); row = b * RPB + j; }
            const float* md = MOD + (size_t)(j < CTXL ? 16 : b) * 6144;
            RowVec x1 = xq[r];
#pragma unroll
            for (int q = 0; q < 4; ++q) x1.v[q] = x1.v[q] + (f32x4){bflo(yq[r].w[q].x), bfhi(yq[r].w[q].x), bflo(yq[r].w[q].y), bfhi(yq[r].w[q].y)};
            const RowVec y = norm_mod(x1, a.in[I_N2G] + LAYER * 1024, md + 4 * 1024, md + 3 * 1024, F_lane);
            unsigned long long pk[4], pl[4];
#pragma unroll
            for (int q = 0; q < 4; ++q) { const unsigned h0 = f2bf(y.v[q][0]), h1 = f2bf(y.v[q][1]), h2_ = f2bf(y.v[q][2]), h3 = f2bf(y.v[q][3]);
                pk[q] = (unsigned long long)(h0 | (h1 << 16)) | ((unsigned long long)(h2_ | (h3 << 16)) << 32);
                const float l0 = y.v[q][0] - __builtin_bit_cast(float, h0 << 16), l1 = y.v[q][1] - __builtin_bit_cast(float, h1 << 16), l2 = y.v[q][2] - __builtin_bit_cast(float, h2_ << 16), l3 = y.v[q][3] - __builtin_bit_cast(float, h3 << 16);
                pl[q] = (unsigned long long)pk2(l0, l1) | ((unsigned long long)pk2(l2, l3) << 32); }
            if (valid) { unsigned long long* o8 = (unsigned long long*)(H2 + (size_t)row * DM) + F_lane;
#pragma unroll
                for (int q = 0; q < 4; ++q) o8[64 * q] = pk[q]; }
#pragma unroll
            for (int q = 0; q < 4; ++q) { *(LAS unsigned long long*)(hbuf + rl * RT_HPITCH + (4 * F_lane + 256 * q) * 2) = pk[q]; *(LAS unsigned long long*)(hbuf_lo + rl * RT_HPITCH + (4 * F_lane + 256 * q) * 2) = pl[q]; }
        }
        {   const int ign = ig + 16;
#pragma unroll
            for (int r = 0; r < 2; ++r) { const int i = (ign + 2 * F.wave + r < i1) ? ign + 2 * F.wave + r : i1 - 1; xq[r] = RT_LDX(i); yq[r] = ld_raw_bf16(YB + (size_t)RT_YROW(i) * DM, F_lane); } }
        __syncthreads();
        {   f32x4 acc[3];
#pragma unroll
            for (int nt = 0; nt < 3; ++nt) acc[nt] = (f32x4){0.f, 0.f, 0.f, 0.f};
#pragma unroll
            for (int ks = 0; ks < 4; ++ks) { const int bo = (F_lane & 15) * RT_HPITCH + (128 * F.wave + 32 * ks + 8 * (F_lane >> 4)) * 2;
                const bf16x8 bfr = *(const LAS bf16x8*)(hbuf + bo), bfl = *(const LAS bf16x8*)(hbuf_lo + bo);
#pragma unroll
                for (int nt = 0; nt < 3; ++nt) { acc[nt] = __builtin_amdgcn_mfma_f32_16x16x32_bf16(Whi[nt][ks], bfr, acc[nt], 0, 0, 0); acc[nt] = __builtin_amdgcn_mfma_f32_16x16x32_bf16(Wlo[nt][ks], bfr, acc[nt], 0, 0, 0);
                    acc[nt] = __builtin_amdgcn_mfma_f32_16x16x32_bf16(Whi[nt][ks], bfl, acc[nt], 0, 0, 0); } }
#pragma unroll
            for (int nt = 0; nt < 3; ++nt)
#pragma unroll
                for (int rg = 0; rg < 4; ++rg) part[(F.wave * 48 + 16 * nt + 4 * (F_lane >> 4) + rg) * 16 + (F_lane & 15)] = acc[nt][rg]; }
        __syncthreads();
        for (int idx = F_tid; idx < 36 * 16; idx += NTHR) { const int o = idx >> 4, r = idx & 15; float sacc = o < 4 ? gb[o] : eb[o - 4];
#pragma unroll
            for (int w = 0; w < 8; ++w) sacc += part[(w * 48 + o) * 16 + r];
            lgs[r * 48 + o] = sacc; }
        __syncthreads();
        if (F_tid < 16 && ig + F_tid < i1) {
            float lg[36];
#pragma unroll
            for (int o4 = 0; o4 < 9; ++o4) { const f32x4 t4 = *(const LAS f32x4*)(lgs + F_tid * 48 + 4 * o4); lg[4 * o4] = t4[0]; lg[4 * o4 + 1] = t4[1]; lg[4 * o4 + 2] = t4[2]; lg[4 * o4 + 3] = t4[3]; }
            int grp = 0; float gmax = lg[0];
#pragma unroll
            for (int q = 1; q < 4; ++q) if (lg[q] > gmax) { gmax = lg[q]; grp = q; }
            float den = 0.f;
#pragma unroll
            for (int q = 0; q < 4; ++q) den += __expf(lg[q] - gmax);
            const float pg = 1.f / den;
            float el[8];
#pragma unroll
            for (int q = 0; q < 8; ++q) { float v = 0.f;
#pragma unroll
                for (int g2 = 0; g2 < 4; ++g2) v = (grp == g2) ? lg[4 + 8 * g2 + q] : v;
                el[q] = v; }
            int i0e = 0; float m0 = el[0];
#pragma unroll
            for (int q = 1; q < 8; ++q) if (el[q] > m0) { m0 = el[q]; i0e = q; }
            int i1e = -1; float m1 = -INFINITY;
#pragma unroll
            for (int q = 0; q < 8; ++q) if (q != i0e && el[q] > m1) { m1 = el[q]; i1e = q; }
            const float ex = __expf(m1 - m0); const float g0 = pg / (1.f + ex), g1 = pg * ex / (1.f + ex);
            const int e0 = grp * 8 + i0e, e1 = grp * 8 + i1e; const int li = ig + F_tid - i0;
            recE[2 * li] = e0; recE[2 * li + 1] = e1; recG[2 * li] = g0; recG[2 * li + 1] = g1;
            recP[2 * li] = atomicAdd((int*)&lcnt[e0], 1); recP[2 * li + 1] = atomicAdd((int*)&lcnt[e1], 1);
        }
    }
    __syncthreads();
    const int tid2 = F.wave * 64 + lane_id();
    if (tid2 < 32) { const int c = lcnt[tid2]; lbase[tid2] = c > 0 ? (int)__hip_atomic_fetch_add(F.ctl + CW_CNT + 64 * LAYER + tid2, (unsigned)c, RLX_AGENT) : 0; }
    __syncthreads();
    int* TOK = (int*)(F.ws + WS_TOKIDX); float* GT = (float*)(F.ws + WS_GATE); int* RT = (int*)(F.ws + WS_ROUTE);
    for (int idx = tid2; idx < 2 * (i1 - i0); idx += NTHR) { const int li = idx >> 1, i = i0 + li; int row;
        if (LAYER == 0) row = i; else row = (i >> 12) * RPB + CTXL + (i & 4095);
        const int e = recE[idx], pos = lbase[e] + recP[idx];
        TOK[(size_t)e * CAP + pos] = row; GT[(size_t)e * CAP + pos] = recG[idx]; RT[(size_t)row * 4 + 2 * (idx & 1)] = e; RT[(size_t)row * 4 + 2 * (idx & 1) + 1] = pos; }
#undef RT_LDX
#undef RT_YROW
}

template <int LAYER> __device__ __forceinline__ int cmb_row(int i) { return LAYER == 0 ? i : (i >> 12) * RPB + CTXL + (i & 4095); }
template <int LAYER>
__device__ __forceinline__ void p_combine(Frame& F, const Args& a) {
    const int F_lane = lane_id(), F_tid = F.wave * 64 + F_lane; (void)F_tid;
    const float* MOD = (const float*)(F.ws + WS_MOD) + (size_t)LAYER * 17 * 6144; const float* MOD1 = (const float*)(F.ws + WS_MOD) + (size_t)17 * 6144;
    float* XC = (float*)(F.ws + WS_XC); bf16* H = (bf16*)(F.ws + WS_BUF1); const bf16* MOUT = (const bf16*)(F.ws + WS_BUF2); const int* RT = (const int*)(F.ws + WS_ROUTE); const bf16* YB = (const bf16*)(F.ws + WS_Y);
    LAS int* tab = (LAS int*)F.lds; moe_tab(F, tab, LAYER);
    const int gw = F.bid * NWAVES + F.wave, NGW = F.G * NWAVES; const int nrows = LAYER == 0 ? NROWS : NB * SEQ;
    if (gw >= nrows) return;
    typedef int i32x4 __attribute__((ext_vector_type(4)));
#define CMB_XP(row_) ({ int b_, j_; jrow_split((row_), b_, j_); j_ < CTXL ? XC + ((size_t)b_ * CTXL + j_) * DM : a.out + ((size_t)b_ * SEQ + (j_ - CTXL)) * DM; })
#define CMB_LDX(row_) ({ RowVec xr_; int b_, j_; jrow_split((row_), b_, j_); if (LAYER == 0) xr_ = ld_row_nt(j_ < CTXL ? a.in[I_CTX] + ((size_t)b_ * CTXL + j_) * DM : a.in[I_X] + ((size_t)b_ * SEQ + (j_ - CTXL)) * DM, F_lane); else xr_ = ld_row_bf16(x2b_row(F.ws, b_, j_ - CTXL), F_lane); xr_; })
    int i = gw; int row = cmb_row<LAYER>(i);
    i32x4 rt = *(const i32x4*)(RT + (size_t)row * 4);
    int i_n = i + NGW < nrows ? i + NGW : i; int row_n = cmb_row<LAYER>(i_n);
    i32x4 rt_n = *(const i32x4*)(RT + (size_t)row_n * 4);
    RowVec x = CMB_LDX(row); RowRaw yr = ld_raw_bf16(YB + (size_t)row * DM, F_lane);
    RowRaw m0 = ld_raw_bf16(MOUT + ((size_t)tab[rt[0]] * 256 + rt[1]) * DM, F_lane), m1 = ld_raw_bf16(MOUT + ((size_t)tab[rt[2]] * 256 + rt[3]) * DM, F_lane);
    for (; i < nrows; ) {
        const int i_nn = i_n + NGW < nrows ? i_n + NGW : i_n; const int row_nn = cmb_row<LAYER>(i_nn);
        const i32x4 rt_nn = *(const i32x4*)(RT + (size_t)row_nn * 4);
        const RowVec x_n = CMB_LDX(row_n); const RowRaw yr_n = ld_raw_bf16(YB + (size_t)row_n * DM, F_lane);
        const RowRaw m0_n = ld_raw_bf16(MOUT + ((size_t)tab[rt_n[0]] * 256 + rt_n[1]) * DM, F_lane), m1_n = ld_raw_bf16(MOUT + ((size_t)tab[rt_n[2]] * 256 + rt_n[3]) * DM, F_lane);
        int b, j; jrow_split(row, b, j); float* xp = CMB_XP(row); const int mb = j < CTXL ? 16 : b;
        const RowVec g5 = ld_row(MOD + (size_t)mb * 6144 + 5 * 1024, F_lane);
#pragma unroll
        for (int q = 0; q < 4; ++q) { const f32x4 a0 = (f32x4){bflo(m0.w[q].x), bfhi(m0.w[q].x), bflo(m0.w[q].y), bfhi(m0.w[q].y)}, a1 = (f32x4){bflo(m1.w[q].x), bfhi(m1.w[q].x), bflo(m1.w[q].y), bfhi(m1.w[q].y)};
            x.v[q] = (x.v[q] + (f32x4){bflo(yr.w[q].x), bfhi(yr.w[q].x), bflo(yr.w[q].y), bfhi(yr.w[q].y)}) + g5.v[q] * (a0 + a1); }
        if (LAYER == 0) { if (j >= CTXL) st_row_bf16_nt(x2b_row(F.ws, b, j - CTXL), F_lane, x); const float* md = MOD1 + (size_t)mb * 6144; const RowVec y = norm_mod(x, a.in[I_N1G] + 1024, md + 1024, md, F_lane); st_row_bf16(H + (size_t)row * DM, F_lane, y); }
        else { const RowVec y = norm_mod(x, a.in[I_FNG], nullptr, nullptr, F_lane); st_row_nt(xp, F_lane, y); }
        if (i + NGW >= nrows) break;
        i = i_n; row = row_n; x = x_n; yr = yr_n; m0 = m0_n; m1 = m1_n; i_n = i_nn; row_n = row_nn; rt_n = rt_nn;
    }
#undef CMB_XP
#undef CMB_LDX
}

__device__ __forceinline__ void p_transpose_y(Frame& F) {
    const int F_lane = lane_id();
    const bf16* YT = (const bf16*)(F.ws + WS_BUF4); bf16* YM = (bf16*)(F.ws + WS_BUF1);
    LAS unsigned short* t = (LAS unsigned short*)(F.lds + F.wave * 9216);
    const int gw = F.bid * NWAVES + F.wave, NGW = F.G * NWAVES; const int NT_R = NROWS / 64; const int NTILES = 8 * NT_R;
    if (gw >= NTILES) return;
    u32x4 cur[8], nxt[8];
#define TY_LOAD(dst, tile_) do { const int cb_ = (tile_) / NT_R, rb_ = (tile_) % NT_R; _Pragma("unroll") for (int i = 0; i < 8; ++i) dst[i] = __builtin_nontemporal_load((const u32x4*)(YT + (size_t)(cb_ * 64 + 8 * i + (F_lane >> 3)) * NROWS + rb_ * 64 + 8 * (F_lane & 7))); } while (0)
    TY_LOAD(cur, gw);
    for (int tile = gw; tile < NTILES; tile += NGW) { const int cb = tile / NT_R, rb = tile % NT_R; const int c0 = cb * 64, r0 = rb * 64;
        const int tn = tile + NGW < NTILES ? tile + NGW : tile; TY_LOAD(nxt, tn);
#pragma unroll
        for (int i = 0; i < 8; ++i) *(LAS u32x4*)(t + (8 * i + (F_lane >> 3)) * 72 + 8 * (F_lane & 7)) = cur[i];
        LDS_WAIT(); asm volatile("" ::: "memory");
#pragma unroll
        for (int i = 0; i < 8; ++i) { const int r = 8 * i + (F_lane >> 3), cc = F_lane & 7; unsigned short e[8];
#pragma unroll
            for (int k = 0; k < 8; ++k) e[k] = t[(8 * cc + k) * 72 + r];
            u32x4 w; w.x = e[0] | ((unsigned)e[1] << 16); w.y = e[2] | ((unsigned)e[3] << 16); w.z = e[4] | ((unsigned)e[5] << 16); w.w = e[6] | ((unsigned)e[7] << 16);
            *(u32x4*)(YM + (size_t)(r0 + r) * DM + c0 + 8 * cc) = w; }
        LDS_WAIT(); asm volatile("" ::: "memory");
#pragma unroll
        for (int i = 0; i < 8; ++i) cur[i] = nxt[i];
    }
#undef TY_LOAD
}
constexpr int HY_UP = 8208;
constexpr int HY_G_OFF = 16 * HY_UP, HY_G_BYTES = 8192 * 2 + 32, HY_RED_OFF = HY_G_OFF + HY_G_BYTES;

#define LAUNDER(x) asm volatile("" : "+v"(x))
__device__ __forceinline__ void hy_load_filter(Frame& F, const float* HR, int order, int c, LAS unsigned short* GR, LAS float* red) {
    const int lane_ = lane_id();
    float v[16]; float s = 0.f; int tid = F.wave * 64 + lane_; LAUNDER(tid);
#pragma unroll
    for (int k = 0; k < 16; ++k) { const int i = tid + 512 * k; const int lag = 4096 - i; float val = 0.f;
        if (i >= 1) val = lag >= 0 ? HR[(size_t)(order * 512 + c) * 4096 + lag] : HR[(size_t)(1024 + order * 512 + c) * 4096 - lag];
        v[k] = val; s += fabsf(val); }
    s = wave_sum(s); if (lane_ == 0) red[F.wave] = s;
    __syncthreads();
    float S = 0.f;
#pragma unroll
    for (int w = 0; w < 8; ++w) S += red[w];
    const float inv = 1.f / (S + 1e-6f);
#pragma unroll
    for (int k = 0; k < 16; ++k) GR[tid + 512 * k] = (unsigned short)f2bf(v[k] * inv);
    __syncthreads();
}
__device__ __forceinline__ f32x4 sconv4(const bf16* up, int tb, int n, float w0, float w1, float w2, float bias) {
    const u32x2 w = *(const u32x2*)up; const float pv = tb > 0 ? bf2f(up[tb > 0 ? -1 : 0]) : 0.f, nx = tb + 4 < n ? bf2f(up[tb + 4 < n ? 4 : 0]) : 0.f;
    const float u0 = bflo(w.x), u1 = bfhi(w.x), u2 = bflo(w.y), u3 = bfhi(w.y);
    return (f32x4){w0 * pv + w1 * u0 + w2 * u1 + bias, w0 * u0 + w1 * u1 + w2 * u2 + bias, w0 * u1 + w1 * u2 + w2 * u3 + bias, w0 * u2 + w1 * u3 + w2 * nx + bias};
}
__device__ __forceinline__ void hy_half(f32x4 (&acc)[16], bf16x8 (&Bw)[8], unsigned (&x)[5], bf16x8& Btmp, const LAS unsigned char* xbase, const int xoff, const LAS unsigned char* bbase, const int boff, const unsigned sh,
                                        const int u, const int qlo, const int qhi, const int par, const bool binstall, const bool bprefetch, const bool xprefetch) {
    if (par == 0 && binstall) Bw[(8 - u) & 7] = Btmp;
    u32x4 w;
#pragma unroll
    for (int k = 0; k < 4; ++k) w[k] = __builtin_amdgcn_alignbit(x[k + 1], x[k], sh);
    const bf16x8 a = __builtin_bit_cast(bf16x8, w);
    if (xprefetch) {
#pragma unroll
        for (int k = 0; k < 5; ++k) x[k] = *(const LAS unsigned*)(xbase + xoff + 4 * k); }
    if (par == 0 && bprefetch) Btmp = *(const LAS bf16x8*)(bbase + boff);
    __builtin_amdgcn_sched_barrier(0);
#pragma unroll
    for (int q = 0; q < 8; ++q) if (q >= qlo && q <= qhi) { const int sl = (q - u) & 7;
        acc[2 * q + par] = __builtin_amdgcn_mfma_f32_16x16x32_bf16(a, Bw[sl], acc[2 * q + par], 0, 0, 0); }
    __builtin_amdgcn_sched_barrier(0);
}
__device__ __forceinline__ void hy_step(f32x4 (&acc)[16], bf16x8 (&Bw)[8], unsigned (&x)[5], bf16x8& Btmp, const LAS unsigned char* xbase, const int xoff, const LAS unsigned char* bbase, const int boff, const unsigned sh,
                                        const int u, const int qlo, const int qhi, const bool binstall, const bool bprefetch, const bool last) {
    hy_half(acc, Bw, x, Btmp, xbase, xoff - 32, bbase, boff, sh, u, qlo, qhi, 0, binstall, bprefetch, true);
    hy_half(acc, Bw, x, Btmp, xbase, xoff - 64, bbase, boff, sh, u, qlo, qhi, 1, false, false, !last);
}
template <int NJ, int UPITCH>
__device__ __forceinline__ void hy_conv_pass(f32x4 (&acc)[16], const LAS unsigned char* U, const LAS unsigned short* GR, int v, int lane_in) {
    int lane = lane_in; LAUNDER(lane); const int row = lane & 15, g = lane >> 4, r = row & 1;
    const unsigned sh = 16u * (unsigned)r;
    const LAS unsigned char* ub = U + row * UPITCH + g * 16;
    const LAS unsigned char* xa = (const LAS unsigned char*)GR + 2 * (32 * NJ - row + 8 * g - r) - 64 * (8 * v - (NJ - 1));
    const LAS unsigned char* bn = ub + (NJ - 2) * 64;
    bf16x8 Bw[8]; bf16x8 Btmp = *(const LAS bf16x8*)(ub + (NJ - 1) * 64); unsigned x[5];
#pragma unroll
    for (int i = 0; i < 8; ++i) Bw[i] = (bf16x8){0, 0, 0, 0, 0, 0, 0, 0};
#pragma unroll
    for (int k = 0; k < 5; ++k) x[k] = *(const LAS unsigned*)(xa + 4 * k);
    { const LAS unsigned char* xl = xa - 64 * 8; const LAS unsigned char* bl = bn - 64 * 7; asm volatile("" : "+v"(xl), "+v"(bl));
#pragma unroll
      for (int s = 0; s < 7; ++s) hy_step(acc, Bw, x, Btmp, xl, 64 * (8 - s), bl, 64 * (7 - s), sh, s + 1, 0, s, true, true, false);
      xa -= 64 * 7; bn -= 64 * 7; }
#pragma unroll 1
    for (int it = 0; it < (NJ - 8) / 8; ++it) {
        const LAS unsigned char* xl = xa - 64 * 8; const LAS unsigned char* bl = bn - 64 * 7; asm volatile("" : "+v"(xl), "+v"(bl));
#pragma unroll
        for (int u = 0; u < 8; ++u) hy_step(acc, Bw, x, Btmp, xl, 64 * (8 - u), bl, 64 * (7 - u), sh, u, 0, 7, true, true, false);
        xa -= 512; bn -= 512;
    }
    { const LAS unsigned char* xl = xa - 64 * 8; asm volatile("" : "+v"(xl));
      hy_step(acc, Bw, x, Btmp, xl, 64 * 8, ub, 0, sh, 0, 0, 7, true, false, false);
#pragma unroll
      for (int m = 1; m < 8; ++m) hy_step(acc, Bw, x, Btmp, xl, 64 * (8 - m), ub, 0, sh, m, m, 7, false, false, m == 7); }
}
__device__ __forceinline__ void hyena_latent_unit(Frame& F, const Args& a, int c) {
    const bf16* UT = (const bf16*)(F.ws + WS_BUF2); bf16* YT = (bf16*)(F.ws + WS_BUF4); const float* HR = (const float*)(F.ws + WS_HRAW);
    const int lane_ = lane_id(); const int tid_ = F.wave * 64 + lane_;
    LAS unsigned char* U = F.lds; LAS unsigned short* GR = (LAS unsigned short*)(F.lds + HY_G_OFF); LAS float* red = (LAS float*)(F.lds + HY_RED_OFF);
    const float* cw = a.in[I_HYCW]; const float* cb = a.in[I_HYCB]; const float* sk = a.in[I_HYSKIP];
#ifndef HYP
#define HYP 0
#endif
    hy_load_filter(F, HR, 0, c, GR, red);
    if (HYP == 1) { hy_load_filter(F, HR, 1, c, GR, red); hy_load_filter(F, HR, 0, c, GR, red); }
    for (int hyrep = 0; hyrep < (HYP == 2 ? 2 : 1); ++hyrep)
    {
        const float w0 = cw[c], w1 = cw[1536 + c], w2 = cw[3072 + c], bs = cb[c]; int tid = tid_; LAUNDER(tid);
        const int t8 = (tid & 511) * 8; const bf16* up0 = UT + (size_t)c * NROWS + CTXL + t8;
        u32x4 uw[16]; unsigned short upv[16], unx[16];
#pragma unroll
        for (int k = 0; k < 16; ++k) { const bf16* up = up0 + (size_t)k * RPB; uw[k] = *(const u32x4*)up; upv[k] = up[-1]; unx[k] = up[8]; }
#pragma unroll
        for (int k = 0; k < 16; ++k) {
            const float e0 = t8 > 0 ? bf2f(upv[k]) : 0.f, e9 = t8 + 8 < 4096 ? bf2f(unx[k]) : 0.f;
            const float e1 = bflo(uw[k].x), e2 = bfhi(uw[k].x), e3 = bflo(uw[k].y), e4 = bfhi(uw[k].y), e5 = bflo(uw[k].z), e6 = bfhi(uw[k].z), e7 = bflo(uw[k].w), e8 = bfhi(uw[k].w);
            u32x4 w; w.x = pk2(w0 * e0 + w1 * e1 + w2 * e2 + bs, w0 * e1 + w1 * e2 + w2 * e3 + bs); w.y = pk2(w0 * e2 + w1 * e3 + w2 * e4 + bs, w0 * e3 + w1 * e4 + w2 * e5 + bs);
            w.z = pk2(w0 * e4 + w1 * e5 + w2 * e6 + bs, w0 * e5 + w1 * e6 + w2 * e7 + bs); w.w = pk2(w0 * e6 + w1 * e7 + w2 * e8 + bs, w0 * e7 + w1 * e8 + w2 * e9 + bs);
            *(LAS u32x4*)(U + k * HY_UP + t8 * 2) = w; }
    }
    __syncthreads();
    u32x2 keep[2][16];
#pragma unroll
    for (int pass = 0; pass < 2; ++pass) {
        const int xoff = pass == 0 ? 512 : 1024;
        const float w0 = cw[xoff + c], w1 = cw[1536 + xoff + c], w2 = cw[3072 + xoff + c], bs = cb[xoff + c], skip = sk[pass * 512 + c];
#pragma unroll
        for (int sp = 0; sp < 2; ++sp) {
            const int v = 2 * F.wave + sp;
            unsigned pf0, pf1;
            { int lp = lane_; LAUNDER(lp); const bf16* pfp = UT + (size_t)(xoff + c) * NROWS + (lp & 15) * RPB + CTXL + 256 * v + (lp >> 4) * 32;
              pf0 = *(const unsigned*)pfp; pf1 = *(const unsigned*)(pfp + 128); }
            f32x4 acc[16];
#pragma unroll
            for (int i = 0; i < 16; ++i) acc[i] = (f32x4){0.f, 0.f, 0.f, 0.f};
#ifdef HY_DUP
            { hy_conv_pass<128, HY_UP>(acc, U, GR, v, lane_); f32x4 d = acc[0];
#pragma unroll
              for (int i = 1; i < 16; ++i) d = d + acc[i];
              asm volatile("" : "+v"(d) :: "memory");
#pragma unroll
              for (int i = 0; i < 16; ++i) acc[i] = d * 0.f; }
#endif
            hy_conv_pass<128, HY_UP>(acc, U, GR, v, lane_);
            asm volatile("" :: "v"(pf0), "v"(pf1) : "memory"); __builtin_amdgcn_sched_barrier(0);
            int ln = lane_; LAUNDER(ln); const int b = ln & 15, g = ln >> 4;
            const bf16* ux = UT + (size_t)(xoff + c) * NROWS + b * RPB + CTXL + 256 * v + 4 * g;
            for (int eprep = 0; eprep < (HYP == 3 ? 2 : 1); ++eprep)
#pragma unroll
            for (int tg = 0; tg < 4; ++tg) {
                u32x2 xw[4]; unsigned short xp[4], xn[4];
#pragma unroll
                for (int j = 0; j < 4; ++j) { const bf16* up = ux + 16 * (4 * tg + j); xw[j] = *(const u32x2*)up; xp[j] = up[-1]; xn[j] = up[4]; }
#pragma unroll
                for (int j = 0; j < 4; ++j) { const int ti = 4 * tg + j; const int tb = 256 * v + 16 * ti + 4 * g;
                    const float pv = tb > 0 ? bf2f(xp[j]) : 0.f, nx = tb + 4 < 4096 ? bf2f(xn[j]) : 0.f; const float u0 = bflo(xw[j].x), u1 = bfhi(xw[j].x), u2 = bflo(xw[j].y), u3 = bfhi(xw[j].y);
                    const f32x4 xx = (f32x4){w0 * pv + w1 * u0 + w2 * u1 + bs, w0 * u0 + w1 * u1 + w2 * u2 + bs, w0 * u1 + w1 * u2 + w2 * u3 + bs, w0 * u2 + w1 * u3 + w2 * nx + bs};
                    const u32x2 vw = *(const LAS u32x2*)(U + b * HY_UP + tb * 2); const f32x4 vv = (f32x4){bflo(vw.x), bfhi(vw.x), bflo(vw.y), bfhi(vw.y)};
                    const f32x4 res = xx * (acc[ti] + vv * skip); u32x2 w; w.x = pk2(res[0], res[1]); w.y = pk2(res[2], res[3]); keep[sp][ti] = w; }
                asm volatile("" : "+v"(keep[sp][4 * tg]), "+v"(keep[sp][4 * tg + 1]), "+v"(keep[sp][4 * tg + 2]), "+v"(keep[sp][4 * tg + 3]) :: "memory");
            }
        }
        __syncthreads();
        {   int ln = lane_; LAUNDER(ln); const int b = ln & 15, g = ln >> 4;
#pragma unroll
            for (int sp = 0; sp < 2; ++sp)
#pragma unroll
                for (int ti = 0; ti < 16; ++ti) { const int tb = 256 * (2 * F.wave + sp) + 16 * ti + 4 * g; *(LAS u32x2*)(U + b * HY_UP + tb * 2) = keep[sp][ti]; } }
        if (pass == 0) hy_load_filter(F, HR, 1, c, GR, red);
        else __syncthreads();
    }
    int tid3 = tid_; LAUNDER(tid3);
#pragma unroll 2
    for (int k = 0; k < 16; ++k) { const int q = tid3 + 512 * k, bb = q >> 9, t8 = (q & 511) * 8; const u32x4 w = *(const LAS u32x4*)(U + bb * HY_UP + t8 * 2);
        *(u32x4*)(YT + (size_t)c * NROWS + bb * RPB + CTXL + t8) = w; }
    __syncthreads();
}
constexpr int HC_UP = 528, HC_G_OFF = 16 * HC_UP, HC_WAVE_BYTES = HC_G_OFF + 1024 + 64;
__device__ __forceinline__ void hc_load_filter(const float* HR, int order, int c, LAS unsigned short* GR, int lane) {
    float v[8]; float s = 0.f;
#pragma unroll
    for (int k = 0; k < 8; ++k) { const int i = lane + 64 * k; const int lag = 256 - i; float val = 0.f;
        if (i >= 1) val = lag >= 0 ? HR[(size_t)(order * 512 + c) * 256 + lag] : HR[(size_t)(1024 + order * 512 + c) * 256 - lag];
        v[k] = val; s += fabsf(val); }
    const float inv = 1.f / (wave_sum(s) + 1e-6f);
#pragma unroll
    for (int k = 0; k < 8; ++k) GR[lane + 64 * k] = (unsigned short)f2bf(v[k] * inv);
    LDS_WAIT(); asm volatile("" ::: "memory");
}
__device__ __forceinline__ void hyena_ctx_wave(Frame& F, const Args& a, int c) {
    const bf16* UT = (const bf16*)(F.ws + WS_BUF2); bf16* YT = (bf16*)(F.ws + WS_BUF4); const float* HR = (const float*)(F.ws + WS_HRAWC);
    const int lane = lane_id();
    LAS unsigned char* U = F.lds + F.wave * HC_WAVE_BYTES; LAS unsigned short* GR = (LAS unsigned short*)(U + HC_G_OFF);
    const float* cw = a.in[I_HYCW]; const float* cb = a.in[I_HYCB]; const float* sk = a.in[I_HYSKIP];
    hc_load_filter(HR, 0, c, GR, lane);
    {   const float w0 = cw[c], w1 = cw[1536 + c], w2 = cw[3072 + c], bs = cb[c];
#pragma unroll 2
        for (int k = 0; k < 8; ++k) { const int q = lane + 64 * k, b = q >> 5, t8 = (q & 31) * 8; const bf16* up = UT + (size_t)c * NROWS + b * RPB + t8;
            const u32x4 uw = *(const u32x4*)up; const float e0 = t8 > 0 ? bf2f(up[-1]) : 0.f, e9 = t8 + 8 < 256 ? bf2f(up[8]) : 0.f;
            const float e1 = bflo(uw.x), e2 = bfhi(uw.x), e3 = bflo(uw.y), e4 = bfhi(uw.y), e5 = bflo(uw.z), e6 = bfhi(uw.z), e7 = bflo(uw.w), e8 = bfhi(uw.w);
            u32x4 w; w.x = pk2(w0 * e0 + w1 * e1 + w2 * e2 + bs, w0 * e1 + w1 * e2 + w2 * e3 + bs); w.y = pk2(w0 * e2 + w1 * e3 + w2 * e4 + bs, w0 * e3 + w1 * e4 + w2 * e5 + bs);
            w.z = pk2(w0 * e4 + w1 * e5 + w2 * e6 + bs, w0 * e5 + w1 * e6 + w2 * e7 + bs); w.w = pk2(w0 * e6 + w1 * e7 + w2 * e8 + bs, w0 * e7 + w1 * e8 + w2 * e9 + bs);
            *(LAS u32x4*)(U + b * HC_UP + t8 * 2) = w; }
        LDS_WAIT(); asm volatile("" ::: "memory");
    }
    const int b = lane & 15, g = lane >> 4;
#pragma unroll
    for (int pass = 0; pass < 2; ++pass) {
        const int xoff = pass == 0 ? 512 : 1024;
        const float w0 = cw[xoff + c], w1 = cw[1536 + xoff + c], w2 = cw[3072 + xoff + c], bs = cb[xoff + c], skip = sk[pass * 512 + c];
        f32x4 acc[16];
#pragma unroll
        for (int i = 0; i < 16; ++i) acc[i] = (f32x4){0.f, 0.f, 0.f, 0.f};
        hy_conv_pass<8, HC_UP>(acc, U, GR, 0, lane);
        const bf16* ux = UT + (size_t)(xoff + c) * NROWS + b * RPB + 4 * g;
        u32x2 keep[16];
#pragma unroll
        for (int ti = 0; ti < 16; ++ti) { const int tb = 16 * ti + 4 * g; const bf16* up = ux + 16 * ti; const u32x2 xw = *(const u32x2*)up;
            const float pv = tb > 0 ? bf2f(up[-1]) : 0.f, nx = tb + 4 < 256 ? bf2f(up[4]) : 0.f; const float u0 = bflo(xw.x), u1 = bfhi(xw.x), u2 = bflo(xw.y), u3 = bfhi(xw.y);
            const f32x4 xx = (f32x4){w0 * pv + w1 * u0 + w2 * u1 + bs, w0 * u0 + w1 * u1 + w2 * u2 + bs, w0 * u1 + w1 * u2 + w2 * u3 + bs, w0 * u2 + w1 * u3 + w2 * nx + bs};
            const u32x2 vw = *(const LAS u32x2*)(U + b * HC_UP + tb * 2); const f32x4 vv = (f32x4){bflo(vw.x), bfhi(vw.x), bflo(vw.y), bfhi(vw.y)};
            const f32x4 res = xx * (acc[ti] + vv * skip); keep[ti].x = pk2(res[0], res[1]); keep[ti].y = pk2(res[2], res[3]); }
        if (pass == 0) {
            LDS_WAIT(); asm volatile("" ::: "memory");
#pragma unroll
            for (int ti = 0; ti < 16; ++ti) *(LAS u32x2*)(U + b * HC_UP + (16 * ti + 4 * g) * 2) = keep[ti];
            hc_load_filter(HR, 1, c, GR, lane);
        } else {
#pragma unroll
            for (int ti = 0; ti < 16; ++ti) *(u32x2*)(YT + (size_t)c * NROWS + b * RPB + 16 * ti + 4 * g) = keep[ti];
        }
    }
    LDS_WAIT(); asm volatile("" ::: "memory");
}

constexpr int WL1_0 = W_ITEMS_L1MOE, WL1_1 = WL1_0 + 2400, WL1_2 = WL1_1 + 4000, WL1_3 = WL1_2 + 1100, WL1_4 = WL1_3 + 1100, WL1_5 = W_ITEMS_ALL;
__global__ void __launch_bounds__(NTHR, 2) fwd_kernel(Args args) {
    extern __shared__ __attribute__((aligned(16))) unsigned char lds_raw[];
    Frame F; F.lds = (LAS unsigned char*)lds_raw; F.wave = __builtin_amdgcn_readfirstlane((int)threadIdx.x >> 6); F.G = gridDim.x; F.bid = blockIdx.x;
    F.ws = args.ws; F.ctl = (gu32*)(args.ws + WS_CTL);
    unsigned char* ws = args.ws;
    volatile LAS unsigned* MISC = (volatile LAS unsigned*)(F.lds + MISC_OFF);
    { const int l0 = lane_id(); if (F.wave == 0) MISC[l0] = 0u; }
    __syncthreads();
    XcdBarrier bar; bar.bar = (unsigned*)(F.ctl + CW_BAR); bar.x = 0; bar.st = nullptr;
    if (args.one_launch) bar = xcd_barrier_post((unsigned*)(F.ctl + CW_BAR), MISC + 8, F.wave == 0 && lane_id() == 0);
    const int lo = args.ph_lo, hi = args.ph_hi;
#ifndef PHASE_MASK
#define PHASE_MASK 0xFFFFFFFFu
#endif
#define IN(k) ((((PHASE_MASK) >> (k)) & 1u) && lo <= (k) && (k) < hi)
#ifndef REP_PHASE
#define REP_PHASE -1
#endif
#ifndef REP_PART
#define REP_PART 3
#endif
#define TAIL_WEIGHTS(nu_, lo_, hi_) do { const int nu__ = (nu_); const int busy__ = nu__ - (nu__ / F.G) * F.G; if (busy__ > 0 && F.bid >= busy__) weight_items(F, args, (lo_), (hi_), F.bid - busy__, F.G - busy__); else if (busy__ == 0) weight_items(F, args, (lo_), (hi_), F.bid, F.G); __syncthreads(); } while (0)
#define PH(k, ...) if (IN(k)) { __VA_ARGS__ } if (REP_PHASE == (k) && IN(k)) { __VA_ARGS__ }
#define SEAM(k) do { if (IN(k) && IN((k) + 1)) xcd_barrier(bar, F.wave == 0 && lane_id() == 0); } while (0)
    const float* MOD0 = (const float*)(ws + WS_MOD); const float* MOD1 = MOD0 + 17 * 6144;
    LAS unsigned char* ring = F.lds;

    PH(0,  p0_prologue(F, args);) SEAM(0);
    PH(1,  p_norm1_l0(F, args);) SEAM(1);
    PH(2,
        { pg8::SchedInProj S{(const char*)(ws + WS_BUF1), (const char*)(ws + WS_WHY), (const char*)(ws + WS_WATT0), F.G, F.bid};
          pg8::EpiInProj E{pg8::EpiBf16{(bf16*)(ws + WS_BUF2), NROWS}, pg8::EpiQkv<0>{(bf16*)(ws + WS_BUF3), D_ATT0, (const f32x2*)(ws + WS_ROPE), nullptr, nullptr}};
          pg8::gemm_phase<pg8::EpiInProj, pg8::SchedInProj, true>(ring, 1024, S, E, F.wave);
          { const int busy = 9 * 272 - (9 * 272 / F.G) * F.G; if (busy > 0 && busy < F.G && F.bid >= busy) p_filter_stage_b(F, args, F.bid - busy, F.G - busy); else if (busy == 0 || busy >= F.G) p_filter_stage_b(F, args, F.bid, F.G); __syncthreads(); }
          TAIL_WEIGHTS(9 * 272, WL1_0, WL1_1); }
    ) SEAM(2);
#define P3_HY do { for (int c = F.bid; c < HYC; c += F.G) hyena_latent_unit(F, args, c); for (int c = F.bid + F.G * F.wave; c < HYC; c += F.G * NWAVES) hyena_ctx_wave(F, args, c); __syncthreads(); } while (0)
#define P3_AT do { const attn_body::bf16* QKV = (const attn_body::bf16*)(ws + WS_BUF3); attn_body::bf16* YM = (attn_body::bf16*)(ws + WS_BUF1); \
        for (int L = F.bid; L < 2048 + 128; L += F.G) { \
            if (L < 2048) { const int b = L >> 7, h = (L >> 4) & 7, qb = L & 15, q0 = qb * 256; const int lat0 = q0 >= 128 ? q0 - 128 : 0; const int lend = q0 + 384 < SEQ ? q0 + 384 : SEQ; const int NT = 4 + (lend - lat0) / 64; \
                const attn_body::bf16* base = QKV + (size_t)b * RPB * D_ATT0; \
                attn_body::attn_unit<1, D_ATT0, D_ATT0, DM, 8>(base + (size_t)(CTXL + q0) * D_ATT0 + h * 64, base + 512 + (h >> 2) * 64, base + 640 + (h >> 2) * 64, \
                    YM + ((size_t)b * RPB + CTXL + q0) * DM + 512 + h * 64, NT, lat0, q0, args.in[I_SINK][h] * LOG2E, (char*)lds_raw, F.wave, 0.f, false, false, nullptr, nullptr); } \
            else { const int r = L - 2048, b = r >> 3, h = r & 7; const attn_body::bf16* base = QKV + (size_t)b * RPB * D_ATT0; \
                attn_body::attn_unit<0, D_ATT0, D_ATT0, DM, 8>(base + h * 64, base + 512 + (h >> 2) * 64, base + 640 + (h >> 2) * 64, \
                    YM + (size_t)b * RPB * DM + 512 + h * 64, 4, 0, 0, args.in[I_SINK][h] * LOG2E, (char*)lds_raw, F.wave, 0.f, false, false, nullptr, nullptr); } } } while (0)
    if (IN(3)) {
        P3_HY; if (REP_PHASE == 3 && (REP_PART & 1)) { P3_HY; }
    } SEAM(3);
    if (IN(4)) { if (F.bid & 1) { p_transpose_y(F); __syncthreads(); } P3_AT; if (REP_PHASE == 4) { P3_AT; } if (!(F.bid & 1)) { __syncthreads(); p_transpose_y(F); } } SEAM(4);
    PH(5,
        pg8::SchedDense S; S.init(ws + WS_BUF1, ws + WS_WOUT0, NROWS, 1024, 1024, F.G, F.bid);
        pg8::EpiOut E{(bf16*)(ws + WS_Y), MOD0};
        pg8::gemm_phase<pg8::EpiOut, pg8::SchedDense, true>(ring, 1024, S, E, F.wave);
        TAIL_WEIGHTS(272 * 4, WL1_1, WL1_2);) SEAM(5);
    PH(6,  p_norm2_route<0>(F, args);) SEAM(6);
    PH(7,
        LAS int* tab = (LAS int*)(F.lds + pg8::STAGE_BYTES); moe_tab(F, tab, 0);
        pg8::SchedMoe<true> S{(const char*)(ws + WS_BUF1), (const char*)(ws + WS_WGU), (size_t)1024 * 1024 * 2, 1024, tab, (const int*)(ws + WS_TOKIDX), F.G, F.bid};
        pg8::EpiGateUp E{(bf16*)(ws + WS_BUF5)};
        pg8::gemm_phase<pg8::EpiGateUp, pg8::SchedMoe<true>, true>(ring, 1024, S, E, F.wave);
        { const int nu7 = tab[32] * 4; __syncthreads(); TAIL_WEIGHTS(nu7, WL1_2, WL1_3); }) SEAM(7);
    PH(8,
        LAS int* tab = (LAS int*)(F.lds + pg8::STAGE_BYTES); moe_tab(F, tab, 0);
        pg8::SchedMoe<false> S{(const char*)(ws + WS_BUF5), (const char*)(ws + WS_WDN), (size_t)1024 * 512 * 2, 512, tab, nullptr, F.G, F.bid};
        pg8::EpiDown E{(bf16*)(ws + WS_BUF2), (const float*)(ws + WS_GATE), tab};
        pg8::gemm_phase<pg8::EpiDown, pg8::SchedMoe<false>, true>(ring, 512, S, E, F.wave);
        { const int nu8 = tab[32] * 4; __syncthreads(); TAIL_WEIGHTS(nu8, WL1_3, WL1_4); }) SEAM(8);
    PH(9,  p_combine<0>(F, args);) SEAM(9);
    PH(10,
        pg8::SchedQkv1 S{(const char*)(ws + WS_BUF1), (const char*)(ws + WS_WQKV1), 1024, F.G, F.bid};
        pg8::EpiQkv<1> E{(bf16*)(ws + WS_BUF2), D_QKV1, (const f32x2*)(ws + WS_ROPE), args.in[I_ODQG], args.in[I_ODKG]};
        pg8::gemm_phase<pg8::EpiQkv<1>, pg8::SchedQkv1, true>(ring, 1024, S, E, F.wave);
        TAIL_WEIGHTS(256 * 6 + 32, WL1_4, WL1_5);) SEAM(10);
    PH(11,
        const attn_body::bf16* QKV = (const attn_body::bf16*)(ws + WS_BUF2); attn_body::bf16* AO = (attn_body::bf16*)(ws + WS_BUF1);
        float gqm = 0.f, gkm = 0.f; for (int d = 0; d < 64; ++d) { gqm = fmaxf(gqm, fabsf(args.in[I_ODQG][d])); gkm = fmaxf(gkm, fabsf(args.in[I_ODKG][d])); }
        const float m0 = 64.f * gqm * gkm * QSCALE * 1.02f;
        if (m0 <= 40.f) {
        for (int L = F.bid; L < 4096; L += F.G) { const int b = L >> 8, h = (L >> 4) & 15, qb = L & 15, q0 = qb * 256; const attn_body::bf16* base = QKV + (size_t)b * RPB * D_QKV1;
            const int Ln = L + F.G; const bool hn = Ln < 4096; const int bn_ = hn ? Ln >> 8 : b, hn_ = hn ? (Ln >> 4) & 15 : h, qn_ = hn ? (Ln & 15) * 256 : q0; const attn_body::bf16* basen = QKV + (size_t)bn_ * RPB * D_QKV1;
            attn_body::attn_unit<0, D_QKV1, D_QKV1, DM, 8, true>(base + (size_t)(CTXL + q0) * D_QKV1 + h * 64, base + 1024 + (h >> 2) * 64, base + 1280 + (h >> 2) * 64,
                AO + ((size_t)b * RPB + CTXL + q0) * DM + h * 64, 68, 0, 0, -INFINITY, (char*)lds_raw, F.wave, m0, L != F.bid, hn, basen + 1024 + (hn_ >> 2) * 64, basen + 1280 + (hn_ >> 2) * 64); }
        } else {
        for (int L = F.bid; L < 4096; L += F.G) { const int b = L >> 8, h = (L >> 4) & 15, qb = L & 15, q0 = qb * 256; const attn_body::bf16* base = QKV + (size_t)b * RPB * D_QKV1;
            const int Ln = L + F.G; const bool hn = Ln < 4096; const int bn_ = hn ? Ln >> 8 : b, hn_ = hn ? (Ln >> 4) & 15 : h, qn_ = hn ? (Ln & 15) * 256 : q0; const attn_body::bf16* basen = QKV + (size_t)bn_ * RPB * D_QKV1;
            attn_body::attn_unit<0, D_QKV1, D_QKV1, DM, 8, false>(base + (size_t)(CTXL + q0) * D_QKV1 + h * 64, base + 1024 + (h >> 2) * 64, base + 1280 + (h >> 2) * 64,
                AO + ((size_t)b * RPB + CTXL + q0) * DM + h * 64, 68, 0, 0, -INFINITY, (char*)lds_raw, F.wave, 0.f, L != F.bid, hn, basen + 1024 + (hn_ >> 2) * 64, basen + 1280 + (hn_ >> 2) * 64); }
        }
    ) SEAM(11);
    PH(12,
        pg8::SchedLat S{(const char*)(ws + WS_BUF1), (const char*)(ws + WS_WOUT1), 1024, 4, F.G, F.bid};
        pg8::EpiOut E{(bf16*)(ws + WS_Y), MOD1};
        pg8::gemm_phase<pg8::EpiOut, pg8::SchedLat, true>(ring, 1024, S, E, F.wave);) SEAM(12);
    PH(13,  p_norm2_route<1>(F, args);) SEAM(13);
    PH(14,
        LAS int* tab = (LAS int*)(F.lds + pg8::STAGE_BYTES); moe_tab(F, tab, 1);
        pg8::SchedMoe<true> S{(const char*)(ws + WS_BUF1), (const char*)(ws + WS_WGU) + (size_t)32 * 1024 * 1024 * 2, (size_t)1024 * 1024 * 2, 1024, tab, (const int*)(ws + WS_TOKIDX), F.G, F.bid};
        pg8::EpiGateUp E{(bf16*)(ws + WS_BUF5)};
        pg8::gemm_phase<pg8::EpiGateUp, pg8::SchedMoe<true>, true>(ring, 1024, S, E, F.wave);) SEAM(14);
    PH(15,
        LAS int* tab = (LAS int*)(F.lds + pg8::STAGE_BYTES); moe_tab(F, tab, 1);
        pg8::SchedMoe<false> S{(const char*)(ws + WS_BUF5), (const char*)(ws + WS_WDN) + (size_t)32 * 1024 * 512 * 2, (size_t)1024 * 512 * 2, 512, tab, nullptr, F.G, F.bid};
        pg8::EpiDown E{(bf16*)(ws + WS_BUF2), (const float*)(ws + WS_GATE), tab};
        pg8::gemm_phase<pg8::EpiDown, pg8::SchedMoe<false>, true>(ring, 512, S, E, F.wave);) SEAM(15);
    PH(16, p_combine<1>(F, args);)

#undef IN
#undef SEAM
}

constexpr int N_PHASES = 17;
#ifndef MK_ONE_LAUNCH
#define MK_ONE_LAUNCH 1
#endif
extern "C" void kernel_launch(void* const* d_in, const int* in_sizes, int n_in, void* d_out, int out_size, void* d_ws, size_t ws_size, hipStream_t stream) {
    static int grid = 0;
    if (grid == 0) {
        if (n_in != 32 || out_size != NB * SEQ * DM || ws_size < WS_END) { fprintf(stderr, "kernel_launch: unexpected problem (n_in %d out %d ws %zu, need ws %zu)\n", n_in, out_size, ws_size, (size_t)WS_END); grid = -1; return; }
        int dev = 0, cus = 0, per_cu = 0;
        if (hipGetDevice(&dev) != hipSuccess || hipDeviceGetAttribute(&cus, hipDeviceAttributeMultiprocessorCount, dev) != hipSuccess) { grid = -1; return; }
        if (hipFuncSetAttribute((const void*)fwd_kernel, hipFuncAttributeMaxDynamicSharedMemorySize, LDS_BYTES) != hipSuccess) { fprintf(stderr, "kernel_launch: hipFuncSetAttribute failed\n"); grid = -1; return; }
        if (hipOccupancyMaxActiveBlocksPerMultiprocessor(&per_cu, (const void*)fwd_kernel, NTHR, LDS_BYTES) != hipSuccess || per_cu < 1) fprintf(stderr, "kernel_launch: occupancy query says %d\n", per_cu);
        (void)hipGetLastError();
        grid = cus;
    }
    if (grid < 0) return;
    (void)hipMemsetAsync((char*)d_ws + WS_CTL, 0, CTL_ZERO_BYTES, stream);
    Args a{};
    for (int i = 0; i < 32; ++i) a.in[i] = (const float*)d_in[i];
    a.out = (float*)d_out; a.ws = (unsigned char*)d_ws; a.pad = 0;
    if (MK_ONE_LAUNCH) { a.ph_lo = 0; a.ph_hi = N_PHASES; a.one_launch = 1; hipLaunchKernelGGL(fwd_kernel, dim3(grid), dim3(NTHR), LDS_BYTES, stream, a); }
    else for (int p = 0; p < N_PHASES; ++p) { a.ph_lo = p; a.ph_hi = p + 1; a.one_launch = 0; hipLaunchKernelGGL(fwd_kernel, dim3(grid), dim3(NTHR), LDS_BYTES, stream, a); }
}
```

```cpp
#include <hip/hip_runtime.h>
#include <hip/hip_bf16.h>
#include <cstdio>
#include <cstdint>
#include <cmath>

#define GAS __attribute__((address_space(1)))
#define LAS __attribute__((address_space(3)))
typedef unsigned short bf16;
typedef unsigned short bf16_t;
typedef short bf16x8 __attribute__((ext_vector_type(8)));
typedef short s16x4 __attribute__((ext_vector_type(4)));
typedef float f32x2 __attribute__((ext_vector_type(2)));
typedef float f32x4 __attribute__((ext_vector_type(4)));
typedef float f32x16 __attribute__((ext_vector_type(16)));
typedef unsigned u32x2 __attribute__((ext_vector_type(2)));
typedef unsigned u32x4 __attribute__((ext_vector_type(4)));
typedef unsigned v4u __attribute__((ext_vector_type(4)));
typedef GAS unsigned gu32;

constexpr int NB = 16, SEQ = 4096, CTXL = 256, DM = 1024, RPB = SEQ + CTXL  , NROWS = NB * RPB  ;
constexpr int CT_LD = NROWS + 128;
constexpr int HYC = 512, HD = 64, NEXP = 32, DEXP = 512, NMOD = 6;
constexpr int D_IN_EVEN = 2304, D_ATT0 = 768, D_QKV1 = 1536;
constexpr float NORM_EPS = 1e-6f;
constexpr float LOG2E = 1.4426950408889634f;
constexpr float QSCALE = 0.125f * 1.4426950408889634f;
constexpr int CAP = NROWS;
constexpr int MAXSLOTS = 147456;

constexpr size_t MiB = 1u << 20;
constexpr size_t WS_CTL = 0, CTL_ZERO_BYTES = 1 * MiB;
constexpr size_t WS_MOD = 1 * MiB;
constexpr size_t WS_ROPE = 2 * MiB;
constexpr size_t WS_HD2 = 2 * MiB + 65536;
constexpr size_t WS_ROUTE = 3 * MiB + 512 * 1024;
constexpr size_t WS_TOKIDX = 5 * MiB;
constexpr size_t WS_GATE = 14 * MiB;
constexpr size_t WS_HRAW = 23 * MiB;
constexpr size_t WS_HRAWC = 55 * MiB;
constexpr size_t WS_WHY = 57 * MiB;
constexpr size_t WS_WATT0 = 60 * MiB;
constexpr size_t WS_WOUT0 = 62 * MiB;
constexpr size_t WS_WQKV1 = 64 * MiB;
constexpr size_t WS_WOUT1 = 67 * MiB;
constexpr size_t WS_WGU = 69 * MiB;
constexpr size_t WS_WDN = 197 * MiB;
constexpr size_t WS_XC = 261 * MiB;
constexpr size_t WS_BUF1 = 277 * MiB;
constexpr size_t WS_BUF2 = 413 * MiB;
constexpr size_t WS_BUF3 = 618 * MiB;
constexpr size_t WS_BUF5 = 720 * MiB;
constexpr size_t WS_BUF4 = 864 * MiB;
constexpr size_t WS_Y = 864 * MiB;
constexpr size_t WS_END = 1000 * MiB;
static_assert(WS_BUF2 + (size_t)1536 * CT_LD * 2 <= WS_BUF3 && WS_BUF4 + (size_t)512 * CT_LD * 2 <= WS_END, "padded channel-major images fit");
static_assert(WS_BUF2 + (size_t)MAXSLOTS * 1024 * 2 <= WS_BUF5, "MOUT fits BUF2+BUF3");
constexpr int CW_TMO = 0, CW_CODE = 1;
constexpr int CW_CNT = 1024;
constexpr int CW_BAR = 4096;

constexpr int LDS_BYTES = 160 * 1024 - 256;
constexpr int MISC_OFF = LDS_BYTES - 256;

#define RLX_AGENT __ATOMIC_RELAXED, __HIP_MEMORY_SCOPE_AGENT
#define LDS_WAIT() asm volatile("s_waitcnt lgkmcnt(0)" ::: "memory")
#define VM_WAIT() asm volatile("s_waitcnt vmcnt(0)" ::: "memory")
__device__ __forceinline__ unsigned f2bf(float f) { unsigned u = __builtin_bit_cast(unsigned, f); return (u + 0x7fffu + ((u >> 16) & 1u)) >> 16; }
typedef float f32x2_t_ __attribute__((ext_vector_type(2))); typedef __bf16 bf16x2_t_ __attribute__((ext_vector_type(2)));
__device__ __forceinline__ unsigned pk2(float lo, float hi) { f32x2_t_ v = {lo, hi}; bf16x2_t_ b = __builtin_convertvector(v, bf16x2_t_); return __builtin_bit_cast(unsigned, b); }
__device__ __forceinline__ float bf2f(unsigned short b) { return __builtin_bit_cast(float, (unsigned)b << 16); }
__device__ __forceinline__ float bflo(unsigned w) { return __builtin_bit_cast(float, w << 16); }
__device__ __forceinline__ float bfhi(unsigned w) { return __builtin_bit_cast(float, w & 0xffff0000u); }
__device__ __forceinline__ unsigned cvt_pk_bf16(float lo, float hi) { unsigned r; asm volatile("v_cvt_pk_bf16_f32 %0, %1, %2" : "=v"(r) : "v"(lo), "v"(hi)); return r; }
__device__ __forceinline__ float wave_sum(float v) {
#pragma unroll
    for (int o = 1; o < 64; o <<= 1) v += __shfl_xor(v, o);
    return v;
}
__device__ __forceinline__ int lane_id() { unsigned z = 0u; asm volatile("" : "+s"(z)); return (int)__builtin_amdgcn_mbcnt_hi(~0u, __builtin_amdgcn_mbcnt_lo(~0u, z)); }
__device__ __forceinline__ float silu_f(float x) { return x / (1.f + __expf(-x)); }
namespace pg8 {
constexpr int BM = 256, BK = 64, HALF = 128, HTB = HALF * BK * 2  , STAGE_BYTES = 8 * HTB, NXCD = 8, WGM = 8;
__host__ __device__ __forceinline__ int lds_byte(int r, int c) { const int st = (r >> 4) * 2 + (c >> 5), rr = r & 15, cc = c & 31, ob = rr * 64 + cc * 2; return st * 1024 + (ob ^ (((ob >> 9) & 1) << 5)); }
__host__ __device__ __forceinline__ void stage_rc(int b, int& R, int& C) { const int st = b / 1024, sb = b % 1024, swz = sb ^ (((sb >> 9) & 1) << 5); R = (st >> 1) * 16 + swz / 64; C = (st & 1) * 32 + (swz % 64) / 2; }
__host__ __device__ __forceinline__ int perm32(int rho) { const int n = rho >> 4, i = rho & 15; return 8 * (i >> 2) + 4 * n + (i & 3); }

struct Unit { int pm, pn, e, aux; };

template <class Epi, class Sched, bool ALIGN_EPI = false>
__device__ __forceinline__ void gemm_phase(LAS unsigned char* lds, const int K, const Sched& S, const Epi& E, const int wave_id) {
    const int wid = wave_id, lane = lane_id(), tid = wid * 64 + lane, wr = wid >> 2, wc = wid & 3, fr = lane & 15, fq = lane >> 4;
    const int nt = K / BK;
    int R0, C0, R1, C1; stage_rc(tid * 16, R0, C0); stage_rc(tid * 16 + 8192, R1, C1);
    unsigned voffB[2];
    voffB[0] = (unsigned)(((R0 & ~31) + perm32(R0 & 31)) * K + C0) * 2u; voffB[1] = (unsigned)(((R1 & ~31) + perm32(R1 & 31)) * K + C1) * 2u;
    const size_t kstep = (size_t)(BK * 2);
    const size_t hstep = (size_t)HALF * K * 2;
    const unsigned ldsw = (unsigned)wid * 1024u;
    const int aoff = lds_byte(wr * 64 + fr, fq * 8), boff = lds_byte(wc * 32 + fr, fq * 8);
#define PG8_SA(b, h) (((b) * 2 + (h)) * HTB)
#define PG8_SB(b, h) ((4 + (b) * 2 + (h)) * HTB)
#define PG8_STAGE2(bufoff, gbase, v0, v1) do { \
        __builtin_amdgcn_global_load_lds((const unsigned*)((const char*)(gbase) + (v0)), (LAS unsigned*)(lds + (bufoff) + ldsw), 16, 0, 0); \
        __builtin_amdgcn_global_load_lds((const unsigned*)((const char*)(gbase) + (v1)), (LAS unsigned*)(lds + (bufoff) + ldsw + 8192), 16, 0, 0); } while (0)
#define PG8_STAGEB(bufoff, gbase) PG8_STAGE2(bufoff, gbase, voffB[0], voffB[1])
#define PG8_LDA(dst, b, h) do { _Pragma("unroll") for (int m = 0; m < 4; ++m) _Pragma("unroll") for (int k = 0; k < 2; ++k) dst[m][k] = *(const LAS bf16x8*)(lds + PG8_SA(b, h) + aoff + m * 2048 + k * 1024); } while (0)
#define PG8_LDB(dst, b, h) do { _Pragma("unroll") for (int n = 0; n < 2; ++n) _Pragma("unroll") for (int k = 0; k < 2; ++k) dst[n][k] = *(const LAS bf16x8*)(lds + PG8_SB(b, h) + boff + n * 2048 + k * 1024); } while (0)
#define PG8_MMA(ai, bj, At, Bt) do { __builtin_amdgcn_s_setprio(1); _Pragma("unroll") for (int m = 0; m < 4; ++m) _Pragma("unroll") for (int n = 0; n < 2; ++n) _Pragma("unroll") for (int k = 0; k < 2; ++k) \
        acc[ai][bj][m][n] = __builtin_amdgcn_mfma_f32_16x16x32_bf16(Bt[n][k], At[m][k], acc[ai][bj][m][n], 0, 0, 0); __builtin_amdgcn_s_setprio(0); } while (0)
#define PG8_WAIT_V(n) asm volatile("s_waitcnt vmcnt(" #n ")" ::: "memory")
#define PG8_WAIT_L(n) asm volatile("s_waitcnt lgkmcnt(" #n ")" ::: "memory")
#define PG8_BAR __builtin_amdgcn_s_barrier()
#define PG8_SCHED __builtin_amdgcn_sched_barrier(0)
    Unit cur, nxt; int ui = 0;
    if (!S.next(0, cur)) return;
    f32x4 acc[2][2][4][2];
#pragma unroll
    for (int a = 0; a < 2; ++a)
#pragma unroll
        for (int b = 0; b < 2; ++b)
#pragma unroll
            for (int m = 0; m < 4; ++m)
#pragma unroll
                for (int n = 0; n < 2; ++n) acc[a][b][m][n] = (f32x4){0.f, 0.f, 0.f, 0.f};
    bf16x8 At[4][2], B0[2][2], B1[2][2];
    unsigned cv00, cv01, cv10, cv11, nv00, nv01, nv10, nv11;
    if constexpr (Sched::GATHER) { int r0, r1, r2, r3; S.a_rows(cur, R0, R1, r0, r1, r2, r3);
        cv00 = (unsigned)(r0 * K + C0) * 2u; cv01 = (unsigned)(r1 * K + C1) * 2u; cv10 = (unsigned)(r2 * K + C0) * 2u; cv11 = (unsigned)(r3 * K + C1) * 2u;
    } else { cv00 = (unsigned)(R0 * K + C0) * 2u; cv01 = (unsigned)(R1 * K + C1) * 2u; cv10 = cv00 + (unsigned)hstep; cv11 = cv01 + (unsigned)hstep; }
    nv00 = cv00; nv01 = cv01; nv10 = cv10; nv11 = cv11;
    const char* cA = S.a_base(cur); const char* cB = S.b_base(cur);
    PG8_STAGEB(PG8_SB(0, 0), cB); PG8_STAGEB(PG8_SB(0, 1), cB + hstep); PG8_STAGE2(PG8_SA(0, 0), cA, cv00, cv01); PG8_STAGE2(PG8_SA(0, 1), cA, cv10, cv11);
    if (wr == 1) PG8_BAR;
    PG8_WAIT_V(2); PG8_BAR;
    PG8_STAGEB(PG8_SB(1, 0), cB + kstep); PG8_STAGE2(PG8_SA(1, 0), cA + kstep, cv00, cv01); PG8_STAGEB(PG8_SB(1, 1), cB + hstep + kstep);
    PG8_WAIT_V(6); PG8_BAR;
    for (;;) {
        const bool has_next = S.next(ui + 1, nxt);
        const char* nA = has_next ? S.a_base(nxt) : cA; const char* nB = has_next ? S.b_base(nxt) : cB;
        if constexpr (Sched::GATHER) { if (has_next) { int r0, r1, r2, r3; S.a_rows(nxt, R0, R1, r0, r1, r2, r3);
            nv00 = (unsigned)(r0 * K + C0) * 2u; nv01 = (unsigned)(r1 * K + C1) * 2u; nv10 = (unsigned)(r2 * K + C0) * 2u; nv11 = (unsigned)(r3 * K + C1) * 2u; } else { nv00 = cv00; nv01 = cv01; nv10 = cv10; nv11 = cv11; } }
        for (int t = 0; t < nt; t += 2) {
            const bool last = (t == nt - 2);
            const char* a1 = cA + (size_t)(t + 1) * kstep;
            const char* a2 = last ? nA : cA + (size_t)(t + 2) * kstep; const char* b2 = last ? nB : cB + (size_t)(t + 2) * kstep;
            const char* a3 = a2 + kstep; const char* b3 = b2 + kstep;
            unsigned s00 = cv00, s01 = cv01, s10 = cv10, s11 = cv11;
            if constexpr (Sched::GATHER) { if (last) { s00 = nv00; s01 = nv01; s10 = nv10; s11 = nv11; } }
            PG8_LDB(B0, 0, 0); PG8_LDB(B1, 0, 1); PG8_SCHED; PG8_LDA(At, 0, 0); PG8_STAGE2(PG8_SA(1, 1), a1, cv10, cv11);
            PG8_WAIT_V(8); PG8_WAIT_L(0); PG8_BAR; PG8_MMA(0, 0, At, B0); PG8_MMA(0, 1, At, B1); PG8_BAR; PG8_SCHED;
            PG8_LDA(At, 0, 1); PG8_STAGEB(PG8_SB(0, 0), b2); PG8_STAGEB(PG8_SB(0, 1), b2 + hstep); PG8_STAGE2(PG8_SA(0, 0), a2, s00, s01);
            PG8_WAIT_V(8); PG8_WAIT_L(0); PG8_BAR; PG8_MMA(1, 0, At, B0); PG8_MMA(1, 1, At, B1); PG8_BAR; PG8_SCHED;
            PG8_LDB(B0, 1, 0); PG8_LDB(B1, 1, 1); PG8_SCHED; PG8_LDA(At, 1, 0); PG8_STAGE2(PG8_SA(0, 1), a2, s10, s11);
            PG8_WAIT_V(8); PG8_WAIT_L(0); PG8_BAR; PG8_MMA(0, 0, At, B0); PG8_MMA(0, 1, At, B1); PG8_BAR; PG8_SCHED;
            PG8_LDA(At, 1, 1); PG8_STAGEB(PG8_SB(1, 0), b3); PG8_STAGEB(PG8_SB(1, 1), b3 + hstep); PG8_STAGE2(PG8_SA(1, 0), a3, s00, s01);
            PG8_WAIT_V(8); PG8_WAIT_L(0); PG8_BAR; PG8_MMA(1, 0, At, B0); PG8_MMA(1, 1, At, B1); PG8_BAR; PG8_SCHED;
        }
        if constexpr (ALIGN_EPI) { if (wr == 0) PG8_BAR; }
        E(acc, cur, wr, wc, fr, fq);
        if (!has_next) break;
#pragma unroll
        for (int a = 0; a < 2; ++a)
#pragma unroll
            for (int b = 0; b < 2; ++b)
#pragma unroll
                for (int m = 0; m < 4; ++m)
#pragma unroll
                    for (int n = 0; n < 2; ++n) acc[a][b][m][n] = (f32x4){0.f, 0.f, 0.f, 0.f};
        cur = nxt; cA = nA; cB = nB; ++ui; cv00 = nv00; cv01 = nv01; cv10 = nv10; cv11 = nv11;
        if constexpr (ALIGN_EPI) { if (wr == 1) PG8_BAR; }
    }
    PG8_WAIT_V(0);
    if constexpr (!ALIGN_EPI) { if (wr == 0) PG8_BAR; }
    PG8_BAR;
#undef PG8_SA
#undef PG8_SB
#undef PG8_STAGE2
#undef PG8_STAGEB
#undef PG8_LDA
#undef PG8_LDB
#undef PG8_MMA
#undef PG8_WAIT_V
#undef PG8_WAIT_L
#undef PG8_BAR
#undef PG8_SCHED
}
}
namespace pg8 {
__device__ __forceinline__ int xcd_remap(int L, int n) { const int q = n / NXCD, r = n % NXCD, xcd = L % NXCD, off = L / NXCD; return (xcd < r ? xcd * (q + 1) : r * (q + 1) + (xcd - r) * q) + off; }
struct SchedDense {
    static constexpr bool GATHER = false;
    const char* A; const char* Bt; int K; int nM, nN, nwg, G, c;
    __device__ __forceinline__ void init(const void* A_, const void* Bt_, int M, int N, int K_, int G_, int c_) { A = (const char*)A_; Bt = (const char*)Bt_; K = K_; nM = M / BM; nN = N / BM; nwg = nM * nN; G = G_; c = c_; }
    __device__ __forceinline__ bool next(int i, Unit& u) const {
        const long L = (long)i * G + c; if (L >= nwg) return false;
        int wgid = (int)L; { const int q = nwg / NXCD, r = nwg % NXCD, xcd = wgid % NXCD, off = wgid / NXCD; wgid = (xcd < r ? xcd * (q + 1) : r * (q + 1) + (xcd - r) * q) + off; }
        const int nig = WGM * nN, gid = wgid / nig, fm = gid * WGM, gsz = (nM - fm) < WGM ? (nM - fm) : WGM;
        u.pm = fm + ((wgid % nig) % gsz); u.pn = (wgid % nig) / gsz; u.e = 0; u.aux = 0; return true;
    }
    __device__ __forceinline__ const char* a_base(const Unit& u) const { return A + (size_t)u.pm * BM * K * 2; }
    __device__ __forceinline__ const char* b_base(const Unit& u) const { return Bt + (size_t)u.pn * BM * K * 2; }
    __device__ __forceinline__ void a_rows(const Unit&, int, int, int&, int&, int&, int&) const {}
};
struct SchedQkv1 {
    static constexpr bool GATHER = false;
    const char* A; const char* Bt; int K; int G, c;
    __device__ __forceinline__ bool next(int i, Unit& u) const {
        const int L0 = i * G + c; if (L0 >= 256 * 6 + 32) return false; const int L = xcd_remap(L0, 256 * 6 + 32); const int NL = 256 * 6;
        if (L < NL) { const int g = L / 48, w = L % 48; const int lt = g * 8 + (w % 8); u.pn = w / 8; u.pm = (lt / 16) * 17 + 1 + (lt % 16); u.e = 0; u.aux = 0; return true; }
        const int r = L - NL; if (r >= 32) return false;
        u.pm = (r >> 1) * 17; u.pn = 4 + (r & 1); u.e = 0; u.aux = 0; return true;
    }
    __device__ __forceinline__ const char* a_base(const Unit& u) const { return A + (size_t)u.pm * BM * K * 2; }
    __device__ __forceinline__ const char* b_base(const Unit& u) const { return Bt + (size_t)u.pn * BM * K * 2; }
    __device__ __forceinline__ void a_rows(const Unit&, int, int, int&, int&, int&, int&) const {}
};
struct SchedInProj {
    static constexpr bool GATHER = false;
    const char* H; const char* Why; const char* Watt; int G, c;
    __device__ __forceinline__ bool next(int i, Unit& u) const {
        const int L0 = i * G + c; if (L0 >= 9 * 272) return false; const int L = xcd_remap(L0, 9 * 272); const int N0 = 6 * 272;
        if (L < N0) { u.e = 0; u.pn = L / 6; u.pm = L % 6; u.aux = 0; return true; }
        const int r = L - N0; if (r >= 3 * 272) return false;
        u.e = 1; const int g = r / 24, w = r % 24; u.pm = g * 8 + (w % 8); u.pn = w / 8; u.aux = 0; return true;
    }
    __device__ __forceinline__ const char* a_base(const Unit& u) const { return (u.e == 0 ? Why : H) + (size_t)u.pm * BM * 1024 * 2; }
    __device__ __forceinline__ const char* b_base(const Unit& u) const { return (u.e == 0 ? H : Watt) + (size_t)u.pn * BM * 1024 * 2; }
    __device__ __forceinline__ void a_rows(const Unit&, int, int, int&, int&, int&, int&) const {}
};
struct SchedLat {
    static constexpr bool GATHER = false;
    const char* A; const char* Bt; int K; int nN; int G, c;
    __device__ __forceinline__ bool next(int i, Unit& u) const {
        const int L0 = i * G + c; if (L0 >= 256 * nN) return false; const int L = xcd_remap(L0, 256 * nN);
        const int per = 8 * nN; const int g = L / per, w = L % per; const int lt = g * 8 + (w % 8); u.pn = w / 8; u.pm = (lt / 16) * 17 + 1 + (lt % 16); u.e = 0; u.aux = 0; return true;
    }
    __device__ __forceinline__ const char* a_base(const Unit& u) const { return A + (size_t)u.pm * BM * K * 2; }
    __device__ __forceinline__ const char* b_base(const Unit& u) const { return Bt + (size_t)u.pn * BM * K * 2; }
    __device__ __forceinline__ void a_rows(const Unit&, int, int, int&, int&, int&, int&) const {}
};
template <bool GATH>
struct SchedMoe {
    static constexpr bool GATHER = GATH;
    const char* A; const char* W; size_t wstride; int K; const LAS int* tab; const int* tokidx; int G, c;
    __device__ __forceinline__ bool next(int i, Unit& u) const {
        const int L0 = i * G + c; const int nu = tab[32] * 4; if (L0 >= nu) return false; const int L = xcd_remap(L0, nu); const int tau = L >> 2;
        int e = 0;
#pragma unroll 1
        for (int s = 16; s >= 1; s >>= 1) if (tab[e + s] <= tau) e += s;
        u.pm = tau; u.pn = L & 3; u.e = e; u.aux = tau - tab[e]; return true;
    }
    __device__ __forceinline__ const char* a_base(const Unit& u) const { return GATH ? A : A + (size_t)u.pm * BM * K * 2; }
    __device__ __forceinline__ const char* b_base(const Unit& u) const { return W + (size_t)u.e * wstride + (size_t)u.pn * BM * K * 2; }
    __device__ __forceinline__ void a_rows(const Unit& u, int R0, int R1, int& r0, int& r1, int& r2, int& r3) const {
        const int cnt = tab[64 + u.e]; const int* ti = tokidx + (size_t)u.e * CAP; const int p = u.aux * BM;
        int p0 = p + R0, p1 = p + R1, p2 = p + 128 + R0, p3 = p + 128 + R1;
        p0 = p0 < cnt ? p0 : 0; p1 = p1 < cnt ? p1 : 0; p2 = p2 < cnt ? p2 : 0; p3 = p3 < cnt ? p3 : 0;
        r0 = ti[p0]; r1 = ti[p1]; r2 = ti[p2]; r3 = ti[p3];
    }
};

struct EpiBf16 {
    bf16* O; int ldc;
    __device__ __forceinline__ void operator()(const f32x4 (&acc)[2][2][4][2], const Unit& u, int wr, int wc, int fr, int fq) const {
        const int row0 = u.pm * BM + wr * 64 + fr, col0 = u.pn * BM + wc * 32 + 8 * fq;
#pragma unroll
        for (int ai = 0; ai < 2; ++ai)
#pragma unroll
            for (int m = 0; m < 4; ++m) { bf16* rowp = O + (size_t)(row0 + ai * HALF + m * 16) * ldc + col0;
#pragma unroll
                for (int bj = 0; bj < 2; ++bj) { const f32x4 v0 = acc[ai][bj][m][0], v1 = acc[ai][bj][m][1];
                    u32x4 w; w.x = cvt_pk_bf16(v0[0], v0[1]); w.y = cvt_pk_bf16(v0[2], v0[3]); w.z = cvt_pk_bf16(v1[0], v1[1]); w.w = cvt_pk_bf16(v1[2], v1[3]);
                    *(u32x4*)(rowp + bj * HALF) = w; } }
    }
};
template <int LAYER>
struct EpiQkv {
    bf16* O; int ldc; const f32x2* rope  ; const float* qg; const float* kg;
    __device__ __forceinline__ void operator()(const f32x4 (&acc)[2][2][4][2], const Unit& u, int wr, int wc, int fr, int fq) const {
        const bool ctx = (u.pm % 17) == 0;
        const int jrow0 = u.pm * BM + wr * 64 + fr;
        const int t0 = ((u.pm % 17) - 1) * BM + wr * 64 + fr;
#pragma unroll
        for (int bj = 0; bj < 2; ++bj) {
            int kind;
            if (LAYER == 0) kind = (u.pn < 2) ? 0 : (bj == 0 ? 1 : 2); else kind = (u.pn < 4) ? 0 : (u.pn == 4 ? 1 : 2);
            const bool l0kv = (LAYER == 0 && u.pn == 2);
            const int half = l0kv ? (wc & 1) : bj;
            const int colb = l0kv ? (u.pn * BM + bj * HALF + wc * 32) : (u.pn * BM + wc * 64 + bj * 32);
#pragma unroll
            for (int ai = 0; ai < 2; ++ai)
#pragma unroll
                for (int m = 0; m < 4; ++m) {
                    f32x4 v0 = acc[ai][bj][m][0], v1 = acc[ai][bj][m][1];
                    const int roff = ai * HALF + m * 16;
                    if (LAYER == 1 && kind != 2) {
                        const f32x4 w0 = acc[ai][bj ^ 1][m][0], w1 = acc[ai][bj ^ 1][m][1];
                        float ss = (v0[0] * v0[0] + v0[1] * v0[1]) + (v0[2] * v0[2] + v0[3] * v0[3]) + (v1[0] * v1[0] + v1[1] * v1[1]) + (v1[2] * v1[2] + v1[3] * v1[3])
                                 + (w0[0] * w0[0] + w0[1] * w0[1]) + (w0[2] * w0[2] + w0[3] * w0[3]) + (w1[0] * w1[0] + w1[1] * w1[1]) + (w1[2] * w1[2] + w1[3] * w1[3]);
                        ss += __shfl_xor(ss, 16); ss += __shfl_xor(ss, 32);
                        const float rs = rsqrtf(ss * (1.f / 64.f) + NORM_EPS);
                        const float* g = (kind == 0 ? qg : kg) + 32 * bj;
                        const f32x4 g0 = *(const f32x4*)(g + 4 * fq), g1 = *(const f32x4*)(g + 16 + 4 * fq);
                        v0 = v0 * rs * g0; v1 = v1 * rs * g1;
                    }
                    if (kind != 2 && !ctx) {
                        const int t = t0 + roff; const int pos = half == 0 ? (t >> 6) : (t & 63);
                        const f32x2* rp = rope + pos * 16 + 4 * fq;
                        f32x4 a, b;
#pragma unroll
                        for (int i = 0; i < 4; ++i) { const f32x2 cs = rp[i]; a[i] = v0[i] * cs.x - v1[i] * cs.y; b[i] = v1[i] * cs.x + v0[i] * cs.y; }
                        v0 = a; v1 = b;
                    }
                    if (kind == 0) { v0 = v0 * QSCALE; v1 = v1 * QSCALE; }
                    u32x4 w; w.x = cvt_pk_bf16(v0[0], v0[1]); w.y = cvt_pk_bf16(v0[2], v0[3]); w.z = cvt_pk_bf16(v1[0], v1[1]); w.w = cvt_pk_bf16(v1[2], v1[3]);
                    *(u32x4*)(O + (size_t)(jrow0 + roff) * ldc + colb + 8 * fq) = w;
                }
        }
    }
};
struct EpiInProj {
    EpiBf16 e0; EpiQkv<0> e1;
    __device__ __forceinline__ void operator()(const f32x4 (&acc)[2][2][4][2], const Unit& u, int wr, int wc, int fr, int fq) const { if (u.e == 0) e0(acc, u, wr, wc, fr, fq); else e1(acc, u, wr, wc, fr, fq); }
};
struct EpiOut {
    bf16* Y; const float* mod  ;
    __device__ __forceinline__ void operator()(const f32x4 (&acc)[2][2][4][2], const Unit& u, int wr, int wc, int fr, int fq) const {
        const int b = u.pm / 17, j = u.pm % 17; const bool ctx = (j == 0);
        const float* g = mod + ((size_t)(ctx ? 16 : b) * NMOD + 2) * DM;
        const int row0 = u.pm * BM + wr * 64 + fr, col0 = u.pn * BM + wc * 32 + 8 * fq;
        f32x4 gv[2][2];
#pragma unroll
        for (int bj = 0; bj < 2; ++bj)
#pragma unroll
            for (int n = 0; n < 2; ++n) gv[bj][n] = *(const f32x4*)(g + col0 + bj * HALF + 4 * n);
#pragma unroll
        for (int ai = 0; ai < 2; ++ai)
#pragma unroll
            for (int m = 0; m < 4; ++m) { bf16* rowp = Y + (size_t)(row0 + ai * HALF + m * 16) * DM + col0;
#pragma unroll
                for (int bj = 0; bj < 2; ++bj) { const f32x4 v0 = acc[ai][bj][m][0] * gv[bj][0], v1 = acc[ai][bj][m][1] * gv[bj][1];
                    u32x4 w; w.x = cvt_pk_bf16(v0[0], v0[1]); w.y = cvt_pk_bf16(v0[2], v0[3]); w.z = cvt_pk_bf16(v1[0], v1[1]); w.w = cvt_pk_bf16(v1[2], v1[3]);
                    *(u32x4*)(rowp + bj * HALF) = w; } }
    }
};
struct EpiGateUp {
    bf16* HID;
    __device__ __forceinline__ void operator()(const f32x4 (&acc)[2][2][4][2], const Unit& u, int wr, int wc, int fr, int fq) const {
        const int row0 = u.pm * BM + wr * 64 + fr, col0 = u.pn * 128 + wc * 32 + 8 * fq;
#pragma unroll
        for (int ai = 0; ai < 2; ++ai)
#pragma unroll
            for (int m = 0; m < 4; ++m) {
                const f32x4 g0 = acc[ai][0][m][0], g1 = acc[ai][0][m][1], u0 = acc[ai][1][m][0], u1 = acc[ai][1][m][1];
                float h[8];
#pragma unroll
                for (int i = 0; i < 4; ++i) { h[i] = g0[i] / (1.f + __expf(-g0[i])) * u0[i]; h[4 + i] = g1[i] / (1.f + __expf(-g1[i])) * u1[i]; }
                u32x4 w; w.x = cvt_pk_bf16(h[0], h[1]); w.y = cvt_pk_bf16(h[2], h[3]); w.z = cvt_pk_bf16(h[4], h[5]); w.w = cvt_pk_bf16(h[6], h[7]);
                *(u32x4*)(HID + (size_t)(row0 + ai * HALF + m * 16) * DEXP + col0) = w; }
    }
};
struct EpiDown {
    bf16* MOUT; const float* gate; const LAS int* tab;
    __device__ __forceinline__ void operator()(const f32x4 (&acc)[2][2][4][2], const Unit& u, int wr, int wc, int fr, int fq) const {
        const int r0 = wr * 64 + fr, col0 = u.pn * BM + wc * 32 + 8 * fq; const int cnt = tab[64 + u.e]; const float* gp = gate + (size_t)u.e * CAP;
#pragma unroll
        for (int ai = 0; ai < 2; ++ai)
#pragma unroll
            for (int m = 0; m < 4; ++m) { const int r = r0 + ai * HALF + m * 16; const int pos = u.aux * BM + r; const float gt = pos < cnt ? gp[pos] : 0.f;
                bf16* rowp = MOUT + (size_t)(u.pm * BM + r) * DM + col0;
#pragma unroll
                for (int bj = 0; bj < 2; ++bj) { const f32x4 v0 = acc[ai][bj][m][0] * gt, v1 = acc[ai][bj][m][1] * gt;
                    u32x4 w; w.x = cvt_pk_bf16(v0[0], v0[1]); w.y = cvt_pk_bf16(v0[2], v0[3]); w.z = cvt_pk_bf16(v1[0], v1[1]); w.w = cvt_pk_bf16(v1[2], v1[3]);
                    *(u32x4*)(rowp + bj * HALF) = w; } }
    }
};
}
namespace attn_body {
using bf16=__hip_bfloat16;
using bf16x8=__attribute__((ext_vector_type(8)))short;
using s16x4=__attribute__((ext_vector_type(4)))short;
using f32x16=__attribute__((ext_vector_type(16)))float;
using u32x4=__attribute__((ext_vector_type(4)))unsigned;
constexpr int D=64;
constexpr int NW=8,QBLK=32,QB=QBLK*NW,KVBLK=64;
__device__ __forceinline__ int crow(int r,int hi){return (r&3)+8*(r>>2)+4*hi;}
#define SBAR() __builtin_amdgcn_sched_barrier(0)
__device__ __forceinline__ void swamask(f32x16&p0,f32x16&p1,int d0){
  const float NEG=-INFINITY;
  #pragma unroll
  for(int r=0;r<16;++r){const int d=d0+(r&3)+8*(r>>2); if((unsigned)(d+128)>256u)p0[r]=NEG; if((unsigned)(d+160)>256u)p1[r]=NEG;}
}

constexpr int NSLOT=3, SLOTB=8192;
constexpr int LDS_K=0, LDS_V=NSLOT*SLOTB, LDS_WS=2*NSLOT*SLOTB, LDS_OST=LDS_WS+NW*64*4, LDS_BYTES=LDS_OST+NW*4096;
constexpr float C2=0.125f*1.4426950408889634f;
__device__ __forceinline__ void glds16(const void*gsrc,unsigned lds_dst){unsigned keep;
  asm volatile("s_mov_b32 %0, m0\n\ts_mov_b32 m0, %2\n\ts_nop 0\n\tglobal_load_lds_dwordx4 %1, off\n\ts_mov_b32 m0, %0":"=&s"(keep):"v"(gsrc),"s"(lds_dst):"memory");}
__device__ __forceinline__ float max3f(float a,float b,float c){float r;asm("v_max3_f32 %0, %1, %2, %3":"=v"(r):"v"(a),"v"(b),"v"(c));return r;}
__device__ __forceinline__ float max2f(float a,float b){float r;asm("v_max_f32_e32 %0, %1, %2":"=v"(r):"v"(a),"v"(b));return r;}
__device__ __forceinline__ float fadd_s(float a,float b){float r;asm("v_add_f32_e32 %0, %1, %2":"=v"(r):"v"(a),"v"(b));return r;}
__device__ __forceinline__ float fsub_s(float a,float b){float r;asm("v_sub_f32_e32 %0, %1, %2":"=v"(r):"v"(a),"v"(b));return r;}
typedef float f32x2_t __attribute__((ext_vector_type(2))); typedef __bf16 bf16x2_t __attribute__((ext_vector_type(2)));
__device__ __forceinline__ unsigned cvtpk_s(float lo,float hi){f32x2_t v={lo,hi};bf16x2_t b=__builtin_convertvector(v,bf16x2_t);return __builtin_bit_cast(unsigned,b);}
#define WAIT_BAR(N) asm volatile("s_waitcnt vmcnt(" #N ") lgkmcnt(0)\n\ts_barrier":::"memory")

__device__ __forceinline__ void qkt(f32x16&p0,f32x16&p1,const char*Kslot,const bf16x8*qr,const f32x16&negm,int r32,int hi){
  const char*kb=Kslot+hi*1024+r32*16;
  #pragma unroll
  for(int d0=0;d0<4;++d0){
    const bf16x8 b0=*reinterpret_cast<const bf16x8*>(kb+d0*2048);
    const bf16x8 b1=*reinterpret_cast<const bf16x8*>(kb+d0*2048+512);
    if(d0==0){p0=__builtin_amdgcn_mfma_f32_32x32x16_bf16(b0,qr[0],negm,0,0,0);p1=__builtin_amdgcn_mfma_f32_32x32x16_bf16(b1,qr[0],negm,0,0,0);}
    else{p0=__builtin_amdgcn_mfma_f32_32x32x16_bf16(b0,qr[d0],p0,0,0,0);p1=__builtin_amdgcn_mfma_f32_32x32x16_bf16(b1,qr[d0],p1,0,0,0);}}
}
typedef __attribute__((address_space(3))) const char* lds_cptr;
typedef short v4i16_t __attribute__((ext_vector_type(4)));
__device__ __forceinline__ void kload8(bf16x8*kf,lds_cptr kp){
  kf[0]=*(const __attribute__((address_space(3))) bf16x8*)(kp);      kf[1]=*(const __attribute__((address_space(3))) bf16x8*)(kp+512);
  kf[2]=*(const __attribute__((address_space(3))) bf16x8*)(kp+2048); kf[3]=*(const __attribute__((address_space(3))) bf16x8*)(kp+2560);
  kf[4]=*(const __attribute__((address_space(3))) bf16x8*)(kp+4096); kf[5]=*(const __attribute__((address_space(3))) bf16x8*)(kp+4608);
  kf[6]=*(const __attribute__((address_space(3))) bf16x8*)(kp+6144); kf[7]=*(const __attribute__((address_space(3))) bf16x8*)(kp+6656);
}
__device__ __forceinline__ void kload2(bf16x8*kf,lds_cptr kp,int j){ kf[2*j]=*(const __attribute__((address_space(3))) bf16x8*)(kp+j*2048); kf[2*j+1]=*(const __attribute__((address_space(3))) bf16x8*)(kp+j*2048+512); }
__device__ __forceinline__ s16x4 vtr(lds_cptr p){ return __builtin_bit_cast(s16x4,__builtin_amdgcn_ds_read_tr16_b64_v4i16((__attribute__((address_space(3))) v4i16_t*)p)); }
__device__ __forceinline__ float rowmax(const f32x16&p0,const f32x16&p1){
  float a=max3f(p0[0],p0[1],p1[0]),b=max3f(p0[2],p0[3],p1[1]);a=max3f(a,p1[2],p1[3]);
  #pragma unroll
  for(int r=4;r<16;r+=4){a=max3f(a,p0[r],p0[r+1]);b=max3f(b,p0[r+2],p0[r+3]);a=max3f(a,p1[r],p1[r+1]);b=max3f(b,p1[r+2],p1[r+3]);}
  const float m=max2f(a,b);
  auto rr=__builtin_amdgcn_permlane32_swap(__float_as_uint(m),__float_as_uint(m),false,false);
  return max2f(__uint_as_float(rr[0]),__uint_as_float(rr[1]));
}
__device__ __forceinline__ void pv(f32x16*o,int vb,bf16x8 pa0,bf16x8 pa1,bf16x8 pa2,bf16x8 pa3){
  #pragma unroll
  for(int d0=0;d0<2;++d0){s16x4 lo[4],hi[4];
    #pragma unroll
    for(int ks=0;ks<4;++ks){
      asm volatile("ds_read_b64_tr_b16 %0,%1 offset:%c2":"=&v"(lo[ks]):"v"(vb),"i"(d0*4096+ks*1024):"memory");
      asm volatile("ds_read_b64_tr_b16 %0,%1 offset:%c2":"=&v"(hi[ks]):"v"(vb),"i"(d0*4096+ks*1024+512):"memory");}
    asm volatile("s_waitcnt lgkmcnt(0)":::"memory");SBAR();
    #define PK(k) (bf16x8){lo[k][0],lo[k][1],lo[k][2],lo[k][3],hi[k][0],hi[k][1],hi[k][2],hi[k][3]}
    o[d0]=__builtin_amdgcn_mfma_f32_32x32x16_bf16(pa0,PK(0),o[d0],0,0,0);
    o[d0]=__builtin_amdgcn_mfma_f32_32x32x16_bf16(pa1,PK(1),o[d0],0,0,0);
    o[d0]=__builtin_amdgcn_mfma_f32_32x32x16_bf16(pa2,PK(2),o[d0],0,0,0);
    o[d0]=__builtin_amdgcn_mfma_f32_32x32x16_bf16(pa3,PK(3),o[d0],0,0,0);
    #undef PK
  }
}

#ifndef ATTN_STORE16
#define ATTN_STORE16(p,v) (*(u32x4*)(p)=(v))
#endif
template<int MODE,int QP,int KP,int OP,int THRL,bool FIXM=false> __device__ __forceinline__ void attn_unit(const bf16*Qu,const bf16*__restrict__ Kh,const bf16*__restrict__ Vh,bf16*Ou,int NT,int lat0,int tq0,float sinkl2,char*shm,const int wave_id,const float m0fix,const bool pre,const bool has_next,const bf16*__restrict__ Kh_n,const bf16*__restrict__ Vh_n,const bool unused_=false){
  const int wid=wave_id,lane=lane_id(),r32=lane&31,hi=lane>>5;
  const bf16*Qw=Qu+(long)(wid*QBLK)*QP;
  const unsigned lds0=(unsigned)(uintptr_t)shm;
  float*wsf=(float*)(shm+LDS_WS)+wid*64;
  const bf16*ksrc=Kh+(long)lane*KP+wid*8;
  const bf16*vsrc=Vh+(long)(16*(wid&3)+(lane>>2))*KP+(wid>>2)*32+(lane&3)*8;
  #define KROW(t) ((long)(64*(t)+(((t)>=4)?lat0:0)))
  const unsigned kdst=lds0+LDS_K+wid*1024, vdst=lds0+LDS_V+wid*1024;
  #define DMA_K(t,slot) glds16(ksrc+KROW(t)*KP,(unsigned)__builtin_amdgcn_readfirstlane(kdst+(slot)))
  #define DMA_V(t,slot) glds16(vsrc+KROW(t)*KP,(unsigned)__builtin_amdgcn_readfirstlane(vdst+(slot)))
  const int vb0=(int)(lds0+LDS_V)+((lane>>4)&1)*32+(lane&3)*8+(4*hi+((lane&15)>>2))*64;
  const char*Kbase=shm+LDS_K; bf16x8 kf[8];
  const lds_cptr shm3=(lds_cptr)shm; const lds_cptr kp0=shm3+LDS_K+hi*1024+r32*16; const lds_cptr vp0=shm3+LDS_V+((lane>>4)&1)*32+(lane&3)*8+(4*hi+((lane&15)>>2))*64;
  if(!pre){DMA_K(0,0);DMA_V(0,0);DMA_K(1,SLOTB);}
  bf16x8 qr[4];
  #pragma unroll
  for(int d0=0;d0<4;++d0)qr[d0]=*reinterpret_cast<const bf16x8*>(&Qw[(long)r32*QP+d0*16+hi*8]);
  float mhat=0.f,l_reg=0.f;f32x16 o[2];o[0]=f32x16{};o[1]=f32x16{};f32x16 negm=f32x16{};
  if(FIXM){mhat=m0fix;
    #pragma unroll
    for(int r=0;r<16;++r)negm[r]=-m0fix;}
  asm volatile("":"+v"(negm));
  const int qrel=wid*QBLK+r32;
  const int mq=4*hi-(tq0+qrel)+lat0-256;
  #define CMASK(P0,P1,t) do{ if(MODE==1 && (t)>=4) swamask(P0,P1,mq+64*(t)); }while(0)
  bool resc=false;
  #define START(P0,P1) do{ resc=false; \
    if(!FIXM){ const float rm=rowmax(P0,P1); const float dl=rm; mhat=fadd_s(mhat,dl); \
      _Pragma("unroll") for(int r=0;r<16;++r){P0[r]=fsub_s(P0[r],dl);P1[r]=fsub_s(P1[r],dl);} \
      _Pragma("unroll") for(int r=0;r<16;++r)negm[r]=-mhat; asm volatile("":"+v"(negm)); } \
    _Pragma("unroll") for(int r=0;r<16;++r)P0[r]=__builtin_amdgcn_exp2f(P0[r]); }while(0)
  #define RESC() do{ if(resc){ asm volatile("s_waitcnt lgkmcnt(0)":::"memory"); \
      _Pragma("unroll") for(int d_=0;d_<2;++d_) _Pragma("unroll") for(int r=0;r<16;++r)o[d_][r]*=wsf[crow(r,hi)]; } }while(0)
  f32x16 pA0,pA1,pB0,pB1;
  int sl_prev=0,sl_cur=0,sl_next=SLOTB;
  #define ROT() do{sl_prev=sl_cur;sl_cur=sl_next;sl_next=(sl_next==(NSLOT-1)*SLOTB)?0:sl_next+SLOTB;}while(0)
  DMA_K(2,2*SLOTB);
  WAIT_BAR(3);
  qkt(pA0,pA1,Kbase,qr,negm,r32,hi);asm volatile("s_nop 15\n\ts_nop 7":"+v"(pA0),"+v"(pA1));CMASK(pA0,pA1,0);
  START(pA0,pA1);
  _Pragma("unroll") for(int r=0;r<16;++r)pA1[r]=__builtin_amdgcn_exp2f(pA1[r]);
  WAIT_BAR(0);
  DMA_K(3,0);DMA_V(1,SLOTB);
  ROT();
  kload8(kf,kp0+sl_cur);
  WAIT_BAR(2);
  s16x4 vlo[8],vhi[8]; u32x4 pw0,pw1,pw2,pw3;
  #define PKW(P,B) cvtpk_s(P[B],P[B+1])
  #define PAF(k) __builtin_bit_cast(bf16x8,pw##k)
  #define VFR(i) (bf16x8){vlo[i][0],vlo[i][1],vlo[i][2],vlo[i][3],vhi[i][0],vhi[i][1],vhi[i][2],vhi[i][3]}
  #define PIN(x) asm volatile("":"+v"(x))
  #define MX3(a,b,c) __builtin_fmaxf(__builtin_fmaxf((a),(b)),(c))
  #define GAPA(MF,A0,A1,A2,A3,W0,W1,PW) do{ MF; sacc+=A0; sacc+=A1; sacc+=A2; sacc+=A3; PIN(sacc); W0; W1; PIN(PW); SBAR(); }while(0)
  #define EX(v) __builtin_amdgcn_exp2f(v)
  #define GAPB(MF,X,B) do{ MF; X[B]=EX(X[B]); X[B+1]=EX(X[B+1]); X[B+2]=EX(X[B+2]); X[B+3]=EX(X[B+3]); PIN(X); SBAR(); }while(0)
  #define VRD(i) do{ vlo[i]=vtr(vp_+(((i)>>2)*4096+((i)&3)*1024)); vhi[i]=vtr(vp_+(((i)>>2)*4096+((i)&3)*1024+512)); }while(0)
  #define KRD(G,j) do{ if(G){ kload2(kf,kp0+sl_next,j); SBAR(); } }while(0)
  #define STEP(C0,C1,P0,P1,t,GK,GV,GL) do{ SBAR(); \
    const lds_cptr vp_=vp0+sl_prev; \
    VRD(0); SBAR(); float sacc=(P0[0]+P0[1]); \
    GAPA(C0=__builtin_amdgcn_mfma_f32_32x32x16_bf16(kf[0],qr[0],negm,0,0,0), P0[2],P0[3],P0[4],P0[5],     pw0[0]=PKW(P0,0), pw0[1]=PKW(P0,2), pw0); \
    VRD(4); SBAR(); GAPA(C1=__builtin_amdgcn_mfma_f32_32x32x16_bf16(kf[1],qr[0],negm,0,0,0), P0[6],P0[7],P0[8],P0[9],     pw0[2]=PKW(P0,4), pw0[3]=PKW(P0,6), pw0); \
    VRD(1); SBAR(); GAPA(C0=__builtin_amdgcn_mfma_f32_32x32x16_bf16(kf[2],qr[1],C0,0,0,0),   P0[10],P0[11],P0[12],P0[13], pw1[0]=PKW(P0,8), pw1[1]=PKW(P0,10), pw1); \
    VRD(5); SBAR(); GAPA(C1=__builtin_amdgcn_mfma_f32_32x32x16_bf16(kf[3],qr[1],C1,0,0,0),   P0[14],P0[15],P1[0],P1[1],   pw1[2]=PKW(P0,12),pw1[3]=PKW(P0,14), pw1); \
    VRD(2); SBAR(); GAPA(C0=__builtin_amdgcn_mfma_f32_32x32x16_bf16(kf[4],qr[2],C0,0,0,0),   P1[2],P1[3],P1[4],P1[5],     pw2[0]=PKW(P1,0), pw2[1]=PKW(P1,2), pw2); \
    VRD(6); SBAR(); GAPA(C1=__builtin_amdgcn_mfma_f32_32x32x16_bf16(kf[5],qr[2],C1,0,0,0),   P1[6],P1[7],P1[8],P1[9],     pw2[2]=PKW(P1,4), pw2[3]=PKW(P1,6), pw2); \
    VRD(3); SBAR(); GAPA(C0=__builtin_amdgcn_mfma_f32_32x32x16_bf16(kf[6],qr[3],C0,0,0,0),   P1[10],P1[11],P1[12],P1[13], pw3[0]=PKW(P1,8), pw3[1]=PKW(P1,10), pw3); \
    VRD(7); SBAR(); GAPA(C1=__builtin_amdgcn_mfma_f32_32x32x16_bf16(kf[7],qr[3],C1,0,0,0),   P1[14],P1[15],0.f,0.f,       pw3[2]=PKW(P1,12),pw3[3]=PKW(P1,14), pw3); \
    l_reg+=sacc; \
    if(GK){DMA_K((t)+3,sl_cur);} if(GV){DMA_V((t)+1,sl_next);} \
    CMASK(C0,C1,t); \
    if(!FIXM){ float a=MX3(C0[0],C0[1],C1[0]),b=MX3(C0[2],C0[3],C1[1]); a=MX3(a,C1[2],C1[3]); \
      _Pragma("unroll") for(int r=4;r<16;r+=4){a=MX3(a,C0[r],C0[r+1]);b=MX3(b,C0[r+2],C0[r+3]);a=MX3(a,C1[r],C1[r+1]);b=MX3(b,C1[r+2],C1[r+3]);} \
      float rm=__builtin_fmaxf(a,b); { auto rr=__builtin_amdgcn_permlane32_swap(__float_as_uint(rm),__float_as_uint(rm),false,false); rm=__builtin_fmaxf(__uint_as_float(rr[0]),__uint_as_float(rr[1])); } \
      resc=false; \
      if(__builtin_expect(__any(rm>(float)THRL),0)){ const float dl=__builtin_fmaxf(rm,0.f); mhat+=dl; \
        _Pragma("unroll") for(int r=0;r<16;++r){C0[r]-=dl;C1[r]-=dl;} \
        _Pragma("unroll") for(int r=0;r<16;++r)negm[r]=-mhat; asm volatile("":"+v"(negm)); \
        const float f=__builtin_amdgcn_exp2f(-dl); l_reg*=f; if(hi==0)wsf[r32]=f; resc=true; } } \
    SBAR(); \
    GAPB(o[0]=__builtin_amdgcn_mfma_f32_32x32x16_bf16(PAF(0),VFR(0),o[0],0,0,0), C0,0); \
    GAPB(o[1]=__builtin_amdgcn_mfma_f32_32x32x16_bf16(PAF(0),VFR(4),o[1],0,0,0), C0,4); \
    KRD(GL,0); GAPB(o[0]=__builtin_amdgcn_mfma_f32_32x32x16_bf16(PAF(1),VFR(1),o[0],0,0,0), C0,8); \
    KRD(GL,1); GAPB(o[1]=__builtin_amdgcn_mfma_f32_32x32x16_bf16(PAF(1),VFR(5),o[1],0,0,0), C0,12); \
    KRD(GL,2); GAPB(o[0]=__builtin_amdgcn_mfma_f32_32x32x16_bf16(PAF(2),VFR(2),o[0],0,0,0), C1,0); \
    KRD(GL,3); GAPB(o[1]=__builtin_amdgcn_mfma_f32_32x32x16_bf16(PAF(2),VFR(6),o[1],0,0,0), C1,4); \
    GAPB(o[0]=__builtin_amdgcn_mfma_f32_32x32x16_bf16(PAF(3),VFR(3),o[0],0,0,0), C1,8); \
    GAPB(o[1]=__builtin_amdgcn_mfma_f32_32x32x16_bf16(PAF(3),VFR(7),o[1],0,0,0), C1,12); \
    }while(0)
  int t=1;
  for(;t+5<NT;t+=2){
    STEP(pB0,pB1,pA0,pA1,t,true,true,true);     WAIT_BAR(2); RESC(); ROT();
    STEP(pA0,pA1,pB0,pB1,t+1,true,true,true);   WAIT_BAR(2); RESC(); ROT();
  }
  #define ENDW(tt) do{ if((tt)+3<NT){WAIT_BAR(2);} else if((tt)+2<NT){WAIT_BAR(1);} else {WAIT_BAR(0);} }while(0)
  for(;t+1<NT;t+=2){
    STEP(pB0,pB1,pA0,pA1,t,(t+3<NT),(t+1<NT),(t+1<NT));       ENDW(t);   RESC(); ROT();
    STEP(pA0,pA1,pB0,pB1,t+1,(t+4<NT),(t+2<NT),(t+2<NT));     ENDW(t+1); RESC(); ROT();
  }
  STEP(pB0,pB1,pA0,pA1,NT-1,false,false,false); RESC();
  { float sacc=pB0[0]+pB0[1]; _Pragma("unroll") for(int r=2;r<16;++r)sacc+=pB0[r]; _Pragma("unroll") for(int r=0;r<16;++r)sacc+=pB1[r]; l_reg+=sacc;
    pw0=(u32x4){PKW(pB0,0),PKW(pB0,2),PKW(pB0,4),PKW(pB0,6)};pw1=(u32x4){PKW(pB0,8),PKW(pB0,10),PKW(pB0,12),PKW(pB0,14)};pw2=(u32x4){PKW(pB1,0),PKW(pB1,2),PKW(pB1,4),PKW(pB1,6)};pw3=(u32x4){PKW(pB1,8),PKW(pB1,10),PKW(pB1,12),PKW(pB1,14)};
    SBAR(); pv(o,vb0+sl_cur,PAF(0),PAF(1),PAF(2),PAF(3)); }
  #undef PKW
  #undef PAF
  #undef VFR
  #undef PIN
  #undef MX3
  #undef GAPA
  #undef GAPB
  #undef EX
  #undef VRD
  #undef KRD
  #undef STEP
  #undef ENDW
  asm volatile("s_waitcnt lgkmcnt(0)\n\ts_barrier":::"memory");
  if(has_next){ const bf16*ksn=Kh_n+(long)lane*KP+wid*8; const bf16*vsn=Vh_n+(long)(16*(wid&3)+(lane>>2))*KP+(wid>>2)*32+(lane&3)*8;
    glds16(ksn,(unsigned)__builtin_amdgcn_readfirstlane(kdst)); glds16(vsn,(unsigned)__builtin_amdgcn_readfirstlane(vdst)); glds16(ksn+(long)64*KP,(unsigned)__builtin_amdgcn_readfirstlane(kdst+SLOTB));
 }
  {auto rr=__builtin_amdgcn_permlane32_swap(__float_as_uint(l_reg),__float_as_uint(l_reg),false,false);l_reg=__uint_as_float(rr[0])+__uint_as_float(rr[1]);}
  l_reg+=__builtin_amdgcn_exp2f(sinkl2-mhat);
  if(hi==0)wsf[32+r32]=l_reg;asm volatile("s_waitcnt lgkmcnt(0)":::"memory");
  float rli[16];
  #pragma unroll
  for(int r=0;r<16;++r)rli[r]=__builtin_amdgcn_rcpf(wsf[32+crow(r,hi)]);
  bf16*Ow=Ou+(long)(wid*QBLK)*OP;
  { bf16*stg=(bf16*)(shm+LDS_OST)+wid*2048;
    #pragma unroll
    for(int r=0;r<16;++r){const int orow=crow(r,hi);
      #pragma unroll
      for(int d0=0;d0<2;++d0)stg[orow*64+d0*32+r32]=__float2bfloat16(o[d0][r]*rli[r]);}
    asm volatile("s_waitcnt lgkmcnt(0)":::"memory");
    #pragma unroll
    for(int i=0;i<4;++i){const int row=i*8+(lane>>3),ch=lane&7; const u32x4 v=*(const u32x4*)(stg+row*64+ch*8); ATTN_STORE16(Ow+(long)row*OP+ch*8,v);} }
  asm volatile("s_waitcnt lgkmcnt(0)":::"memory");
  #undef DMA_K
  #undef KROW
  #undef DMA_V
  #undef CMASK
  #undef START
  #undef RESC
  #undef ROT
}
constexpr int ATTN_LDS_BYTES=LDS_BYTES;
#undef SBAR
#undef WAIT_BAR
}
#define XB_TMO      128
#define XB_XCNT(j)  (256  + 64 * (j))
#define XB_XSUB(j)  (1280 + 64 * (j))
#define XB_XGEN(j)  (2304 + 64 * (j))
#define XB_TOP      3328
#define XB_TOPGEN   3392
#define XCD_BAR_WORDS 3456
#define XB_SPIN_CAP (1u << 18)

__device__ __forceinline__ unsigned xb_ld(unsigned* p)              { return __hip_atomic_load(p, __ATOMIC_RELAXED, __HIP_MEMORY_SCOPE_AGENT); }
__device__ __forceinline__ unsigned xb_add(unsigned* p, unsigned v) { return __hip_atomic_fetch_add(p, v, __ATOMIC_RELAXED, __HIP_MEMORY_SCOPE_AGENT); }
__device__ __forceinline__ unsigned xb_xcc_id() { return (unsigned)__builtin_amdgcn_s_getreg((3 << 11) | 20) & 0xFu; }
#define XB_SPIN(cond, bar) do { unsigned _sp = 0; while (cond) { __builtin_amdgcn_s_sleep(1); \
    if ((++_sp & 255u) == 0u) { if (xb_ld(&(bar)[XB_TMO])) break; if (_sp > XB_SPIN_CAP) { atomicAdd(&(bar)[XB_TMO], 1u); break; } } } } while (0)

struct XcdBarrier {
    unsigned* bar; unsigned x;
    volatile LAS unsigned* st;
};

__device__ __forceinline__ XcdBarrier xcd_barrier_post(unsigned* bar, volatile LAS unsigned* st, const bool t0) {
    XcdBarrier b; b.bar = bar; b.x = xb_xcc_id(); b.st = st;
    if (t0) (void)xb_add(&bar[XB_XCNT(b.x)], 1u);
    return b;
}
__device__ __forceinline__ void xcd_barrier_complete(unsigned* bar, unsigned x, unsigned& nloc, unsigned& nx) {
    const unsigned G = gridDim.x * gridDim.y * gridDim.z;
    unsigned sum, cnt, mine, sp = 0u;
    for (;;) {
        sum = 0u; cnt = 0u; mine = 0u;
#pragma unroll
        for (unsigned j = 0; j < 16; ++j) { const unsigned c = xb_ld(&bar[XB_XCNT(j)]); sum += c; cnt += (c > 0u) ? 1u : 0u; mine = (j == x) ? c : mine; }
        if (sum == G) break;
        __builtin_amdgcn_s_sleep(1);
        if ((++sp & 255u) == 0u) { if (xb_ld(&bar[XB_TMO])) break; if (sp > XB_SPIN_CAP) { atomicAdd(&bar[XB_TMO], 1u); break; } }
    }
    nloc = mine > 0u ? mine : 1u; nx = cnt > 0u ? cnt : 1u;
}

__device__ __forceinline__ void xcd_barrier(const XcdBarrier& b, const bool t0) {
    asm volatile("s_waitcnt vmcnt(0)" ::: "memory");
    __syncthreads();
    if (t0) {
        unsigned* bar = b.bar;
        __builtin_amdgcn_s_waitcnt(0);
        unsigned nloc = b.st[0], nx = b.st[1];
        if (nloc == 0u) { xcd_barrier_complete(bar, b.x, nloc, nx); b.st[0] = nloc; b.st[1] = nx; }
        const unsigned old = xb_add(&bar[XB_XSUB(b.x)], 1u);
        const unsigned gen = old / nloc;
        if (old + 1u == (gen + 1u) * nloc) {
            __builtin_amdgcn_fence(__ATOMIC_RELEASE, "agent");
            asm volatile("s_waitcnt vmcnt(0)" ::: "memory");
            const unsigned og = xb_add(&bar[XB_TOP], 1u);
            const unsigned tg = og / nx;
            if (og + 1u == (tg + 1u) * nx) xb_add(&bar[XB_TOPGEN], 1u);
            else XB_SPIN(xb_ld(&bar[XB_TOPGEN]) == tg, bar);
            __builtin_amdgcn_fence(__ATOMIC_ACQUIRE, "agent");
            xb_add(&bar[XB_XGEN(b.x)], 1u);
            asm volatile("s_waitcnt vmcnt(0)" ::: "memory");
        } else {
            XB_SPIN(xb_ld(&bar[XB_XGEN(b.x)]) == gen, bar);
            __builtin_amdgcn_fence(__ATOMIC_ACQUIRE, "agent");
            asm volatile("s_waitcnt vmcnt(0)" ::: "memory");
        }
    }
    __syncthreads();
}
constexpr int NWAVES = 8, NTHR = 512;
struct Args { const float* in[32]; float* out; unsigned char* ws; int ph_lo, ph_hi, one_launch, pad; };
enum InIdx { I_X = 0, I_C, I_CTX, I_CCTX, I_ADAW, I_ADAB, I_N1G, I_N2G, I_EVWIN, I_EVWOUT, I_HYCW, I_HYCB, I_HYW1, I_HYB1, I_HYW2, I_HYB2, I_HYW3, I_HYFREQ, I_HYSKIP, I_SINK,
             I_ODWQKV, I_ODWOUT, I_ODQG, I_ODKG, I_RTGW, I_RTGB, I_RTEW, I_RTEB, I_MOEG, I_MOEU, I_MOED, I_FNG };
struct Frame {
    LAS unsigned char* lds; int wave, G, bid;
    unsigned char* ws; gu32* ctl;
};
struct TItem { const float* src; int ldw; bf16* WT; int Kd, drow0, drow1, k0; bool perm; };
__device__ __forceinline__ int qkv_drow(int n) { const int pn = n >> 8, rem = n & 255; return 256 * pn + 128 * ((rem & 63) >> 5) + 32 * (rem >> 6); }
__device__ __forceinline__ TItem decode_item(const Args& a, unsigned char* ws, int it) {
    constexpr int S1 = 16 * 24, S2 = S1 + 16 * 12, S3 = S2 + 16 * 16, S4 = S3 + 16 * 24, S5 = S4 + 16 * 16;
    TItem t; t.perm = false;
    if (it < S1) { const int kb = it / 24, nb = it % 24, n = 64 * nb; t.src = a.in[I_EVWIN] + (size_t)(64 * kb) * D_IN_EVEN + n; t.ldw = D_IN_EVEN; t.WT = (bf16*)(ws + WS_WHY); t.Kd = 1024; t.drow0 = n; t.drow1 = n + 32; t.k0 = 64 * kb; }
    else if (it < S2) { const int r = it - S1, kb = r / 12, nb = r % 12, n = 64 * nb;
        if (n < 512) { t.drow0 = qkv_drow(n); t.drow1 = qkv_drow(n + 32); t.perm = true; } else { t.drow0 = n; t.drow1 = n + 32; t.perm = n < 640; }
        t.src = a.in[I_EVWIN] + (size_t)(64 * kb) * D_IN_EVEN + 1536 + n; t.ldw = D_IN_EVEN; t.WT = (bf16*)(ws + WS_WATT0); t.Kd = 1024; t.k0 = 64 * kb; }
    else if (it < S3) { const int r = it - S2, kb = r / 16, nb = r % 16, n = 64 * nb; t.src = a.in[I_EVWOUT] + (size_t)(64 * kb) * 1024 + n; t.ldw = 1024; t.WT = (bf16*)(ws + WS_WOUT0); t.Kd = 1024; t.drow0 = n; t.drow1 = n + 32; t.k0 = 64 * kb; }
    else if (it < S4) { const int r = it - S3, kb = r / 24, nb = r % 24, n = 64 * nb;
        t.src = a.in[I_ODWQKV] + (size_t)(64 * kb) * D_QKV1 + n; t.ldw = D_QKV1; t.WT = (bf16*)(ws + WS_WQKV1); t.Kd = 1024; t.drow0 = qkv_drow(n); t.drow1 = qkv_drow(n + 32); t.k0 = 64 * kb; t.perm = n < 1280; }
    else if (it < S5) { const int r = it - S4, kb = r / 16, nb = r % 16, n = 64 * nb; t.src = a.in[I_ODWOUT] + (size_t)(64 * kb) * 1024 + n; t.ldw = 1024; t.WT = (bf16*)(ws + WS_WOUT1); t.Kd = 1024; t.drow0 = n; t.drow1 = n + 32; t.k0 = 64 * kb; }
    else { const int r = it - S5, le = r / 384, sub = r % 384;
        if (sub < 256) { const int up = sub >> 7, s2 = sub & 127, kb = s2 >> 3, nb = s2 & 7, n = 64 * nb;
            t.src = a.in[up ? I_MOEU : I_MOEG] + (size_t)le * 1024 * 512 + (size_t)(64 * kb) * 512 + n; t.ldw = 512; t.WT = (bf16*)(ws + WS_WGU) + (size_t)le * 1024 * 1024; t.Kd = 1024;
            t.drow0 = 256 * (n >> 7) + (n & 127) + 128 * up; t.drow1 = t.drow0 + 32; t.k0 = 64 * kb; }
        else { const int s2 = sub - 256, kb = s2 >> 4, nb = s2 & 15, n = 64 * nb;
            t.src = a.in[I_MOED] + (size_t)le * 512 * 1024 + (size_t)(64 * kb) * 1024 + n; t.ldw = 1024; t.WT = (bf16*)(ws + WS_WDN) + (size_t)le * 1024 * 512; t.Kd = 512; t.drow0 = n; t.drow1 = n + 32; t.k0 = 64 * kb; } }
    return t;
}
__device__ __forceinline__ int pinv32(int j) { return j < 16 ? 8 * (j >> 2) + (j & 3) : 8 * ((j - 16) >> 2) + 4 + ((j - 16) & 3); }
struct TRegs { float v[64]; };
__device__ __forceinline__ TRegs titem_load(const TItem& t, int lane) { TRegs r; const float* p = t.src + lane;
#pragma unroll
    for (int i = 0; i < 64; ++i) r.v[i] = __builtin_nontemporal_load(p + (size_t)i * t.ldw);
    return r; }
__device__ __forceinline__ void titem_store(const TItem& t, const TRegs& r, LAS float* scr, int lane) {
#pragma unroll
    for (int i = 0; i < 64; ++i) scr[i * 65 + lane] = r.v[i];
    LDS_WAIT(); asm volatile("" ::: "memory");
    const int c = lane & 7;
#pragma unroll
    for (int j = 0; j < 8; ++j) { const int n = (lane >> 3) + 8 * j; const LAS float* s = scr + (8 * c) * 65 + n;
        v4u o; o.x = pk2(s[0 * 65], s[1 * 65]); o.y = pk2(s[2 * 65], s[3 * 65]); o.z = pk2(s[4 * 65], s[5 * 65]); o.w = pk2(s[6 * 65], s[7 * 65]);
        const int nl = n & 31;
        *(GAS v4u*)(t.WT + (size_t)((j >= 4 ? t.drow1 : t.drow0) + (t.perm ? pinv32(nl) : nl)) * t.Kd + t.k0 + 8 * c) = o; }
    LDS_WAIT(); asm volatile("" ::: "memory");
}

constexpr int W_ITEMS_ALL = 16 * 24 + 16 * 12 + 16 * 16 + 16 * 24 + 16 * 16 + 64 * 384, W_ITEMS_L1MOE = W_ITEMS_ALL - 32 * 384;
__device__ __forceinline__ void weight_items(Frame& F, const Args& a, const int lo, const int hi, const int rank, const int nblk) {
    const int F_lane = lane_id();
    LAS float* scr = (LAS float*)(F.lds + F.wave * 16896);
    const int gw = lo + rank * NWAVES + F.wave, NGW = nblk * NWAVES;
    if (gw < hi) {
        TItem cur = decode_item(a, F.ws, gw); TRegs rc = titem_load(cur, F_lane);
        for (int it = gw; it < hi; it += NGW) {
            const int itn = it + NGW < hi ? it + NGW : it; const TItem nxt = decode_item(a, F.ws, itn); const TRegs rn = titem_load(nxt, F_lane);
            titem_store(cur, rc, scr, F_lane);
            cur = nxt; rc = rn;
        }
    }
}

__device__ __forceinline__ void p0_prologue(Frame& F, const Args& a) {
    const int F_lane = lane_id(), F_tid = F.wave * 64 + F_lane; (void)F_tid;
    unsigned char* ws = F.ws;
    {
        LAS float* sv = (LAS float*)F.lds; LAS float* red = (LAS float*)(F.lds + 17 * 1024 * 4);
        float* MOD = (float*)(ws + WS_MOD);
        for (int u = F.bid; u < 192; u += F.G) {
            const int l = u / 96, n0 = (u % 96) * 64;
            for (int idx = F_tid; idx < 17 * 1024; idx += NTHR) { const int b = idx >> 10, k = idx & 1023; const float v = b < 16 ? a.in[I_C][b * 1024 + k] : a.in[I_CCTX][k]; sv[idx] = silu_f(v); }
            __syncthreads();
            float acc[17];
#pragma unroll
            for (int b = 0; b < 17; ++b) acc[b] = 0.f;
            const float* Wp = a.in[I_ADAW] + (size_t)l * 1024 * 6144 + n0 + F_lane;
            for (int k0 = F.wave * 128; k0 < F.wave * 128 + 128; k0 += 16) { float wv[16];
#pragma unroll
                for (int kk = 0; kk < 16; ++kk) wv[kk] = Wp[(size_t)(k0 + kk) * 6144];
#pragma unroll
                for (int kk = 0; kk < 16; ++kk)
#pragma unroll
                    for (int b = 0; b < 17; ++b) acc[b] += sv[b * 1024 + k0 + kk] * wv[kk]; }
#pragma unroll
            for (int b = 0; b < 17; ++b) red[(F.wave * 17 + b) * 64 + F_lane] = acc[b];
            __syncthreads();
            for (int idx = F_tid; idx < 17 * 64; idx += NTHR) { const int b = idx >> 6, j = idx & 63; float s = a.in[I_ADAB][l * 6144 + n0 + j];
#pragma unroll
                for (int w = 0; w < 8; ++w) s += red[(w * 17 + b) * 64 + j];
                MOD[((size_t)l * 17 + b) * 6144 + n0 + j] = s; }
            __syncthreads();
        }
    }
    {
        const float* w1 = a.in[I_HYW1]; const float* b1 = a.in[I_HYB1]; const float* w2 = a.in[I_HYW2]; const float* b2 = a.in[I_HYB2]; const float* fr = a.in[I_HYFREQ];
        float* HD2 = (float*)(ws + WS_HD2);
        const int gw = F.bid * NWAVES + F.wave, NGW = F.G * NWAVES;
        if (gw < 4352) {
            float w1c[33], w2c[64];
#pragma unroll
            for (int i = 0; i < 33; ++i) w1c[i] = w1[i * 64 + F_lane];
#pragma unroll
            for (int i = 0; i < 64; ++i) w2c[i] = w2[i * 64 + F_lane];
            const float frl = fr[F_lane], b1l = b1[F_lane], b2l = b2[F_lane];
            for (int tt = gw; tt < 4352; tt += NGW) {
                const int n = tt < 4096 ? 4096 : 256, t = tt < 4096 ? tt : tt - 4096; const float tf = (float)t; const float tn = tf / (float)(n - 1);
                float z = 0.f;
                if (F_lane == 0) z = tn;
                else if (F_lane < 33) { const int m = (F_lane - 1) & 15; const float band = 1e-4f + (float)m * ((15.f - 1e-4f) / 15.f); const float ang = ((float)(2.0 * M_PI / (double)n) * tf) * band;
                    z = F_lane < 17 ? cosf(ang) : -sinf(ang); }
                float h1 = b1l;
#pragma unroll
                for (int i = 0; i < 33; ++i) h1 += __builtin_bit_cast(float, __builtin_amdgcn_readlane(__builtin_bit_cast(int, z), i)) * w1c[i];
                h1 = sinf(frl * h1);
                float h2 = b2l;
#pragma unroll
                for (int i = 0; i < 64; ++i) h2 += __builtin_bit_cast(float, __builtin_amdgcn_readlane(__builtin_bit_cast(int, h1), i)) * w2c[i];
                h2 = sinf(frl * h2);
                HD2[(size_t)tt * 64 + F_lane] = h2;
            }
        }
    }
    if (F.bid == 0) {
        f32x2* RT = (f32x2*)(ws + WS_ROPE);
        for (int idx = F_tid; idx < 1024; idx += NTHR) { const int pos = idx >> 4, i = idx & 15; const float inv = powf(10000.f, -(float)(2 * i) / 32.f); const float ang = (float)pos * inv; RT[idx] = (f32x2){cosf(ang), sinf(ang)}; }
    }
    weight_items(F, a, 0, W_ITEMS_L1MOE, F.bid, F.G);
    __syncthreads();
}

struct RowVec { f32x4 v[4]; };
__device__ __forceinline__ RowVec ld_row(const float* p, int lane) { RowVec r; const f32x4* q = (const f32x4*)p + lane;
#pragma unroll
    for (int j = 0; j < 4; ++j) r.v[j] = q[64 * j]; return r; }
__device__ __forceinline__ RowVec ld_row_nt(const float* p, int lane) { RowVec r; const f32x4* q = (const f32x4*)p + lane;
#pragma unroll
    for (int j = 0; j < 4; ++j) r.v[j] = __builtin_nontemporal_load(q + 64 * j); return r; }
__device__ __forceinline__ void st_row(float* p, int lane, const RowVec& r) { f32x4* q = (f32x4*)p + lane;
#pragma unroll
    for (int j = 0; j < 4; ++j) q[64 * j] = r.v[j]; }
__device__ __forceinline__ void st_row_bf16_nt(bf16* p, int lane, const RowVec& r) { unsigned long long* o8 = (unsigned long long*)p + lane;
#pragma unroll
    for (int j = 0; j < 4; ++j) __builtin_nontemporal_store((unsigned long long)pk2(r.v[j][0], r.v[j][1]) | ((unsigned long long)pk2(r.v[j][2], r.v[j][3]) << 32), o8 + 64 * j); }
__device__ __forceinline__ void st_row_nt(float* p, int lane, const RowVec& r) { f32x4* q = (f32x4*)p + lane;
#pragma unroll
    for (int j = 0; j < 4; ++j) __builtin_nontemporal_store(r.v[j], q + 64 * j); }
__device__ __forceinline__ void st_row_bf16(bf16* p, int lane, const RowVec& r) { unsigned long long* o8 = (unsigned long long*)p + lane;
#pragma unroll
    for (int j = 0; j < 4; ++j) o8[64 * j] = (unsigned long long)pk2(r.v[j][0], r.v[j][1]) | ((unsigned long long)pk2(r.v[j][2], r.v[j][3]) << 32); }
__device__ __forceinline__ RowVec ld_row_bf16(const bf16* p, int lane) { RowVec r; const u32x2* q = (const u32x2*)p + lane;
#pragma unroll
    for (int j = 0; j < 4; ++j) { const u32x2 w = __builtin_nontemporal_load(q + 64 * j); r.v[j] = (f32x4){bflo(w.x), bfhi(w.x), bflo(w.y), bfhi(w.y)}; } return r; }
struct RowRaw { u32x2 w[4]; };
__device__ __forceinline__ RowRaw ld_raw_bf16(const bf16* p, int lane) { RowRaw r; const u32x2* q = (const u32x2*)p + lane;
#pragma unroll
    for (int j = 0; j < 4; ++j) r.w[j] = __builtin_nontemporal_load(q + 64 * j); return r; }
__device__ __forceinline__ RowVec norm_mod(const RowVec& x, const float* g, const float* scale, const float* shift, int lane) {
    float ss = 0.f;
#pragma unroll
    for (int j = 0; j < 4; ++j) ss += (x.v[j][0] * x.v[j][0] + x.v[j][1] * x.v[j][1]) + (x.v[j][2] * x.v[j][2] + x.v[j][3] * x.v[j][3]);
    const float rs = rsqrtf(wave_sum(ss) * (1.f / 1024.f) + NORM_EPS);
    const RowVec gv = ld_row(g, lane); RowVec y;
    if (scale) { const RowVec sc = ld_row(scale, lane), sf = ld_row(shift, lane);
#pragma unroll
        for (int j = 0; j < 4; ++j) y.v[j] = (x.v[j] * rs * gv.v[j]) * (sc.v[j] + 1.f) + sf.v[j];
    } else {
#pragma unroll
        for (int j = 0; j < 4; ++j) y.v[j] = x.v[j] * rs * gv.v[j];
    }
    return y;
}
__device__ __forceinline__ void jrow_split(int row, int& b, int& j) { b = row / RPB; j = row - b * RPB; }

__device__ __forceinline__ void split_hl(const float (&v)[8], bf16x8& hi, bf16x8& lo) {
#pragma unroll
    for (int j = 0; j < 8; ++j) { const unsigned hb = f2bf(v[j]); hi[j] = (short)hb; lo[j] = (short)f2bf(v[j] - __builtin_bit_cast(float, hb << 16)); }
}
__device__ __forceinline__ void p_filter_stage_b(Frame& F, const Args& a, const int rank, const int nblk) {
    const int F_lane = lane_id();
    const float* w3 = a.in[I_HYW3]; const float* HD2 = (const float*)(F.ws + WS_HD2);
    const int gw = rank * NWAVES + F.wave, NGW = nblk * NWAVES;
    const float mind = logf(1e-2f) / 1.5f, maxd = logf(1e-2f) / 0.3f;
    const int lr = F_lane & 15, lg = F_lane >> 4;
    for (int wu = gw; wu < 68 * 32; wu += NGW) {
        const int tc = wu >> 5, cchunk = wu & 31; const bool isc = tc >= 64; const int n = isc ? 256 : 4096; const int t0 = (isc ? tc - 64 : tc) * 64; const int tt0 = isc ? 4096 + t0 : t0;
        float* HR = (float*)(F.ws + (isc ? WS_HRAWC : WS_HRAW)); const int colb = cchunk * 64;
        bf16x8 Ahi[4][2], Alo[4][2];
#pragma unroll
        for (int tt = 0; tt < 4; ++tt)
#pragma unroll
            for (int ks = 0; ks < 2; ++ks) { const float* hp = HD2 + (size_t)(tt0 + 16 * tt + lr) * 64 + 32 * ks + 8 * lg; const f32x4 h0 = *(const f32x4*)hp, h1 = *(const f32x4*)(hp + 4);
                const float v[8] = {h0[0], h0[1], h0[2], h0[3], h1[0], h1[1], h1[2], h1[3]}; split_hl(v, Ahi[tt][ks], Alo[tt][ks]); }
        const float rn1 = 1.f / (float)(n - 1);
#pragma unroll 1
        for (int ct = 0; ct < 4; ++ct) {
            const int col = colb + 16 * ct + lr;
            bf16x8 Bhi[2], Blo[2];
#pragma unroll
            for (int ks = 0; ks < 2; ++ks) { float v[8];
#pragma unroll
                for (int j = 0; j < 8; ++j) v[j] = w3[(size_t)(32 * ks + 8 * lg + j) * 2048 + col];
                split_hl(v, Bhi[ks], Blo[ks]); }
            const float ad = fabsf(mind + (float)(col & 511) * ((maxd - mind) / 511.f)) * LOG2E;
#pragma unroll
            for (int tt = 0; tt < 4; ++tt) { f32x4 acc = (f32x4){0.f, 0.f, 0.f, 0.f};
#pragma unroll
                for (int ks = 0; ks < 2; ++ks) { acc = __builtin_amdgcn_mfma_f32_16x16x32_bf16(Ahi[tt][ks], Bhi[ks], acc, 0, 0, 0); acc = __builtin_amdgcn_mfma_f32_16x16x32_bf16(Alo[tt][ks], Bhi[ks], acc, 0, 0, 0);
                    acc = __builtin_amdgcn_mfma_f32_16x16x32_bf16(Ahi[tt][ks], Blo[ks], acc, 0, 0, 0); }
                const int tb = t0 + 16 * tt + 4 * lg; f32x4 o;
#pragma unroll
                for (int r = 0; r < 4; ++r) o[r] = acc[r] * __builtin_amdgcn_exp2f(-((float)(tb + r) * rn1) * ad);
                *(f32x4*)(HR + (size_t)col * n + tb) = o; }
        }
    }
}

__device__ __forceinline__ bf16* x2b_row(unsigned char* ws, int b, int t) {
    const size_t base = b < 8 ? WS_WGU + (size_t)b * (8 * MiB) : (b < 12 ? WS_WDN + (size_t)(b - 8) * (8 * MiB) : WS_HRAW + (size_t)(b - 12) * (8 * MiB));
    return (bf16*)(ws + base) + (size_t)t * DM;
}
__device__ __forceinline__ const float* p1_src(const Args& a, int row) { int b, j; jrow_split(row, b, j); return j < CTXL ? a.in[I_CTX] + ((size_t)b * CTXL + j) * DM : a.in[I_X] + ((size_t)b * SEQ + (j - CTXL)) * DM; }
__device__ __forceinline__ void p_norm1_l0(Frame& F, const Args& a) {
    const int F_lane = lane_id();
    const float* MOD = (const float*)(F.ws + WS_MOD); bf16* H = (bf16*)(F.ws + WS_BUF1);
    const int gw = F.bid * NWAVES + F.wave, NGW = F.G * NWAVES;
    RowVec xn = ld_row_nt(p1_src(a, gw < NROWS ? gw : 0), F_lane);
    for (int row = gw; row < NROWS; row += NGW) { int b, j; jrow_split(row, b, j);
        const RowVec x = xn; const int rn = row + NGW < NROWS ? row + NGW : row; xn = ld_row_nt(p1_src(a, rn), F_lane);
        const float* md = MOD + (size_t)(j < CTXL ? 16 : b) * 6144;
        const RowVec y = norm_mod(x, a.in[I_N1G], md + 1024, md, F_lane);
        st_row_bf16(H + (size_t)row * DM, F_lane, y); }
}

__device__ __forceinline__ void moe_tab(Frame& F, LAS int* tab, int layer) {
    const int F_lane = lane_id(), F_tid = F.wave * 64 + F_lane; (void)F_tid;
    if (F_tid < 32) tab[64 + F_tid] = (int)__hip_atomic_load(F.ctl + CW_CNT + 64 * layer + F_tid, RLX_AGENT);
    __syncthreads();
    if (F_tid == 0) { int s = 0; for (int e = 0; e < 32; ++e) { tab[e] = s; s += (tab[64 + e] + 255) >> 8; } tab[32] = s; for (int e = 33; e < 64; ++e) tab[e] = 0x7fffffff; }
    __syncthreads();
}

constexpr int RT_HPITCH = 2064;
constexpr int RT_PART_OFF = 2 * 16 * RT_HPITCH, RT_LGS_OFF = RT_PART_OFF + 8 * 48 * 16 * 4, RT_CNT_OFF = RT_LGS_OFF + 16 * 48 * 4, RT_REC_OFF = RT_CNT_OFF + 256, RT_MAXROWS = 288;
static_assert(RT_REC_OFF + 3 * 2 * RT_MAXROWS * 4 <= MISC_OFF, "router LDS map");
template <int LAYER>
__device__ __forceinline__ void p_norm2_route(Frame& F, const Args& a) {
    const int F_lane = lane_id(), F_tid = F.wave * 64 + F_lane;
    const float* MOD = (const float*)(F.ws + WS_MOD) + (size_t)LAYER * 17 * 6144; bf16* H2 = (bf16*)(F.ws + WS_BUF1);
    LAS unsigned char* hbuf = F.lds; LAS unsigned char* hbuf_lo = F.lds + 16 * RT_HPITCH; LAS float* part = (LAS float*)(F.lds + RT_PART_OFF); LAS float* lgs = (LAS float*)(F.lds + RT_LGS_OFF);
    LAS int* lcnt = (LAS int*)(F.lds + RT_CNT_OFF); LAS int* lbase = lcnt + 32;
    LAS int* recE = (LAS int*)(F.lds + RT_REC_OFF); LAS int* recP = recE + 2 * RT_MAXROWS; LAS float* recG = (LAS float*)(recP + 2 * RT_MAXROWS);
    const float* wg = a.in[I_RTGW] + (size_t)LAYER * 1024 * 4; const float* we = a.in[I_RTEW] + (size_t)LAYER * 1024 * 32;
    const float* gb = a.in[I_RTGB] + LAYER * 4; const float* eb = a.in[I_RTEB] + LAYER * 32;
    bf16x8 Whi[3][4], Wlo[3][4];
#pragma unroll
    for (int nt = 0; nt < 3; ++nt)
#pragma unroll
        for (int ks = 0; ks < 4; ++ks) { const int o = 16 * nt + (F_lane & 15); const int k0 = 128 * F.wave + 32 * ks + 8 * (F_lane >> 4);
#pragma unroll
            for (int j = 0; j < 8; ++j) { float wv = 0.f; if (o < 4) wv = wg[(size_t)(k0 + j) * 4 + o]; else if (o < 36) wv = we[(size_t)(k0 + j) * 32 + (o - 4)];
                const unsigned hb = f2bf(wv); const float hf = __builtin_bit_cast(float, hb << 16); Whi[nt][ks][j] = (short)hb; Wlo[nt][ks][j] = (short)f2bf(wv - hf); }
            asm volatile("" : "+v"(Whi[nt][ks]), "+v"(Wlo[nt][ks]) :: "memory"); }
    if (F_tid < 64) lcnt[F_tid] = 0;
    __syncthreads();
    const int nrows = LAYER == 0 ? NROWS : NB * SEQ; const int chunk = (nrows + F.G - 1) / F.G;
    const int i0 = F.bid * chunk, i1 = (i0 + chunk < nrows) ? i0 + chunk : nrows;
    const bf16* YB = (const bf16*)(F.ws + WS_Y);
#define RT_LDX(i_) ({ RowVec xr_; if (LAYER == 0) { int b_, j_; jrow_split((i_), b_, j_); xr_ = ld_row_nt(j_ < CTXL ? a.in[I_CTX] + ((size_t)b_ * CTXL + j_) * DM : a.in[I_X] + ((size_t)b_ * SEQ + (j_ - CTXL)) * DM, F_lane); } \
    else xr_ = ld_row_bf16(x2b_row(F.ws, (i_) >> 12, (i_) & 4095), F_lane); xr_; })
#define RT_YROW(i_) (LAYER == 0 ? (i_) : ((i_) >> 12) * RPB + CTXL + ((i_) & 4095))
    RowVec xq[2]; RowRaw yq[2];
#pragma unroll
    for (int r = 0; r < 2; ++r) { const int i = (i0 + 2 * F.wave + r < i1) ? i0 + 2 * F.wave + r : i1 - 1; xq[r] = RT_LDX(i); yq[r] = ld_raw_bf16(YB + (size_t)RT_YROW(i) * DM, F_lane); }
    for (int ig = i0; ig < i1; ig += 16) {
#pragma unroll
        for (int r = 0; r < 2; ++r) {
            const int rl = 2 * F.wave + r; const bool valid = ig + rl < i1; const int i = valid ? ig + rl : i1 - 1; int row, b, j;
            if (LAYER == 0) { row = i; jrow_split(row, b, j); } else { b = i >> 12; j = CTXL + (i & 4095); row = b * RPB + j; }
            const float* md = MOD + (size_t)(j < CTXL ? 16 : b) * 6144;
            RowVec x1 = xq[r];
#pragma unroll
            for (int q = 0; q < 4; ++q) x1.v[q] = x1.v[q] + (f32x4){bflo(yq[r].w[q].x), bfhi(yq[r].w[q].x), bflo(yq[r].w[q].y), bfhi(yq[r].w[q].y)};
            const RowVec y = norm_mod(x1, a.in[I_N2G] + LAYER * 1024, md + 4 * 1024, md + 3 * 1024, F_lane);
            unsigned long long pk[4], pl[4];
#pragma unroll
            for (int q = 0; q < 4; ++q) { const unsigned h0 = f2bf(y.v[q][0]), h1 = f2bf(y.v[q][1]), h2_ = f2bf(y.v[q][2]), h3 = f2bf(y.v[q][3]);
                pk[q] = (unsigned long long)(h0 | (h1 << 16)) | ((unsigned long long)(h2_ | (h3 << 16)) << 32);
                const float l0 = y.v[q][0] - __builtin_bit_cast(float, h0 << 16), l1 = y.v[q][1] - __builtin_bit_cast(float, h1 << 16), l2 = y.v[q][2] - __builtin_bit_cast(float, h2_ << 16), l3 = y.v[q][3] - __builtin_bit_cast(float, h3 << 16);
                pl[q] = (unsigned long long)pk2(l0, l1) | ((unsigned long long)pk2(l2, l3) << 32); }
            if (valid) { unsigned long long* o8 = (unsigned long long*)(H2 + (size_t)row * DM) + F_lane;
#pragma unroll
                for (int q = 0; q < 4; ++q) o8[64 * q] = pk[q]; }
#pragma unroll
            for (int q = 0; q < 4; ++q) { *(LAS unsigned long long*)(hbuf + rl * RT_HPITCH + (4 * F_lane + 256 * q) * 2) = pk[q]; *(LAS unsigned long long*)(hbuf_lo + rl * RT_HPITCH + (4 * F_lane + 256 * q) * 2) = pl[q]; }
        }
        {   const int ign = ig + 16;
#pragma unroll
            for (int r = 0; r < 2; ++r) { const int i = (ign + 2 * F.wave + r < i1) ? ign + 2 * F.wave + r : i1 - 1; xq[r] = RT_LDX(i); yq[r] = ld_raw_bf16(YB + (size_t)RT_YROW(i) * DM, F_lane); } }
        __syncthreads();
        {   f32x4 acc[3];
#pragma unroll
            for (int nt = 0; nt < 3; ++nt) acc[nt] = (f32x4){0.f, 0.f, 0.f, 0.f};
#pragma unroll
            for (int ks = 0; ks < 4; ++ks) { const int bo = (F_lane & 15) * RT_HPITCH + (128 * F.wave + 32 * ks + 8 * (F_lane >> 4)) * 2;
                const bf16x8 bfr = *(const LAS bf16x8*)(hbuf + bo), bfl = *(const LAS bf16x8*)(hbuf_lo + bo);
#pragma unroll
                for (int nt = 0; nt < 3; ++nt) { acc[nt] = __builtin_amdgcn_mfma_f32_16x16x32_bf16(Whi[nt][ks], bfr, acc[nt], 0, 0, 0); acc[nt] = __builtin_amdgcn_mfma_f32_16x16x32_bf16(Wlo[nt][ks], bfr, acc[nt], 0, 0, 0);
                    acc[nt] = __builtin_amdgcn_mfma_f32_16x16x32_bf16(Whi[nt][ks], bfl, acc[nt], 0, 0, 0); } }
#pragma unroll
            for (int nt = 0; nt < 3; ++nt)
#pragma unroll
                for (int rg = 0; rg < 4; ++rg) part[(F.wave * 48 + 16 * nt + 4 * (F_lane >> 4) + rg) * 16 + (F_lane & 15)] = acc[nt][rg]; }
        __syncthreads();
        for (int idx = F_tid; idx < 36 * 16; idx += NTHR) { const int o = idx >> 4, r = idx & 15; float sacc = o < 4 ? gb[o] : eb[o - 4];
#pragma unroll
            for (int w = 0; w < 8; ++w) sacc += part[(w * 48 + o) * 16 + r];
            lgs[r * 48 + o] = sacc; }
        __syncthreads();
        if (F_tid < 16 && ig + F_tid < i1) {
            float lg[36];
#pragma unroll
            for (int o4 = 0; o4 < 9; ++o4) { const f32x4 t4 = *(const LAS f32x4*)(lgs + F_tid * 48 + 4 * o4); lg[4 * o4] = t4[0]; lg[4 * o4 + 1] = t4[1]; lg[4 * o4 + 2] = t4[2]; lg[4 * o4 + 3] = t4[3]; }
            int grp = 0; float gmax = lg[0];
#pragma unroll
            for (int q = 1; q < 4; ++q) if (lg[q] > gmax) { gmax = lg[q]; grp = q; }
            float den = 0.f;
#pragma unroll
            for (int q = 0; q < 4; ++q) den += __expf(lg[q] - gmax);
            const float pg = 1.f / den;
            float el[8];
#pragma unroll
            for (int q = 0; q < 8; ++q) { float v = 0.f;
#pragma unroll
                for (int g2 = 0; g2 < 4; ++g2) v = (grp == g2) ? lg[4 + 8 * g2 + q] : v;
                el[q] = v; }
            int i0e = 0; float m0 = el[0];
#pragma unroll
            for (int q = 1; q < 8; ++q) if (el[q] > m0) { m0 = el[q]; i0e = q; }
            int i1e = -1; float m1 = -INFINITY;
#pragma unroll
            for (int q = 0; q < 8; ++q) if (q != i0e && el[q] > m1) { m1 = el[q]; i1e = q; }
            const float ex = __expf(m1 - m0); const float g0 = pg / (1.f + ex), g1 = pg * ex / (1.f + ex);
            const int e0 = grp * 8 + i0e, e1 = grp * 8 + i1e; const int li = ig + F_tid - i0;
            recE[2 * li] = e0; recE[2 * li + 1] = e1; recG[2 * li] = g0; recG[2 * li + 1] = g1;
            recP[2 * li] = atomicAdd((int*)&lcnt[e0], 1); recP[2 * li + 1] = atomicAdd((int*)&lcnt[e1], 1);
        }
    }
    __syncthreads();
    const int tid2 = F.wave * 64 + lane_id();
    if (tid2 < 32) { const int c = lcnt[tid2]; lbase[tid2] = c > 0 ? (int)__hip_atomic_fetch_add(F.ctl + CW_CNT + 64 * LAYER + tid2, (unsigned)c, RLX_AGENT) : 0; }
    __syncthreads();
    int* TOK = (int*)(F.ws + WS_TOKIDX); float* GT = (float*)(F.ws + WS_GATE); int* RT = (int*)(F.ws + WS_ROUTE);
    for (int idx = tid2; idx < 2 * (i1 - i0); idx += NTHR) { const int li = idx >> 1, i = i0 + li; int row;
        if (LAYER == 0) row = i; else row = (i >> 12) * RPB + CTXL + (i & 4095);
        const int e = recE[idx], pos = lbase[e] + recP[idx];
        TOK[(size_t)e * CAP + pos] = row; GT[(size_t)e * CAP + pos] = recG[idx]; RT[(size_t)row * 4 + 2 * (idx & 1)] = e; RT[(size_t)row * 4 + 2 * (idx & 1) + 1] = pos; }
#undef RT_LDX
#undef RT_YROW
}

template <int LAYER> __device__ __forceinline__ int cmb_row(int i) { return LAYER == 0 ? i : (i >> 12) * RPB + CTXL + (i & 4095); }
template <int LAYER>
__device__ __forceinline__ void p_combine(Frame& F, const Args& a) {
    const int F_lane = lane_id(), F_tid = F.wave * 64 + F_lane; (void)F_tid;
    const float* MOD = (const float*)(F.ws + WS_MOD) + (size_t)LAYER * 17 * 6144; const float* MOD1 = (const float*)(F.ws + WS_MOD) + (size_t)17 * 6144;
    float* XC = (float*)(F.ws + WS_XC); bf16* H = (bf16*)(F.ws + WS_BUF1); const bf16* MOUT = (const bf16*)(F.ws + WS_BUF2); const int* RT = (const int*)(F.ws + WS_ROUTE); const bf16* YB = (const bf16*)(F.ws + WS_Y);
    LAS int* tab = (LAS int*)F.lds; moe_tab(F, tab, LAYER);
    const int gw = F.bid * NWAVES + F.wave, NGW = F.G * NWAVES; const int nrows = LAYER == 0 ? NROWS : NB * SEQ;
    if (gw >= nrows) return;
    typedef int i32x4 __attribute__((ext_vector_type(4)));
#define CMB_XP(row_) ({ int b_, j_; jrow_split((row_), b_, j_); j_ < CTXL ? XC + ((size_t)b_ * CTXL + j_) * DM : a.out + ((size_t)b_ * SEQ + (j_ - CTXL)) * DM; })
#define CMB_LDX(row_) ({ RowVec xr_; int b_, j_; jrow_split((row_), b_, j_); if (LAYER == 0) xr_ = ld_row_nt(j_ < CTXL ? a.in[I_CTX] + ((size_t)b_ * CTXL + j_) * DM : a.in[I_X] + ((size_t)b_ * SEQ + (j_ - CTXL)) * DM, F_lane); else xr_ = ld_row_bf16(x2b_row(F.ws, b_, j_ - CTXL), F_lane); xr_; })
    int i = gw; int row = cmb_row<LAYER>(i);
    i32x4 rt = *(const i32x4*)(RT + (size_t)row * 4);
    int i_n = i + NGW < nrows ? i + NGW : i; int row_n = cmb_row<LAYER>(i_n);
    i32x4 rt_n = *(const i32x4*)(RT + (size_t)row_n * 4);
    RowVec x = CMB_LDX(row); RowRaw yr = ld_raw_bf16(YB + (size_t)row * DM, F_lane);
    RowRaw m0 = ld_raw_bf16(MOUT + ((size_t)tab[rt[0]] * 256 + rt[1]) * DM, F_lane), m1 = ld_raw_bf16(MOUT + ((size_t)tab[rt[2]] * 256 + rt[3]) * DM, F_lane);
    for (; i < nrows; ) {
        const int i_nn = i_n + NGW < nrows ? i_n + NGW : i_n; const int row_nn = cmb_row<LAYER>(i_nn);
        const i32x4 rt_nn = *(const i32x4*)(RT + (size_t)row_nn * 4);
        const RowVec x_n = CMB_LDX(row_n); const RowRaw yr_n = ld_raw_bf16(YB + (size_t)row_n * DM, F_lane);
        const RowRaw m0_n = ld_raw_bf16(MOUT + ((size_t)tab[rt_n[0]] * 256 + rt_n[1]) * DM, F_lane), m1_n = ld_raw_bf16(MOUT + ((size_t)tab[rt_n[2]] * 256 + rt_n[3]) * DM, F_lane);
        int b, j; jrow_split(row, b, j); float* xp = CMB_XP(row); const int mb = j < CTXL ? 16 : b;
        const RowVec g5 = ld_row(MOD + (size_t)mb * 6144 + 5 * 1024, F_lane);
#pragma unroll
        for (int q = 0; q < 4; ++q) { const f32x4 a0 = (f32x4){bflo(m0.w[q].x), bfhi(m0.w[q].x), bflo(m0.w[q].y), bfhi(m0.w[q].y)}, a1 = (f32x4){bflo(m1.w[q].x), bfhi(m1.w[q].x), bflo(m1.w[q].y), bfhi(m1.w[q].y)};
            x.v[q] = (x.v[q] + (f32x4){bflo(yr.w[q].x), bfhi(yr.w[q].x), bflo(yr.w[q].y), bfhi(yr.w[q].y)}) + g5.v[q] * (a0 + a1); }
        if (LAYER == 0) { if (j >= CTXL) st_row_bf16_nt(x2b_row(F.ws, b, j - CTXL), F_lane, x); const float* md = MOD1 + (size_t)mb * 6144; const RowVec y = norm_mod(x, a.in[I_N1G] + 1024, md + 1024, md, F_lane); st_row_bf16(H + (size_t)row * DM, F_lane, y); }
        else { const RowVec y = norm_mod(x, a.in[I_FNG], nullptr, nullptr, F_lane); st_row_nt(xp, F_lane, y); }
        if (i + NGW >= nrows) break;
        i = i_n; row = row_n; x = x_n; yr = yr_n; m0 = m0_n; m1 = m1_n; i_n = i_nn; row_n = row_nn; rt_n = rt_nn;
    }
#undef CMB_XP
#undef CMB_LDX
}

__device__ __forceinline__ void p_transpose_y(Frame& F) {
    const int F_lane = lane_id();
    const bf16* YT = (const bf16*)(F.ws + WS_BUF4); bf16* YM = (bf16*)(F.ws + WS_BUF1);
    LAS unsigned short* t = (LAS unsigned short*)(F.lds + F.wave * 9216);
    const int gw = F.bid * NWAVES + F.wave, NGW = F.G * NWAVES; const int NT_R = NROWS / 64; const int NTILES = 8 * NT_R;
    if (gw >= NTILES) return;
    u32x4 cur[8], nxt[8];
#define TY_LOAD(dst, tile_) do { const int cb_ = (tile_) / NT_R, rb_ = (tile_) % NT_R; _Pragma("unroll") for (int i = 0; i < 8; ++i) dst[i] = __builtin_nontemporal_load((const u32x4*)(YT + (size_t)(cb_ * 64 + 8 * i + (F_lane >> 3)) * CT_LD + rb_ * 64 + 8 * (F_lane & 7))); } while (0)
    TY_LOAD(cur, gw);
    for (int tile = gw; tile < NTILES; tile += NGW) { const int cb = tile / NT_R, rb = tile % NT_R; const int c0 = cb * 64, r0 = rb * 64;
        const int tn = tile + NGW < NTILES ? tile + NGW : tile; TY_LOAD(nxt, tn);
#pragma unroll
        for (int i = 0; i < 8; ++i) *(LAS u32x4*)(t + (8 * i + (F_lane >> 3)) * 72 + 8 * (F_lane & 7)) = cur[i];
        LDS_WAIT(); asm volatile("" ::: "memory");
#pragma unroll
        for (int i = 0; i < 8; ++i) { const int r = 8 * i + (F_lane >> 3), cc = F_lane & 7; unsigned short e[8];
#pragma unroll
            for (int k = 0; k < 8; ++k) e[k] = t[(8 * cc + k) * 72 + r];
            u32x4 w; w.x = e[0] | ((unsigned)e[1] << 16); w.y = e[2] | ((unsigned)e[3] << 16); w.z = e[4] | ((unsigned)e[5] << 16); w.w = e[6] | ((unsigned)e[7] << 16);
            *(u32x4*)(YM + (size_t)(r0 + r) * DM + c0 + 8 * cc) = w; }
        LDS_WAIT(); asm volatile("" ::: "memory");
#pragma unroll
        for (int i = 0; i < 8; ++i) cur[i] = nxt[i];
    }
#undef TY_LOAD
}
constexpr int HY_UP = 8208;
constexpr int HY_G_OFF = 16 * HY_UP, HY_G_BYTES = 8192 * 2 + 32, HY_RED_OFF = HY_G_OFF + HY_G_BYTES;

#define LAUNDER(x) asm volatile("" : "+v"(x))
__device__ __forceinline__ void hy_load_filter(Frame& F, const float* HR, int order, int c, LAS unsigned short* GR, LAS float* red) {
    const int lane_ = lane_id();
    float v[16]; float s = 0.f; int tid = F.wave * 64 + lane_; LAUNDER(tid);
#pragma unroll
    for (int k = 0; k < 16; ++k) { const int i = tid + 512 * k; const int lag = 4096 - i; float val = 0.f;
        if (i >= 1) val = lag >= 0 ? HR[(size_t)(order * 512 + c) * 4096 + lag] : HR[(size_t)(1024 + order * 512 + c) * 4096 - lag];
        v[k] = val; s += fabsf(val); }
    s = wave_sum(s); if (lane_ == 0) red[F.wave] = s;
    __syncthreads();
    float S = 0.f;
#pragma unroll
    for (int w = 0; w < 8; ++w) S += red[w];
    const float inv = 1.f / (S + 1e-6f);
#pragma unroll
    for (int k = 0; k < 16; ++k) GR[tid + 512 * k] = (unsigned short)f2bf(v[k] * inv);
    __syncthreads();
}
__device__ __forceinline__ f32x4 sconv4(const bf16* up, int tb, int n, float w0, float w1, float w2, float bias) {
    const u32x2 w = *(const u32x2*)up; const float pv = tb > 0 ? bf2f(up[tb > 0 ? -1 : 0]) : 0.f, nx = tb + 4 < n ? bf2f(up[tb + 4 < n ? 4 : 0]) : 0.f;
    const float u0 = bflo(w.x), u1 = bfhi(w.x), u2 = bflo(w.y), u3 = bfhi(w.y);
    return (f32x4){w0 * pv + w1 * u0 + w2 * u1 + bias, w0 * u0 + w1 * u1 + w2 * u2 + bias, w0 * u1 + w1 * u2 + w2 * u3 + bias, w0 * u2 + w1 * u3 + w2 * nx + bias};
}
__device__ __forceinline__ void hy_half(f32x4 (&acc)[16], bf16x8 (&Bw)[8], unsigned (&x)[5], bf16x8& Btmp, const LAS unsigned char* xbase, const int xoff, const LAS unsigned char* bbase, const int boff, const unsigned sh,
                                        const int u, const int qlo, const int qhi, const int par, const bool binstall, const bool bprefetch, const bool xprefetch) {
    if (par == 0 && binstall) Bw[(8 - u) & 7] = Btmp;
    u32x4 w;
#pragma unroll
    for (int k = 0; k < 4; ++k) w[k] = __builtin_amdgcn_alignbit(x[k + 1], x[k], sh);
    const bf16x8 a = __builtin_bit_cast(bf16x8, w);
    if (xprefetch) {
#pragma unroll
        for (int k = 0; k < 5; ++k) x[k] = *(const LAS unsigned*)(xbase + xoff + 4 * k); }
    if (par == 0 && bprefetch) Btmp = *(const LAS bf16x8*)(bbase + boff);
    __builtin_amdgcn_sched_barrier(0);
#pragma unroll
    for (int q = 0; q < 8; ++q) if (q >= qlo && q <= qhi) { const int sl = (q - u) & 7;
        acc[2 * q + par] = __builtin_amdgcn_mfma_f32_16x16x32_bf16(a, Bw[sl], acc[2 * q + par], 0, 0, 0); }
    __builtin_amdgcn_sched_barrier(0);
}
__device__ __forceinline__ void hy_step(f32x4 (&acc)[16], bf16x8 (&Bw)[8], unsigned (&x)[5], bf16x8& Btmp, const LAS unsigned char* xbase, const int xoff, const LAS unsigned char* bbase, const int boff, const unsigned sh,
                                        const int u, const int qlo, const int qhi, const bool binstall, const bool bprefetch, const bool last) {
    hy_half(acc, Bw, x, Btmp, xbase, xoff - 32, bbase, boff, sh, u, qlo, qhi, 0, binstall, bprefetch, true);
    hy_half(acc, Bw, x, Btmp, xbase, xoff - 64, bbase, boff, sh, u, qlo, qhi, 1, false, false, !last);
}
template <int NJ, int UPITCH>
__device__ __forceinline__ void hy_conv_pass(f32x4 (&acc)[16], const LAS unsigned char* U, const LAS unsigned short* GR, int v, int lane_in) {
    int lane = lane_in; LAUNDER(lane); const int row = lane & 15, g = lane >> 4, r = row & 1;
    const unsigned sh = 16u * (unsigned)r;
    const LAS unsigned char* ub = U + row * UPITCH + g * 16;
    const LAS unsigned char* xa = (const LAS unsigned char*)GR + 2 * (32 * NJ - row + 8 * g - r) - 64 * (8 * v - (NJ - 1));
    const LAS unsigned char* bn = ub + (NJ - 2) * 64;
    bf16x8 Bw[8]; bf16x8 Btmp = *(const LAS bf16x8*)(ub + (NJ - 1) * 64); unsigned x[5];
#pragma unroll
    for (int i = 0; i < 8; ++i) Bw[i] = (bf16x8){0, 0, 0, 0, 0, 0, 0, 0};
#pragma unroll
    for (int k = 0; k < 5; ++k) x[k] = *(const LAS unsigned*)(xa + 4 * k);
    { const LAS unsigned char* xl = xa - 64 * 8; const LAS unsigned char* bl = bn - 64 * 7; asm volatile("" : "+v"(xl), "+v"(bl));
#pragma unroll
      for (int s = 0; s < 7; ++s) hy_step(acc, Bw, x, Btmp, xl, 64 * (8 - s), bl, 64 * (7 - s), sh, s + 1, 0, s, true, true, false);
      xa -= 64 * 7; bn -= 64 * 7; }
#pragma unroll 1
    for (int it = 0; it < (NJ - 8) / 8; ++it) {
        const LAS unsigned char* xl = xa - 64 * 8; const LAS unsigned char* bl = bn - 64 * 7; asm volatile("" : "+v"(xl), "+v"(bl));
#pragma unroll
        for (int u = 0; u < 8; ++u) hy_step(acc, Bw, x, Btmp, xl, 64 * (8 - u), bl, 64 * (7 - u), sh, u, 0, 7, true, true, false);
        xa -= 512; bn -= 512;
    }
    { const LAS unsigned char* xl = xa - 64 * 8; asm volatile("" : "+v"(xl));
      hy_step(acc, Bw, x, Btmp, xl, 64 * 8, ub, 0, sh, 0, 0, 7, true, false, false);
#pragma unroll
      for (int m = 1; m < 8; ++m) hy_step(acc, Bw, x, Btmp, xl, 64 * (8 - m), ub, 0, sh, m, m, 7, false, false, m == 7); }
}
__device__ __forceinline__ void hyena_latent_unit(Frame& F, const Args& a, int c) {
    const bf16* UT = (const bf16*)(F.ws + WS_BUF2); bf16* YT = (bf16*)(F.ws + WS_BUF4); const float* HR = (const float*)(F.ws + WS_HRAW);
    const int lane_ = lane_id(); const int tid_ = F.wave * 64 + lane_;
    LAS unsigned char* U = F.lds; LAS unsigned short* GR = (LAS unsigned short*)(F.lds + HY_G_OFF); LAS float* red = (LAS float*)(F.lds + HY_RED_OFF);
    const float* cw = a.in[I_HYCW]; const float* cb = a.in[I_HYCB]; const float* sk = a.in[I_HYSKIP];
#ifndef HYP
#define HYP 0
#endif
    hy_load_filter(F, HR, 0, c, GR, red);
    if (HYP == 1) { hy_load_filter(F, HR, 1, c, GR, red); hy_load_filter(F, HR, 0, c, GR, red); }
    for (int hyrep = 0; hyrep < (HYP == 2 ? 2 : 1); ++hyrep)
    {
        const float w0 = cw[c], w1 = cw[1536 + c], w2 = cw[3072 + c], bs = cb[c]; int tid = tid_; LAUNDER(tid);
        const int t8 = (tid & 511) * 8; const bf16* up0 = UT + (size_t)c * CT_LD + CTXL + t8;
        u32x4 uw[16]; unsigned short upv[16], unx[16];
#pragma unroll
        for (int k = 0; k < 16; ++k) { const bf16* up = up0 + (size_t)k * RPB; uw[k] = *(const u32x4*)up; upv[k] = up[-1]; unx[k] = up[8]; }
#pragma unroll
        for (int k = 0; k < 16; ++k) {
            const float e0 = t8 > 0 ? bf2f(upv[k]) : 0.f, e9 = t8 + 8 < 4096 ? bf2f(unx[k]) : 0.f;
            const float e1 = bflo(uw[k].x), e2 = bfhi(uw[k].x), e3 = bflo(uw[k].y), e4 = bfhi(uw[k].y), e5 = bflo(uw[k].z), e6 = bfhi(uw[k].z), e7 = bflo(uw[k].w), e8 = bfhi(uw[k].w);
            u32x4 w; w.x = pk2(w0 * e0 + w1 * e1 + w2 * e2 + bs, w0 * e1 + w1 * e2 + w2 * e3 + bs); w.y = pk2(w0 * e2 + w1 * e3 + w2 * e4 + bs, w0 * e3 + w1 * e4 + w2 * e5 + bs);
            w.z = pk2(w0 * e4 + w1 * e5 + w2 * e6 + bs, w0 * e5 + w1 * e6 + w2 * e7 + bs); w.w = pk2(w0 * e6 + w1 * e7 + w2 * e8 + bs, w0 * e7 + w1 * e8 + w2 * e9 + bs);
            *(LAS u32x4*)(U + k * HY_UP + t8 * 2) = w; }
    }
    __syncthreads();
    u32x2 keep[2][16];
#pragma unroll
    for (int pass = 0; pass < 2; ++pass) {
        const int xoff = pass == 0 ? 512 : 1024;
        const float w0 = cw[xoff + c], w1 = cw[1536 + xoff + c], w2 = cw[3072 + xoff + c], bs = cb[xoff + c], skip = sk[pass * 512 + c];
#pragma unroll
        for (int sp = 0; sp < 2; ++sp) {
            const int v = 2 * F.wave + sp;
            unsigned pf0, pf1;
            { int lp = lane_; LAUNDER(lp); const bf16* pfp = UT + (size_t)(xoff + c) * CT_LD + (lp & 15) * RPB + CTXL + 256 * v + (lp >> 4) * 32;
              pf0 = *(const unsigned*)pfp; pf1 = *(const unsigned*)(pfp + 128); }
            f32x4 acc[16];
#pragma unroll
            for (int i = 0; i < 16; ++i) acc[i] = (f32x4){0.f, 0.f, 0.f, 0.f};
#ifdef HY_DUP
            { hy_conv_pass<128, HY_UP>(acc, U, GR, v, lane_); f32x4 d = acc[0];
#pragma unroll
              for (int i = 1; i < 16; ++i) d = d + acc[i];
              asm volatile("" : "+v"(d) :: "memory");
#pragma unroll
              for (int i = 0; i < 16; ++i) acc[i] = d * 0.f; }
#endif
            hy_conv_pass<128, HY_UP>(acc, U, GR, v, lane_);
            asm volatile("" :: "v"(pf0), "v"(pf1) : "memory"); __builtin_amdgcn_sched_barrier(0);
            int ln = lane_; LAUNDER(ln); const int b = ln & 15, g = ln >> 4;
            const bf16* ux = UT + (size_t)(xoff + c) * CT_LD + b * RPB + CTXL + 256 * v + 4 * g;
            for (int eprep = 0; eprep < (HYP == 3 ? 2 : 1); ++eprep)
#pragma unroll
            for (int tg = 0; tg < 4; ++tg) {
                u32x2 xw[4]; unsigned short xp[4], xn[4];
#pragma unroll
                for (int j = 0; j < 4; ++j) { const bf16* up = ux + 16 * (4 * tg + j); xw[j] = *(const u32x2*)up; xp[j] = up[-1]; xn[j] = up[4]; }
#pragma unroll
                for (int j = 0; j < 4; ++j) { const int ti = 4 * tg + j; const int tb = 256 * v + 16 * ti + 4 * g;
                    const float pv = tb > 0 ? bf2f(xp[j]) : 0.f, nx = tb + 4 < 4096 ? bf2f(xn[j]) : 0.f; const float u0 = bflo(xw[j].x), u1 = bfhi(xw[j].x), u2 = bflo(xw[j].y), u3 = bfhi(xw[j].y);
                    const f32x4 xx = (f32x4){w0 * pv + w1 * u0 + w2 * u1 + bs, w0 * u0 + w1 * u1 + w2 * u2 + bs, w0 * u1 + w1 * u2 + w2 * u3 + bs, w0 * u2 + w1 * u3 + w2 * nx + bs};
                    const u32x2 vw = *(const LAS u32x2*)(U + b * HY_UP + tb * 2); const f32x4 vv = (f32x4){bflo(vw.x), bfhi(vw.x), bflo(vw.y), bfhi(vw.y)};
                    const f32x4 res = xx * (acc[ti] + vv * skip); u32x2 w; w.x = pk2(res[0], res[1]); w.y = pk2(res[2], res[3]); keep[sp][ti] = w; }
                asm volatile("" : "+v"(keep[sp][4 * tg]), "+v"(keep[sp][4 * tg + 1]), "+v"(keep[sp][4 * tg + 2]), "+v"(keep[sp][4 * tg + 3]) :: "memory");
            }
        }
        __syncthreads();
        {   int ln = lane_; LAUNDER(ln); const int b = ln & 15, g = ln >> 4;
#pragma unroll
            for (int sp = 0; sp < 2; ++sp)
#pragma unroll
                for (int ti = 0; ti < 16; ++ti) { const int tb = 256 * (2 * F.wave + sp) + 16 * ti + 4 * g; *(LAS u32x2*)(U + b * HY_UP + tb * 2) = keep[sp][ti]; } }
        if (pass == 0) hy_load_filter(F, HR, 1, c, GR, red);
        else __syncthreads();
    }
    int tid3 = tid_; LAUNDER(tid3);
#pragma unroll 2
    for (int k = 0; k < 16; ++k) { const int q = tid3 + 512 * k, bb = q >> 9, t8 = (q & 511) * 8; const u32x4 w = *(const LAS u32x4*)(U + bb * HY_UP + t8 * 2);
        *(u32x4*)(YT + (size_t)c * CT_LD + bb * RPB + CTXL + t8) = w; }
    __syncthreads();
}
constexpr int HC_UP = 528, HC_G_OFF = 16 * HC_UP, HC_WAVE_BYTES = HC_G_OFF + 1024 + 64;
__device__ __forceinline__ void hc_load_filter(const float* HR, int order, int c, LAS unsigned short* GR, int lane) {
    float v[8]; float s = 0.f;
#pragma unroll
    for (int k = 0; k < 8; ++k) { const int i = lane + 64 * k; const int lag = 256 - i; float val = 0.f;
        if (i >= 1) val = lag >= 0 ? HR[(size_t)(order * 512 + c) * 256 + lag] : HR[(size_t)(1024 + order * 512 + c) * 256 - lag];
        v[k] = val; s += fabsf(val); }
    const float inv = 1.f / (wave_sum(s) + 1e-6f);
#pragma unroll
    for (int k = 0; k < 8; ++k) GR[lane + 64 * k] = (unsigned short)f2bf(v[k] * inv);
    LDS_WAIT(); asm volatile("" ::: "memory");
}
__device__ __forceinline__ void hyena_ctx_wave(Frame& F, const Args& a, int c) {
    const bf16* UT = (const bf16*)(F.ws + WS_BUF2); bf16* YT = (bf16*)(F.ws + WS_BUF4); const float* HR = (const float*)(F.ws + WS_HRAWC);
    const int lane = lane_id();
    LAS unsigned char* U = F.lds + F.wave * HC_WAVE_BYTES; LAS unsigned short* GR = (LAS unsigned short*)(U + HC_G_OFF);
    const float* cw = a.in[I_HYCW]; const float* cb = a.in[I_HYCB]; const float* sk = a.in[I_HYSKIP];
    hc_load_filter(HR, 0, c, GR, lane);
    {   const float w0 = cw[c], w1 = cw[1536 + c], w2 = cw[3072 + c], bs = cb[c];
#pragma unroll 2
        for (int k = 0; k < 8; ++k) { const int q = lane + 64 * k, b = q >> 5, t8 = (q & 31) * 8; const bf16* up = UT + (size_t)c * CT_LD + b * RPB + t8;
            const u32x4 uw = *(const u32x4*)up; const float e0 = t8 > 0 ? bf2f(up[-1]) : 0.f, e9 = t8 + 8 < 256 ? bf2f(up[8]) : 0.f;
            const float e1 = bflo(uw.x), e2 = bfhi(uw.x), e3 = bflo(uw.y), e4 = bfhi(uw.y), e5 = bflo(uw.z), e6 = bfhi(uw.z), e7 = bflo(uw.w), e8 = bfhi(uw.w);
            u32x4 w; w.x = pk2(w0 * e0 + w1 * e1 + w2 * e2 + bs, w0 * e1 + w1 * e2 + w2 * e3 + bs); w.y = pk2(w0 * e2 + w1 * e3 + w2 * e4 + bs, w0 * e3 + w1 * e4 + w2 * e5 + bs);
            w.z = pk2(w0 * e4 + w1 * e5 + w2 * e6 + bs, w0 * e5 + w1 * e6 + w2 * e7 + bs); w.w = pk2(w0 * e6 + w1 * e7 + w2 * e8 + bs, w0 * e7 + w1 * e8 + w2 * e9 + bs);
            *(LAS u32x4*)(U + b * HC_UP + t8 * 2) = w; }
        LDS_WAIT(); asm volatile("" ::: "memory");
    }
    const int b = lane & 15, g = lane >> 4;
#pragma unroll
    for (int pass = 0; pass < 2; ++pass) {
        const int xoff = pass == 0 ? 512 : 1024;
        const float w0 = cw[xoff + c], w1 = cw[1536 + xoff + c], w2 = cw[3072 + xoff + c], bs = cb[xoff + c], skip = sk[pass * 512 + c];
        f32x4 acc[16];
#pragma unroll
        for (int i = 0; i < 16; ++i) acc[i] = (f32x4){0.f, 0.f, 0.f, 0.f};
        hy_conv_pass<8, HC_UP>(acc, U, GR, 0, lane);
        const bf16* ux = UT + (size_t)(xoff + c) * CT_LD + b * RPB + 4 * g;
        u32x2 keep[16];
#pragma unroll
        for (int ti = 0; ti < 16; ++ti) { const int tb = 16 * ti + 4 * g; const bf16* up = ux + 16 * ti; const u32x2 xw = *(const u32x2*)up;
            const float pv = tb > 0 ? bf2f(up[-1]) : 0.f, nx = tb + 4 < 256 ? bf2f(up[4]) : 0.f; const float u0 = bflo(xw.x), u1 = bfhi(xw.x), u2 = bflo(xw.y), u3 = bfhi(xw.y);
            const f32x4 xx = (f32x4){w0 * pv + w1 * u0 + w2 * u1 + bs, w0 * u0 + w1 * u1 + w2 * u2 + bs, w0 * u1 + w1 * u2 + w2 * u3 + bs, w0 * u2 + w1 * u3 + w2 * nx + bs};
            const u32x2 vw = *(const LAS u32x2*)(U + b * HC_UP + tb * 2); const f32x4 vv = (f32x4){bflo(vw.x), bfhi(vw.x), bflo(vw.y), bfhi(vw.y)};
            const f32x4 res = xx * (acc[ti] + vv * skip); keep[ti].x = pk2(res[0], res[1]); keep[ti].y = pk2(res[2], res[3]); }
        if (pass == 0) {
            LDS_WAIT(); asm volatile("" ::: "memory");
#pragma unroll
            for (int ti = 0; ti < 16; ++ti) *(LAS u32x2*)(U + b * HC_UP + (16 * ti + 4 * g) * 2) = keep[ti];
            hc_load_filter(HR, 1, c, GR, lane);
        } else {
#pragma unroll
            for (int ti = 0; ti < 16; ++ti) *(u32x2*)(YT + (size_t)c * CT_LD + b * RPB + 16 * ti + 4 * g) = keep[ti];
        }
    }
    LDS_WAIT(); asm volatile("" ::: "memory");
}

constexpr int WL1_0 = W_ITEMS_L1MOE, WL1_1 = WL1_0 + 2400, WL1_2 = WL1_1 + 4000, WL1_3 = WL1_2 + 1100, WL1_4 = WL1_3 + 1100, WL1_5 = W_ITEMS_ALL;
__global__ void __launch_bounds__(NTHR, 2) fwd_kernel(Args args) {
    extern __shared__ __attribute__((aligned(16))) unsigned char lds_raw[];
    Frame F; F.lds = (LAS unsigned char*)lds_raw; F.wave = __builtin_amdgcn_readfirstlane((int)threadIdx.x >> 6); F.G = gridDim.x; F.bid = blockIdx.x;
    F.ws = args.ws; F.ctl = (gu32*)(args.ws + WS_CTL);
    unsigned char* ws = args.ws;
    volatile LAS unsigned* MISC = (volatile LAS unsigned*)(F.lds + MISC_OFF);
    { const int l0 = lane_id(); if (F.wave == 0) MISC[l0] = 0u; }
    __syncthreads();
    XcdBarrier bar; bar.bar = (unsigned*)(F.ctl + CW_BAR); bar.x = 0; bar.st = nullptr;
    if (args.one_launch) bar = xcd_barrier_post((unsigned*)(F.ctl + CW_BAR), MISC + 8, F.wave == 0 && lane_id() == 0);
    const int lo = args.ph_lo, hi = args.ph_hi;
#ifndef PHASE_MASK
#define PHASE_MASK 0xFFFFFFFFu
#endif
#define IN(k) ((((PHASE_MASK) >> (k)) & 1u) && lo <= (k) && (k) < hi)
#ifndef REP_PHASE
#define REP_PHASE -1
#endif
#ifndef REP_PART
#define REP_PART 3
#endif
#define TAIL_WEIGHTS(nu_, lo_, hi_) do { const int nu__ = (nu_); const int busy__ = nu__ - (nu__ / F.G) * F.G; if (busy__ > 0 && F.bid >= busy__) weight_items(F, args, (lo_), (hi_), F.bid - busy__, F.G - busy__); else if (busy__ == 0) weight_items(F, args, (lo_), (hi_), F.bid, F.G); __syncthreads(); } while (0)
#define PH(k, ...) if (IN(k)) { __VA_ARGS__ } if (REP_PHASE == (k) && IN(k)) { __VA_ARGS__ }
#define SEAM(k) do { if (IN(k) && IN((k) + 1)) xcd_barrier(bar, F.wave == 0 && lane_id() == 0); } while (0)
    const float* MOD0 = (const float*)(ws + WS_MOD); const float* MOD1 = MOD0 + 17 * 6144;
    LAS unsigned char* ring = F.lds;

    PH(0,  p0_prologue(F, args);) SEAM(0);
    PH(1,  p_norm1_l0(F, args);) SEAM(1);
    PH(2,
        { pg8::SchedInProj S{(const char*)(ws + WS_BUF1), (const char*)(ws + WS_WHY), (const char*)(ws + WS_WATT0), F.G, F.bid};
          pg8::EpiInProj E{pg8::EpiBf16{(bf16*)(ws + WS_BUF2), CT_LD}, pg8::EpiQkv<0>{(bf16*)(ws + WS_BUF3), D_ATT0, (const f32x2*)(ws + WS_ROPE), nullptr, nullptr}};
          pg8::gemm_phase<pg8::EpiInProj, pg8::SchedInProj, true>(ring, 1024, S, E, F.wave);
          { const int busy = 9 * 272 - (9 * 272 / F.G) * F.G; if (busy > 0 && busy < F.G && F.bid >= busy) p_filter_stage_b(F, args, F.bid - busy, F.G - busy); else if (busy == 0 || busy >= F.G) p_filter_stage_b(F, args, F.bid, F.G); __syncthreads(); }
          TAIL_WEIGHTS(9 * 272, WL1_0, WL1_1); }
    ) SEAM(2);
#define P3_HY do { for (int c = F.bid; c < HYC; c += F.G) hyena_latent_unit(F, args, c); for (int c = F.bid + F.G * F.wave; c < HYC; c += F.G * NWAVES) hyena_ctx_wave(F, args, c); __syncthreads(); } while (0)
#define P3_AT do { const attn_body::bf16* QKV = (const attn_body::bf16*)(ws + WS_BUF3); attn_body::bf16* YM = (attn_body::bf16*)(ws + WS_BUF1); \
        for (int L = F.bid; L < 2048 + 128; L += F.G) { \
            if (L < 2048) { const int b = L >> 7, h = (L >> 4) & 7, qb = L & 15, q0 = qb * 256; const int lat0 = q0 >= 128 ? q0 - 128 : 0; const int lend = q0 + 384 < SEQ ? q0 + 384 : SEQ; const int NT = 4 + (lend - lat0) / 64; \
                const attn_body::bf16* base = QKV + (size_t)b * RPB * D_ATT0; \
                attn_body::attn_unit<1, D_ATT0, D_ATT0, DM, 8>(base + (size_t)(CTXL + q0) * D_ATT0 + h * 64, base + 512 + (h >> 2) * 64, base + 640 + (h >> 2) * 64, \
                    YM + ((size_t)b * RPB + CTXL + q0) * DM + 512 + h * 64, NT, lat0, q0, args.in[I_SINK][h] * LOG2E, (char*)lds_raw, F.wave, 0.f, false, false, nullptr, nullptr); } \
            else { const int r = L - 2048, b = r >> 3, h = r & 7; const attn_body::bf16* base = QKV + (size_t)b * RPB * D_ATT0; \
                attn_body::attn_unit<0, D_ATT0, D_ATT0, DM, 8>(base + h * 64, base + 512 + (h >> 2) * 64, base + 640 + (h >> 2) * 64, \
                    YM + (size_t)b * RPB * DM + 512 + h * 64, 4, 0, 0, args.in[I_SINK][h] * LOG2E, (char*)lds_raw, F.wave, 0.f, false, false, nullptr, nullptr); } } } while (0)
    if (IN(3)) {
        P3_HY; if (REP_PHASE == 3 && (REP_PART & 1)) { P3_HY; }
    } SEAM(3);
    if (IN(4)) { if (F.bid & 1) { p_transpose_y(F); __syncthreads(); } P3_AT; if (REP_PHASE == 4) { P3_AT; } if (!(F.bid & 1)) { __syncthreads(); p_transpose_y(F); } } SEAM(4);
    PH(5,
        pg8::SchedDense S; S.init(ws + WS_BUF1, ws + WS_WOUT0, NROWS, 1024, 1024, F.G, F.bid);
        pg8::EpiOut E{(bf16*)(ws + WS_Y), MOD0};
        pg8::gemm_phase<pg8::EpiOut, pg8::SchedDense, true>(ring, 1024, S, E, F.wave);
        TAIL_WEIGHTS(272 * 4, WL1_1, WL1_2);) SEAM(5);
    PH(6,  p_norm2_route<0>(F, args);) SEAM(6);
    PH(7,
        LAS int* tab = (LAS int*)(F.lds + pg8::STAGE_BYTES); moe_tab(F, tab, 0);
        pg8::SchedMoe<true> S{(const char*)(ws + WS_BUF1), (const char*)(ws + WS_WGU), (size_t)1024 * 1024 * 2, 1024, tab, (const int*)(ws + WS_TOKIDX), F.G, F.bid};
        pg8::EpiGateUp E{(bf16*)(ws + WS_BUF5)};
        pg8::gemm_phase<pg8::EpiGateUp, pg8::SchedMoe<true>, true>(ring, 1024, S, E, F.wave);
        { const int nu7 = tab[32] * 4; __syncthreads(); TAIL_WEIGHTS(nu7, WL1_2, WL1_3); }) SEAM(7);
    PH(8,
        LAS int* tab = (LAS int*)(F.lds + pg8::STAGE_BYTES); moe_tab(F, tab, 0);
        pg8::SchedMoe<false> S{(const char*)(ws + WS_BUF5), (const char*)(ws + WS_WDN), (size_t)1024 * 512 * 2, 512, tab, nullptr, F.G, F.bid};
        pg8::EpiDown E{(bf16*)(ws + WS_BUF2), (const float*)(ws + WS_GATE), tab};
        pg8::gemm_phase<pg8::EpiDown, pg8::SchedMoe<false>, true>(ring, 512, S, E, F.wave);
        { const int nu8 = tab[32] * 4; __syncthreads(); TAIL_WEIGHTS(nu8, WL1_3, WL1_4); }) SEAM(8);
    PH(9,  p_combine<0>(F, args);) SEAM(9);
    PH(10,
        pg8::SchedQkv1 S{(const char*)(ws + WS_BUF1), (const char*)(ws + WS_WQKV1), 1024, F.G, F.bid};
        pg8::EpiQkv<1> E{(bf16*)(ws + WS_BUF2), D_QKV1, (const f32x2*)(ws + WS_ROPE), args.in[I_ODQG], args.in[I_ODKG]};
        pg8::gemm_phase<pg8::EpiQkv<1>, pg8::SchedQkv1, true>(ring, 1024, S, E, F.wave);
        TAIL_WEIGHTS(256 * 6 + 32, WL1_4, WL1_5);) SEAM(10);
    PH(11,
        const attn_body::bf16* QKV = (const attn_body::bf16*)(ws + WS_BUF2); attn_body::bf16* AO = (attn_body::bf16*)(ws + WS_BUF1);
        float gqm = 0.f, gkm = 0.f; for (int d = 0; d < 64; ++d) { gqm = fmaxf(gqm, fabsf(args.in[I_ODQG][d])); gkm = fmaxf(gkm, fabsf(args.in[I_ODKG][d])); }
        const float m0 = 64.f * gqm * gkm * QSCALE * 1.02f;
        if (m0 <= 40.f) {
        for (int L = F.bid; L < 4096; L += F.G) { const int b = L >> 8, h = (L >> 4) & 15, qb = L & 15, q0 = qb * 256; const attn_body::bf16* base = QKV + (size_t)b * RPB * D_QKV1;
            const int Ln = L + F.G; const bool hn = Ln < 4096; const int bn_ = hn ? Ln >> 8 : b, hn_ = hn ? (Ln >> 4) & 15 : h, qn_ = hn ? (Ln & 15) * 256 : q0; const attn_body::bf16* basen = QKV + (size_t)bn_ * RPB * D_QKV1;
            attn_body::attn_unit<0, D_QKV1, D_QKV1, DM, 8, true>(base + (size_t)(CTXL + q0) * D_QKV1 + h * 64, base + 1024 + (h >> 2) * 64, base + 1280 + (h >> 2) * 64,
                AO + ((size_t)b * RPB + CTXL + q0) * DM + h * 64, 68, 0, 0, -INFINITY, (char*)lds_raw, F.wave, m0, L != F.bid, hn, basen + 1024 + (hn_ >> 2) * 64, basen + 1280 + (hn_ >> 2) * 64); }
        } else {
        for (int L = F.bid; L < 4096; L += F.G) { const int b = L >> 8, h = (L >> 4) & 15, qb = L & 15, q0 = qb * 256; const attn_body::bf16* base = QKV + (size_t)b * RPB * D_QKV1;
            const int Ln = L + F.G; const bool hn = Ln < 4096; const int bn_ = hn ? Ln >> 8 : b, hn_ = hn ? (Ln >> 4) & 15 : h, qn_ = hn ? (Ln & 15) * 256 : q0; const attn_body::bf16* basen = QKV + (size_t)bn_ * RPB * D_QKV1;
            attn_body::attn_unit<0, D_QKV1, D_QKV1, DM, 8, false>(base + (size_t)(CTXL + q0) * D_QKV1 + h * 64, base + 1024 + (h >> 2) * 64, base + 1280 + (h >> 2) * 64,
                AO + ((size_t)b * RPB + CTXL + q0) * DM + h * 64, 68, 0, 0, -INFINITY, (char*)lds_raw, F.wave, 0.f, L != F.bid, hn, basen + 1024 + (hn_ >> 2) * 64, basen + 1280 + (hn_ >> 2) * 64); }
        }
    ) SEAM(11);
    PH(12,
        pg8::SchedLat S{(const char*)(ws + WS_BUF1), (const char*)(ws + WS_WOUT1), 1024, 4, F.G, F.bid};
        pg8::EpiOut E{(bf16*)(ws + WS_Y), MOD1};
        pg8::gemm_phase<pg8::EpiOut, pg8::SchedLat, true>(ring, 1024, S, E, F.wave);) SEAM(12);
    PH(13,  p_norm2_route<1>(F, args);) SEAM(13);
    PH(14,
        LAS int* tab = (LAS int*)(F.lds + pg8::STAGE_BYTES); moe_tab(F, tab, 1);
        pg8::SchedMoe<true> S{(const char*)(ws + WS_BUF1), (const char*)(ws + WS_WGU) + (size_t)32 * 1024 * 1024 * 2, (size_t)1024 * 1024 * 2, 1024, tab, (const int*)(ws + WS_TOKIDX), F.G, F.bid};
        pg8::EpiGateUp E{(bf16*)(ws + WS_BUF5)};
        pg8::gemm_phase<pg8::EpiGateUp, pg8::SchedMoe<true>, true>(ring, 1024, S, E, F.wave);) SEAM(14);
    PH(15,
        LAS int* tab = (LAS int*)(F.lds + pg8::STAGE_BYTES); moe_tab(F, tab, 1);
        pg8::SchedMoe<false> S{(const char*)(ws + WS_BUF5), (const char*)(ws + WS_WDN) + (size_t)32 * 1024 * 512 * 2, (size_t)1024 * 512 * 2, 512, tab, nullptr, F.G, F.bid};
        pg8::EpiDown E{(bf16*)(ws + WS_BUF2), (const float*)(ws + WS_GATE), tab};
        pg8::gemm_phase<pg8::EpiDown, pg8::SchedMoe<false>, true>(ring, 512, S, E, F.wave);) SEAM(15);
    PH(16, p_combine<1>(F, args);)

#undef IN
#undef SEAM
}

constexpr int N_PHASES = 17;
#ifndef MK_ONE_LAUNCH
#define MK_ONE_LAUNCH 1
#endif
extern "C" void kernel_launch(void* const* d_in, const int* in_sizes, int n_in, void* d_out, int out_size, void* d_ws, size_t ws_size, hipStream_t stream) {
    static int grid = 0;
    if (grid == 0) {
        if (n_in != 32 || out_size != NB * SEQ * DM || ws_size < WS_END) { fprintf(stderr, "kernel_launch: unexpected problem (n_in %d out %d ws %zu, need ws %zu)\n", n_in, out_size, ws_size, (size_t)WS_END); grid = -1; return; }
        int dev = 0, cus = 0, per_cu = 0;
        if (hipGetDevice(&dev) != hipSuccess || hipDeviceGetAttribute(&cus, hipDeviceAttributeMultiprocessorCount, dev) != hipSuccess) { grid = -1; return; }
        if (hipFuncSetAttribute((const void*)fwd_kernel, hipFuncAttributeMaxDynamicSharedMemorySize, LDS_BYTES) != hipSuccess) { fprintf(stderr, "kernel_launch: hipFuncSetAttribute failed\n"); grid = -1; return; }
        if (hipOccupancyMaxActiveBlocksPerMultiprocessor(&per_cu, (const void*)fwd_kernel, NTHR, LDS_BYTES) != hipSuccess || per_cu < 1) fprintf(stderr, "kernel_launch: occupancy query says %d\n", per_cu);
        (void)hipGetLastError();
        grid = cus;
    }
    if (grid < 0) return;
    (void)hipMemsetAsync((char*)d_ws + WS_CTL, 0, CTL_ZERO_BYTES, stream);
    Args a{};
    for (int i = 0; i < 32; ++i) a.in[i] = (const float*)d_in[i];
    a.out = (float*)d_out; a.ws = (unsigned char*)d_ws; a.pad = 0;
    if (MK_ONE_LAUNCH) { a.ph_lo = 0; a.ph_hi = N_PHASES; a.one_launch = 1; hipLaunchKernelGGL(fwd_kernel, dim3(grid), dim3(NTHR), LDS_BYTES, stream, a); }
    else for (int p = 0; p < N_PHASES; ++p) { a.ph_lo = p; a.ph_hi = p + 1; a.one_launch = 0; hipLaunchKernelGGL(fwd_kernel, dim3(grid), dim3(NTHR), LDS_BYTES, stream, a); }
}
```

```cpp
#include <hip/hip_runtime.h>
#include <hip/hip_bf16.h>
#include <cstdio>
#include <cstdint>
#include <cmath>

#define GAS __attribute__((address_space(1)))
#define LAS __attribute__((address_space(3)))
typedef unsigned short bf16;
typedef unsigned short bf16_t;
typedef short bf16x8 __attribute__((ext_vector_type(8)));
typedef short s16x4 __attribute__((ext_vector_type(4)));
typedef float f32x2 __attribute__((ext_vector_type(2)));
typedef float f32x4 __attribute__((ext_vector_type(4)));
typedef float f32x16 __attribute__((ext_vector_type(16)));
typedef unsigned u32x2 __attribute__((ext_vector_type(2)));
typedef unsigned u32x4 __attribute__((ext_vector_type(4)));
typedef unsigned v4u __attribute__((ext_vector_type(4)));
typedef GAS unsigned gu32;

constexpr int NB = 16, SEQ = 4096, CTXL = 256, DM = 1024, RPB = SEQ + CTXL  , NROWS = NB * RPB  ;
constexpr int CT_LD = NROWS + 128;
constexpr int HYC = 512, HD = 64, NEXP = 32, DEXP = 512, NMOD = 6;
constexpr int D_IN_EVEN = 2304, D_ATT0 = 768, D_QKV1 = 1536;
constexpr float NORM_EPS = 1e-6f;
constexpr float LOG2E = 1.4426950408889634f;
constexpr float QSCALE = 0.125f * 1.4426950408889634f;
constexpr int CAP = NROWS;
constexpr int MAXSLOTS = 147456;

constexpr size_t MiB = 1u << 20;
constexpr size_t WS_CTL = 0, CTL_ZERO_BYTES = 1 * MiB;
constexpr size_t WS_MOD = 1 * MiB;
constexpr size_t WS_ROPE = 2 * MiB;
constexpr size_t WS_HD2 = 2 * MiB + 65536;
constexpr size_t WS_ROUTE = 3 * MiB + 512 * 1024;
constexpr size_t WS_TOKIDX = 5 * MiB;
constexpr size_t WS_GATE = 14 * MiB;
constexpr size_t WS_HRAW = 23 * MiB;
constexpr size_t WS_HRAWC = 55 * MiB;
constexpr size_t WS_WHY = 57 * MiB;
constexpr size_t WS_WATT0 = 60 * MiB;
constexpr size_t WS_WOUT0 = 62 * MiB;
constexpr size_t WS_WQKV1 = 64 * MiB;
constexpr size_t WS_WOUT1 = 67 * MiB;
constexpr size_t WS_WGU = 69 * MiB;
constexpr size_t WS_WDN = 197 * MiB;
constexpr size_t WS_XC = 261 * MiB;
constexpr size_t WS_BUF1 = 277 * MiB;
constexpr size_t WS_BUF2 = 413 * MiB;
constexpr size_t WS_BUF3 = 618 * MiB;
constexpr size_t WS_BUF5 = 720 * MiB;
constexpr size_t WS_BUF4 = 864 * MiB;
constexpr size_t WS_Y = 864 * MiB;
constexpr size_t WS_END = 1000 * MiB;
static_assert(WS_BUF2 + (size_t)1536 * CT_LD * 2 <= WS_BUF3 && WS_BUF4 + (size_t)512 * CT_LD * 2 <= WS_END, "padded channel-major images fit");
static_assert(WS_BUF2 + (size_t)MAXSLOTS * 1024 * 2 <= WS_BUF5, "MOUT fits BUF2+BUF3");
constexpr int CW_TMO = 0, CW_CODE = 1;
constexpr int CW_CNT = 1024;
constexpr int CW_BAR = 4096;

constexpr int LDS_BYTES = 160 * 1024 - 256;
constexpr int MISC_OFF = LDS_BYTES - 256;

#define RLX_AGENT __ATOMIC_RELAXED, __HIP_MEMORY_SCOPE_AGENT
#define LDS_WAIT() asm volatile("s_waitcnt lgkmcnt(0)" ::: "memory")
#define VM_WAIT() asm volatile("s_waitcnt vmcnt(0)" ::: "memory")
__device__ __forceinline__ unsigned f2bf(float f) { unsigned u = __builtin_bit_cast(unsigned, f); return (u + 0x7fffu + ((u >> 16) & 1u)) >> 16; }
typedef float f32x2_t_ __attribute__((ext_vector_type(2))); typedef __bf16 bf16x2_t_ __attribute__((ext_vector_type(2)));
__device__ __forceinline__ unsigned pk2(float lo, float hi) { f32x2_t_ v = {lo, hi}; bf16x2_t_ b = __builtin_convertvector(v, bf16x2_t_); return __builtin_bit_cast(unsigned, b); }
__device__ __forceinline__ float bf2f(unsigned short b) { return __builtin_bit_cast(float, (unsigned)b << 16); }
__device__ __forceinline__ float bflo(unsigned w) { return __builtin_bit_cast(float, w << 16); }
__device__ __forceinline__ float bfhi(unsigned w) { return __builtin_bit_cast(float, w & 0xffff0000u); }
__device__ __forceinline__ unsigned cvt_pk_bf16(float lo, float hi) { unsigned r; asm volatile("v_cvt_pk_bf16_f32 %0, %1, %2" : "=v"(r) : "v"(lo), "v"(hi)); return r; }
__device__ __forceinline__ float wave_sum(float v) {
#pragma unroll
    for (int o = 1; o < 64; o <<= 1) v += __shfl_xor(v, o);
    return v;
}
__device__ __forceinline__ int lane_id() { unsigned z = 0u; asm volatile("" : "+s"(z)); return (int)__builtin_amdgcn_mbcnt_hi(~0u, __builtin_amdgcn_mbcnt_lo(~0u, z)); }
__device__ __forceinline__ float silu_f(float x) { return x / (1.f + __expf(-x)); }
namespace pg8 {
constexpr int BM = 256, BK = 64, HALF = 128, HTB = HALF * BK * 2  , STAGE_BYTES = 8 * HTB, NXCD = 8, WGM = 8;
__host__ __device__ __forceinline__ int lds_byte(int r, int c) { const int st = (r >> 4) * 2 + (c >> 5), rr = r & 15, cc = c & 31, ob = rr * 64 + cc * 2; return st * 1024 + (ob ^ (((ob >> 9) & 1) << 5)); }
__host__ __device__ __forceinline__ void stage_rc(int b, int& R, int& C) { const int st = b / 1024, sb = b % 1024, swz = sb ^ (((sb >> 9) & 1) << 5); R = (st >> 1) * 16 + swz / 64; C = (st & 1) * 32 + (swz % 64) / 2; }
__host__ __device__ __forceinline__ int perm32(int rho) { const int n = rho >> 4, i = rho & 15; return 8 * (i >> 2) + 4 * n + (i & 3); }

struct Unit { int pm, pn, e, aux; };

template <class Epi, class Sched, bool ALIGN_EPI = false>
__device__ __forceinline__ void gemm_phase(LAS unsigned char* lds, const int K, const Sched& S, const Epi& E, const int wave_id) {
    const int wid = wave_id, lane = lane_id(), tid = wid * 64 + lane, wr = wid >> 2, wc = wid & 3, fr = lane & 15, fq = lane >> 4;
    const int nt = K / BK;
    int R0, C0, R1, C1; stage_rc(tid * 16, R0, C0); stage_rc(tid * 16 + 8192, R1, C1);
    unsigned voffB[2];
    voffB[0] = (unsigned)(((R0 & ~31) + perm32(R0 & 31)) * K + C0) * 2u; voffB[1] = (unsigned)(((R1 & ~31) + perm32(R1 & 31)) * K + C1) * 2u;
    const size_t kstep = (size_t)(BK * 2);
    const size_t hstep = (size_t)HALF * K * 2;
    const unsigned ldsw = (unsigned)wid * 1024u;
    const int aoff = lds_byte(wr * 64 + fr, fq * 8), boff = lds_byte(wc * 32 + fr, fq * 8);
#define PG8_SA(b, h) (((b) * 2 + (h)) * HTB)
#define PG8_SB(b, h) ((4 + (b) * 2 + (h)) * HTB)
#define PG8_STAGE2(bufoff, gbase, v0, v1) do { \
        __builtin_amdgcn_global_load_lds((const unsigned*)((const char*)(gbase) + (v0)), (LAS unsigned*)(lds + (bufoff) + ldsw), 16, 0, 0); \
        __builtin_amdgcn_global_load_lds((const unsigned*)((const char*)(gbase) + (v1)), (LAS unsigned*)(lds + (bufoff) + ldsw + 8192), 16, 0, 0); } while (0)
#define PG8_STAGEB(bufoff, gbase) PG8_STAGE2(bufoff, gbase, voffB[0], voffB[1])
#define PG8_LDA(dst, b, h) do { _Pragma("unroll") for (int m = 0; m < 4; ++m) _Pragma("unroll") for (int k = 0; k < 2; ++k) dst[m][k] = *(const LAS bf16x8*)(lds + PG8_SA(b, h) + aoff + m * 2048 + k * 1024); } while (0)
#define PG8_LDB(dst, b, h) do { _Pragma("unroll") for (int n = 0; n < 2; ++n) _Pragma("unroll") for (int k = 0; k < 2; ++k) dst[n][k] = *(const LAS bf16x8*)(lds + PG8_SB(b, h) + boff + n * 2048 + k * 1024); } while (0)
#define PG8_MMA(ai, bj, At, Bt) do { __builtin_amdgcn_s_setprio(1); _Pragma("unroll") for (int m = 0; m < 4; ++m) _Pragma("unroll") for (int n = 0; n < 2; ++n) _Pragma("unroll") for (int k = 0; k < 2; ++k) \
        acc[ai][bj][m][n] = __builtin_amdgcn_mfma_f32_16x16x32_bf16(Bt[n][k], At[m][k], acc[ai][bj][m][n], 0, 0, 0); __builtin_amdgcn_s_setprio(0); } while (0)
#define PG8_WAIT_V(n) asm volatile("s_waitcnt vmcnt(" #n ")" ::: "memory")
#define PG8_WAIT_L(n) asm volatile("s_waitcnt lgkmcnt(" #n ")" ::: "memory")
#define PG8_BAR __builtin_amdgcn_s_barrier()
#define PG8_SCHED __builtin_amdgcn_sched_barrier(0)
    Unit cur, nxt; int ui = 0;
    if (!S.next(0, cur)) return;
    f32x4 acc[2][2][4][2];
#pragma unroll
    for (int a = 0; a < 2; ++a)
#pragma unroll
        for (int b = 0; b < 2; ++b)
#pragma unroll
            for (int m = 0; m < 4; ++m)
#pragma unroll
                for (int n = 0; n < 2; ++n) acc[a][b][m][n] = (f32x4){0.f, 0.f, 0.f, 0.f};
    bf16x8 At[4][2], B0[2][2], B1[2][2];
    unsigned cv00, cv01, cv10, cv11, nv00, nv01, nv10, nv11;
    if constexpr (Sched::GATHER) { int r0, r1, r2, r3; S.a_rows(cur, R0, R1, r0, r1, r2, r3);
        cv00 = (unsigned)(r0 * K + C0) * 2u; cv01 = (unsigned)(r1 * K + C1) * 2u; cv10 = (unsigned)(r2 * K + C0) * 2u; cv11 = (unsigned)(r3 * K + C1) * 2u;
    } else { cv00 = (unsigned)(R0 * K + C0) * 2u; cv01 = (unsigned)(R1 * K + C1) * 2u; cv10 = cv00 + (unsigned)hstep; cv11 = cv01 + (unsigned)hstep; }
    nv00 = cv00; nv01 = cv01; nv10 = cv10; nv11 = cv11;
    const char* cA = S.a_base(cur); const char* cB = S.b_base(cur);
    PG8_STAGEB(PG8_SB(0, 0), cB); PG8_STAGEB(PG8_SB(0, 1), cB + hstep); PG8_STAGE2(PG8_SA(0, 0), cA, cv00, cv01); PG8_STAGE2(PG8_SA(0, 1), cA, cv10, cv11);
    if (wr == 1) PG8_BAR;
    PG8_WAIT_V(2); PG8_BAR;
    PG8_STAGEB(PG8_SB(1, 0), cB + kstep); PG8_STAGE2(PG8_SA(1, 0), cA + kstep, cv00, cv01); PG8_STAGEB(PG8_SB(1, 1), cB + hstep + kstep);
    PG8_WAIT_V(6); PG8_BAR;
    for (;;) {
        const bool has_next = S.next(ui + 1, nxt);
        const char* nA = has_next ? S.a_base(nxt) : cA; const char* nB = has_next ? S.b_base(nxt) : cB;
        if constexpr (Sched::GATHER) { if (has_next) { int r0, r1, r2, r3; S.a_rows(nxt, R0, R1, r0, r1, r2, r3);
            nv00 = (unsigned)(r0 * K + C0) * 2u; nv01 = (unsigned)(r1 * K + C1) * 2u; nv10 = (unsigned)(r2 * K + C0) * 2u; nv11 = (unsigned)(r3 * K + C1) * 2u; } else { nv00 = cv00; nv01 = cv01; nv10 = cv10; nv11 = cv11; } }
        for (int t = 0; t < nt; t += 2) {
            const bool last = (t == nt - 2);
            const char* a1 = cA + (size_t)(t + 1) * kstep;
            const char* a2 = last ? nA : cA + (size_t)(t + 2) * kstep; const char* b2 = last ? nB : cB + (size_t)(t + 2) * kstep;
            const char* a3 = a2 + kstep; const char* b3 = b2 + kstep;
            unsigned s00 = cv00, s01 = cv01, s10 = cv10, s11 = cv11;
            if constexpr (Sched::GATHER) { if (last) { s00 = nv00; s01 = nv01; s10 = nv10; s11 = nv11; } }
            PG8_LDB(B0, 0, 0); PG8_LDB(B1, 0, 1); PG8_SCHED; PG8_LDA(At, 0, 0); PG8_STAGE2(PG8_SA(1, 1), a1, cv10, cv11);
            PG8_WAIT_V(8); PG8_WAIT_L(0); PG8_BAR; PG8_MMA(0, 0, At, B0); PG8_MMA(0, 1, At, B1); PG8_BAR; PG8_SCHED;
            PG8_LDA(At, 0, 1); PG8_STAGEB(PG8_SB(0, 0), b2); PG8_STAGEB(PG8_SB(0, 1), b2 + hstep); PG8_STAGE2(PG8_SA(0, 0), a2, s00, s01);
            PG8_WAIT_V(8); PG8_WAIT_L(0); PG8_BAR; PG8_MMA(1, 0, At, B0); PG8_MMA(1, 1, At, B1); PG8_BAR; PG8_SCHED;
            PG8_LDB(B0, 1, 0); PG8_LDB(B1, 1, 1); PG8_SCHED; PG8_LDA(At, 1, 0); PG8_STAGE2(PG8_SA(0, 1), a2, s10, s11);
            PG8_WAIT_V(8); PG8_WAIT_L(0); PG8_BAR; PG8_MMA(0, 0, At, B0); PG8_MMA(0, 1, At, B1); PG8_BAR; PG8_SCHED;
            PG8_LDA(At, 1, 1); PG8_STAGEB(PG8_SB(1, 0), b3); PG8_STAGEB(PG8_SB(1, 1), b3 + hstep); PG8_STAGE2(PG8_SA(1, 0), a3, s00, s01);
            PG8_WAIT_V(8); PG8_WAIT_L(0); PG8_BAR; PG8_MMA(1, 0, At, B0); PG8_MMA(1, 1, At, B1); PG8_BAR; PG8_SCHED;
        }
        if constexpr (ALIGN_EPI) { if (wr == 0) PG8_BAR; }
        E(acc, cur, wr, wc, fr, fq);
        if (!has_next) break;
#pragma unroll
        for (int a = 0; a < 2; ++a)
#pragma unroll
            for (int b = 0; b < 2; ++b)
#pragma unroll
                for (int m = 0; m < 4; ++m)
#pragma unroll
                    for (int n = 0; n < 2; ++n) acc[a][b][m][n] = (f32x4){0.f, 0.f, 0.f, 0.f};
        cur = nxt; cA = nA; cB = nB; ++ui; cv00 = nv00; cv01 = nv01; cv10 = nv10; cv11 = nv11;
        if constexpr (ALIGN_EPI) { if (wr == 1) PG8_BAR; }
    }
    PG8_WAIT_V(0);
    if constexpr (!ALIGN_EPI) { if (wr == 0) PG8_BAR; }
    PG8_BAR;
#undef PG8_SA
#undef PG8_SB
#undef PG8_STAGE2
#undef PG8_STAGEB
#undef PG8_LDA
#undef PG8_LDB
#undef PG8_MMA
#undef PG8_WAIT_V
#undef PG8_WAIT_L
#undef PG8_BAR
#undef PG8_SCHED
}
}
namespace pg8 {
__device__ __forceinline__ int xcd_remap(int L, int n) { const int q = n / NXCD, r = n % NXCD, xcd = L % NXCD, off = L / NXCD; return (xcd < r ? xcd * (q + 1) : r * (q + 1) + (xcd - r) * q) + off; }
struct SchedDense {
    static constexpr bool GATHER = false;
    const char* A; const char* Bt; int K; int nM, nN, nwg, G, c;
    __device__ __forceinline__ void init(const void* A_, const void* Bt_, int M, int N, int K_, int G_, int c_) { A = (const char*)A_; Bt = (const char*)Bt_; K = K_; nM = M / BM; nN = N / BM; nwg = nM * nN; G = G_; c = c_; }
    __device__ __forceinline__ bool next(int i, Unit& u) const {
        const long L = (long)i * G + c; if (L >= nwg) return false;
        int wgid = (int)L; { const int q = nwg / NXCD, r = nwg % NXCD, xcd = wgid % NXCD, off = wgid / NXCD; wgid = (xcd < r ? xcd * (q + 1) : r * (q + 1) + (xcd - r) * q) + off; }
        const int nig = WGM * nN, gid = wgid / nig, fm = gid * WGM, gsz = (nM - fm) < WGM ? (nM - fm) : WGM;
        u.pm = fm + ((wgid % nig) % gsz); u.pn = (wgid % nig) / gsz; u.e = 0; u.aux = 0; return true;
    }
    __device__ __forceinline__ const char* a_base(const Unit& u) const { return A + (size_t)u.pm * BM * K * 2; }
    __device__ __forceinline__ const char* b_base(const Unit& u) const { return Bt + (size_t)u.pn * BM * K * 2; }
    __device__ __forceinline__ void a_rows(const Unit&, int, int, int&, int&, int&, int&) const {}
};
struct SchedQkv1 {
    static constexpr bool GATHER = false;
    const char* A; const char* Bt; int K; int G, c;
    __device__ __forceinline__ bool next(int i, Unit& u) const {
        const int L0 = i * G + c; if (L0 >= 256 * 6 + 32) return false; const int L = xcd_remap(L0, 256 * 6 + 32); const int NL = 256 * 6;
        if (L < NL) { const int g = L / 48, w = L % 48; const int lt = g * 8 + (w % 8); u.pn = w / 8; u.pm = (lt / 16) * 17 + 1 + (lt % 16); u.e = 0; u.aux = 0; return true; }
        const int r = L - NL; if (r >= 32) return false;
        u.pm = (r >> 1) * 17; u.pn = 4 + (r & 1); u.e = 0; u.aux = 0; return true;
    }
    __device__ __forceinline__ const char* a_base(const Unit& u) const { return A + (size_t)u.pm * BM * K * 2; }
    __device__ __forceinline__ const char* b_base(const Unit& u) const { return Bt + (size_t)u.pn * BM * K * 2; }
    __device__ __forceinline__ void a_rows(const Unit&, int, int, int&, int&, int&, int&) const {}
};
struct SchedInProj {
    static constexpr bool GATHER = false;
    const char* H; const char* Why; const char* Watt; int G, c;
    __device__ __forceinline__ bool next(int i, Unit& u) const {
        const int L0 = i * G + c; if (L0 >= 9 * 272) return false; const int L = xcd_remap(L0, 9 * 272); const int N0 = 6 * 272;
        if (L < N0) { u.e = 0; u.pn = L / 6; u.pm = L % 6; u.aux = 0; return true; }
        const int r = L - N0; if (r >= 3 * 272) return false;
        u.e = 1; const int g = r / 24, w = r % 24; u.pm = g * 8 + (w % 8); u.pn = w / 8; u.aux = 0; return true;
    }
    __device__ __forceinline__ const char* a_base(const Unit& u) const { return (u.e == 0 ? Why : H) + (size_t)u.pm * BM * 1024 * 2; }
    __device__ __forceinline__ const char* b_base(const Unit& u) const { return (u.e == 0 ? H : Watt) + (size_t)u.pn * BM * 1024 * 2; }
    __device__ __forceinline__ void a_rows(const Unit&, int, int, int&, int&, int&, int&) const {}
};
struct SchedLat {
    static constexpr bool GATHER = false;
    const char* A; const char* Bt; int K; int nN; int G, c;
    __device__ __forceinline__ bool next(int i, Unit& u) const {
        const int L0 = i * G + c; if (L0 >= 256 * nN) return false; const int L = xcd_remap(L0, 256 * nN);
        const int per = 8 * nN; const int g = L / per, w = L % per; const int lt = g * 8 + (w % 8); u.pn = w / 8; u.pm = (lt / 16) * 17 + 1 + (lt % 16); u.e = 0; u.aux = 0; return true;
    }
    __device__ __forceinline__ const char* a_base(const Unit& u) const { return A + (size_t)u.pm * BM * K * 2; }
    __device__ __forceinline__ const char* b_base(const Unit& u) const { return Bt + (size_t)u.pn * BM * K * 2; }
    __device__ __forceinline__ void a_rows(const Unit&, int, int, int&, int&, int&, int&) const {}
};
template <bool GATH>
struct SchedMoe {
    static constexpr bool GATHER = GATH;
    const char* A; const char* W; size_t wstride; int K; const LAS int* tab; const int* tokidx; int G, c;
    __device__ __forceinline__ bool next(int i, Unit& u) const {
        const int L0 = i * G + c; const int nu = tab[32] * 4; if (L0 >= nu) return false; const int L = xcd_remap(L0, nu); const int tau = L >> 2;
        int e = 0;
#pragma unroll 1
        for (int s = 16; s >= 1; s >>= 1) if (tab[e + s] <= tau) e += s;
        u.pm = tau; u.pn = L & 3; u.e = e; u.aux = tau - tab[e]; return true;
    }
    __device__ __forceinline__ const char* a_base(const Unit& u) const { return GATH ? A : A + (size_t)u.pm * BM * K * 2; }
    __device__ __forceinline__ const char* b_base(const Unit& u) const { return W + (size_t)u.e * wstride + (size_t)u.pn * BM * K * 2; }
    __device__ __forceinline__ void a_rows(const Unit& u, int R0, int R1, int& r0, int& r1, int& r2, int& r3) const {
        const int cnt = tab[64 + u.e]; const int* ti = tokidx + (size_t)u.e * CAP; const int p = u.aux * BM;
        int p0 = p + R0, p1 = p + R1, p2 = p + 128 + R0, p3 = p + 128 + R1;
        p0 = p0 < cnt ? p0 : 0; p1 = p1 < cnt ? p1 : 0; p2 = p2 < cnt ? p2 : 0; p3 = p3 < cnt ? p3 : 0;
        r0 = ti[p0]; r1 = ti[p1]; r2 = ti[p2]; r3 = ti[p3];
    }
};

struct EpiBf16 {
    bf16* O; int ldc;
    __device__ __forceinline__ void operator()(const f32x4 (&acc)[2][2][4][2], const Unit& u, int wr, int wc, int fr, int fq) const {
        const int row0 = u.pm * BM + wr * 64 + fr, col0 = u.pn * BM + wc * 32 + 8 * fq;
#pragma unroll
        for (int ai = 0; ai < 2; ++ai)
#pragma unroll
            for (int m = 0; m < 4; ++m) { bf16* rowp = O + (size_t)(row0 + ai * HALF + m * 16) * ldc + col0;
#pragma unroll
                for (int bj = 0; bj < 2; ++bj) { const f32x4 v0 = acc[ai][bj][m][0], v1 = acc[ai][bj][m][1];
                    u32x4 w; w.x = cvt_pk_bf16(v0[0], v0[1]); w.y = cvt_pk_bf16(v0[2], v0[3]); w.z = cvt_pk_bf16(v1[0], v1[1]); w.w = cvt_pk_bf16(v1[2], v1[3]);
                    *(u32x4*)(rowp + bj * HALF) = w; } }
    }
};
template <int LAYER>
struct EpiQkv {
    bf16* O; int ldc; const f32x2* rope  ; const float* qg; const float* kg;
    __device__ __forceinline__ void operator()(const f32x4 (&acc)[2][2][4][2], const Unit& u, int wr, int wc, int fr, int fq) const {
        const bool ctx = (u.pm % 17) == 0;
        const int jrow0 = u.pm * BM + wr * 64 + fr;
        const int t0 = ((u.pm % 17) - 1) * BM + wr * 64 + fr;
#pragma unroll
        for (int bj = 0; bj < 2; ++bj) {
            int kind;
            if (LAYER == 0) kind = (u.pn < 2) ? 0 : (bj == 0 ? 1 : 2); else kind = (u.pn < 4) ? 0 : (u.pn == 4 ? 1 : 2);
            const bool l0kv = (LAYER == 0 && u.pn == 2);
            const int half = l0kv ? (wc & 1) : bj;
            const int colb = l0kv ? (u.pn * BM + bj * HALF + wc * 32) : (u.pn * BM + wc * 64 + bj * 32);
#pragma unroll
            for (int ai = 0; ai < 2; ++ai)
#pragma unroll
                for (int m = 0; m < 4; ++m) {
                    f32x4 v0 = acc[ai][bj][m][0], v1 = acc[ai][bj][m][1];
                    const int roff = ai * HALF + m * 16;
                    if (LAYER == 1 && kind != 2) {
                        const f32x4 w0 = acc[ai][bj ^ 1][m][0], w1 = acc[ai][bj ^ 1][m][1];
                        float ss = (v0[0] * v0[0] + v0[1] * v0[1]) + (v0[2] * v0[2] + v0[3] * v0[3]) + (v1[0] * v1[0] + v1[1] * v1[1]) + (v1[2] * v1[2] + v1[3] * v1[3])
                                 + (w0[0] * w0[0] + w0[1] * w0[1]) + (w0[2] * w0[2] + w0[3] * w0[3]) + (w1[0] * w1[0] + w1[1] * w1[1]) + (w1[2] * w1[2] + w1[3] * w1[3]);
                        ss += __shfl_xor(ss, 16); ss += __shfl_xor(ss, 32);
                        const float rs = rsqrtf(ss * (1.f / 64.f) + NORM_EPS);
                        const float* g = (kind == 0 ? qg : kg) + 32 * bj;
                        const f32x4 g0 = *(const f32x4*)(g + 4 * fq), g1 = *(const f32x4*)(g + 16 + 4 * fq);
                        v0 = v0 * rs * g0; v1 = v1 * rs * g1;
                    }
                    if (kind != 2 && !ctx) {
                        const int t = t0 + roff; const int pos = half == 0 ? (t >> 6) : (t & 63);
                        const f32x2* rp = rope + pos * 16 + 4 * fq;
                        f32x4 a, b;
#pragma unroll
                        for (int i = 0; i < 4; ++i) { const f32x2 cs = rp[i]; a[i] = v0[i] * cs.x - v1[i] * cs.y; b[i] = v1[i] * cs.x + v0[i] * cs.y; }
                        v0 = a; v1 = b;
                    }
                    if (kind == 0) { v0 = v0 * QSCALE; v1 = v1 * QSCALE; }
                    u32x4 w; w.x = cvt_pk_bf16(v0[0], v0[1]); w.y = cvt_pk_bf16(v0[2], v0[3]); w.z = cvt_pk_bf16(v1[0], v1[1]); w.w = cvt_pk_bf16(v1[2], v1[3]);
                    *(u32x4*)(O + (size_t)(jrow0 + roff) * ldc + colb + 8 * fq) = w;
                }
        }
    }
};
struct EpiInProj {
    EpiBf16 e0; EpiQkv<0> e1;
    __device__ __forceinline__ void operator()(const f32x4 (&acc)[2][2][4][2], const Unit& u, int wr, int wc, int fr, int fq) const { if (u.e == 0) e0(acc, u, wr, wc, fr, fq); else e1(acc, u, wr, wc, fr, fq); }
};
struct EpiOut {
    bf16* Y; const float* mod  ;
    __device__ __forceinline__ void operator()(const f32x4 (&acc)[2][2][4][2], const Unit& u, int wr, int wc, int fr, int fq) const {
        const int b = u.pm / 17, j = u.pm % 17; const bool ctx = (j == 0);
        const float* g = mod + ((size_t)(ctx ? 16 : b) * NMOD + 2) * DM;
        const int row0 = u.pm * BM + wr * 64 + fr, col0 = u.pn * BM + wc * 32 + 8 * fq;
        f32x4 gv[2][2];
#pragma unroll
        for (int bj = 0; bj < 2; ++bj)
#pragma unroll
            for (int n = 0; n < 2; ++n) gv[bj][n] = *(const f32x4*)(g + col0 + bj * HALF + 4 * n);
#pragma unroll
        for (int ai = 0; ai < 2; ++ai)
#pragma unroll
            for (int m = 0; m < 4; ++m) { bf16* rowp = Y + (size_t)(row0 + ai * HALF + m * 16) * DM + col0;
#pragma unroll
                for (int bj = 0; bj < 2; ++bj) { const f32x4 v0 = acc[ai][bj][m][0] * gv[bj][0], v1 = acc[ai][bj][m][1] * gv[bj][1];
                    u32x4 w; w.x = cvt_pk_bf16(v0[0], v0[1]); w.y = cvt_pk_bf16(v0[2], v0[3]); w.z = cvt_pk_bf16(v1[0], v1[1]); w.w = cvt_pk_bf16(v1[2], v1[3]);
                    *(u32x4*)(rowp + bj * HALF) = w; } }
    }
};
struct EpiGateUp {
    bf16* HID;
    __device__ __forceinline__ void operator()(const f32x4 (&acc)[2][2][4][2], const Unit& u, int wr, int wc, int fr, int fq) const {
        const int row0 = u.pm * BM + wr * 64 + fr, col0 = u.pn * 128 + wc * 32 + 8 * fq;
#pragma unroll
        for (int ai = 0; ai < 2; ++ai)
#pragma unroll
            for (int m = 0; m < 4; ++m) {
                const f32x4 g0 = acc[ai][0][m][0], g1 = acc[ai][0][m][1], u0 = acc[ai][1][m][0], u1 = acc[ai][1][m][1];
                float h[8];
#pragma unroll
                for (int i = 0; i < 4; ++i) { h[i] = g0[i] / (1.f + __expf(-g0[i])) * u0[i]; h[4 + i] = g1[i] / (1.f + __expf(-g1[i])) * u1[i]; }
                u32x4 w; w.x = cvt_pk_bf16(h[0], h[1]); w.y = cvt_pk_bf16(h[2], h[3]); w.z = cvt_pk_bf16(h[4], h[5]); w.w = cvt_pk_bf16(h[6], h[7]);
                *(u32x4*)(HID + (size_t)(row0 + ai * HALF + m * 16) * DEXP + col0) = w; }
    }
};
struct EpiDown {
    bf16* MOUT; const float* gate; const LAS int* tab;
    __device__ __forceinline__ void operator()(const f32x4 (&acc)[2][2][4][2], const Unit& u, int wr, int wc, int fr, int fq) const {
        const int r0 = wr * 64 + fr, col0 = u.pn * BM + wc * 32 + 8 * fq; const int cnt = tab[64 + u.e]; const float* gp = gate + (size_t)u.e * CAP;
#pragma unroll
        for (int ai = 0; ai < 2; ++ai)
#pragma unroll
            for (int m = 0; m < 4; ++m) { const int r = r0 + ai * HALF + m * 16; const int pos = u.aux * BM + r; const float gt = pos < cnt ? gp[pos] : 0.f;
                bf16* rowp = MOUT + (size_t)(u.pm * BM + r) * DM + col0;
#pragma unroll
                for (int bj = 0; bj < 2; ++bj) { const f32x4 v0 = acc[ai][bj][m][0] * gt, v1 = acc[ai][bj][m][1] * gt;
                    u32x4 w; w.x = cvt_pk_bf16(v0[0], v0[1]); w.y = cvt_pk_bf16(v0[2], v0[3]); w.z = cvt_pk_bf16(v1[0], v1[1]); w.w = cvt_pk_bf16(v1[2], v1[3]);
                    *(u32x4*)(rowp + bj * HALF) = w; } }
    }
};
}
namespace attn_body {
using bf16=__hip_bfloat16;
using bf16x8=__attribute__((ext_vector_type(8)))short;
using s16x4=__attribute__((ext_vector_type(4)))short;
using f32x16=__attribute__((ext_vector_type(16)))float;
using u32x4=__attribute__((ext_vector_type(4)))unsigned;
constexpr int D=64;
constexpr int NW=8,QBLK=32,QB=QBLK*NW,KVBLK=64;
__device__ __forceinline__ int crow(int r,int hi){return (r&3)+8*(r>>2)+4*hi;}
#define SBAR() __builtin_amdgcn_sched_barrier(0)
__device__ __forceinline__ void swamask(f32x16&p0,f32x16&p1,int d0){
  const float NEG=-INFINITY;
  #pragma unroll
  for(int r=0;r<16;++r){const int d=d0+(r&3)+8*(r>>2); if((unsigned)(d+128)>256u)p0[r]=NEG; if((unsigned)(d+160)>256u)p1[r]=NEG;}
}

constexpr int NSLOT=3, SLOTB=8192;
constexpr int LDS_K=0, LDS_V=NSLOT*SLOTB, LDS_WS=2*NSLOT*SLOTB, LDS_OST=LDS_WS+NW*64*4, LDS_BYTES=LDS_OST+NW*4096;
constexpr float C2=0.125f*1.4426950408889634f;
__device__ __forceinline__ void glds16(const void*gsrc,unsigned lds_dst){unsigned keep;
  asm volatile("s_mov_b32 %0, m0\n\ts_mov_b32 m0, %2\n\ts_nop 0\n\tglobal_load_lds_dwordx4 %1, off\n\ts_mov_b32 m0, %0":"=&s"(keep):"v"(gsrc),"s"(lds_dst):"memory");}
__device__ __forceinline__ float max3f(float a,float b,float c){float r;asm("v_max3_f32 %0, %1, %2, %3":"=v"(r):"v"(a),"v"(b),"v"(c));return r;}
__device__ __forceinline__ float max2f(float a,float b){float r;asm("v_max_f32_e32 %0, %1, %2":"=v"(r):"v"(a),"v"(b));return r;}
__device__ __forceinline__ float fadd_s(float a,float b){float r;asm("v_add_f32_e32 %0, %1, %2":"=v"(r):"v"(a),"v"(b));return r;}
__device__ __forceinline__ float fsub_s(float a,float b){float r;asm("v_sub_f32_e32 %0, %1, %2":"=v"(r):"v"(a),"v"(b));return r;}
typedef float f32x2_t __attribute__((ext_vector_type(2))); typedef __bf16 bf16x2_t __attribute__((ext_vector_type(2)));
__device__ __forceinline__ unsigned cvtpk_s(float lo,float hi){f32x2_t v={lo,hi};bf16x2_t b=__builtin_convertvector(v,bf16x2_t);return __builtin_bit_cast(unsigned,b);}
#define WAIT_BAR(N) asm volatile("s_waitcnt vmcnt(" #N ") lgkmcnt(0)\n\ts_barrier":::"memory")

__device__ __forceinline__ void qkt(f32x16&p0,f32x16&p1,const char*Kslot,const bf16x8*qr,const f32x16&negm,int r32,int hi){
  const char*kb=Kslot+hi*1024+r32*16;
  #pragma unroll
  for(int d0=0;d0<4;++d0){
    const bf16x8 b0=*reinterpret_cast<const bf16x8*>(kb+d0*2048);
    const bf16x8 b1=*reinterpret_cast<const bf16x8*>(kb+d0*2048+512);
    if(d0==0){p0=__builtin_amdgcn_mfma_f32_32x32x16_bf16(b0,qr[0],negm,0,0,0);p1=__builtin_amdgcn_mfma_f32_32x32x16_bf16(b1,qr[0],negm,0,0,0);}
    else{p0=__builtin_amdgcn_mfma_f32_32x32x16_bf16(b0,qr[d0],p0,0,0,0);p1=__builtin_amdgcn_mfma_f32_32x32x16_bf16(b1,qr[d0],p1,0,0,0);}}
}
typedef __attribute__((address_space(3))) const char* lds_cptr;
typedef short v4i16_t __attribute__((ext_vector_type(4)));
__device__ __forceinline__ void kload8(bf16x8*kf,lds_cptr kp){
  kf[0]=*(const __attribute__((address_space(3))) bf16x8*)(kp);      kf[1]=*(const __attribute__((address_space(3))) bf16x8*)(kp+512);
  kf[2]=*(const __attribute__((address_space(3))) bf16x8*)(kp+2048); kf[3]=*(const __attribute__((address_space(3))) bf16x8*)(kp+2560);
  kf[4]=*(const __attribute__((address_space(3))) bf16x8*)(kp+4096); kf[5]=*(const __attribute__((address_space(3))) bf16x8*)(kp+4608);
  kf[6]=*(const __attribute__((address_space(3))) bf16x8*)(kp+6144); kf[7]=*(const __attribute__((address_space(3))) bf16x8*)(kp+6656);
}
__device__ __forceinline__ void kload2(bf16x8*kf,lds_cptr kp,int j){ kf[2*j]=*(const __attribute__((address_space(3))) bf16x8*)(kp+j*2048); kf[2*j+1]=*(const __attribute__((address_space(3))) bf16x8*)(kp+j*2048+512); }
__device__ __forceinline__ s16x4 vtr(lds_cptr p){ return __builtin_bit_cast(s16x4,__builtin_amdgcn_ds_read_tr16_b64_v4i16((__attribute__((address_space(3))) v4i16_t*)p)); }
__device__ __forceinline__ float rowmax(const f32x16&p0,const f32x16&p1){
  float a=max3f(p0[0],p0[1],p1[0]),b=max3f(p0[2],p0[3],p1[1]);a=max3f(a,p1[2],p1[3]);
  #pragma unroll
  for(int r=4;r<16;r+=4){a=max3f(a,p0[r],p0[r+1]);b=max3f(b,p0[r+2],p0[r+3]);a=max3f(a,p1[r],p1[r+1]);b=max3f(b,p1[r+2],p1[r+3]);}
  const float m=max2f(a,b);
  auto rr=__builtin_amdgcn_permlane32_swap(__float_as_uint(m),__float_as_uint(m),false,false);
  return max2f(__uint_as_float(rr[0]),__uint_as_float(rr[1]));
}
__device__ __forceinline__ void pv(f32x16*o,int vb,bf16x8 pa0,bf16x8 pa1,bf16x8 pa2,bf16x8 pa3){
  #pragma unroll
  for(int d0=0;d0<2;++d0){s16x4 lo[4],hi[4];
    #pragma unroll
    for(int ks=0;ks<4;++ks){
      asm volatile("ds_read_b64_tr_b16 %0,%1 offset:%c2":"=&v"(lo[ks]):"v"(vb),"i"(d0*4096+ks*1024):"memory");
      asm volatile("ds_read_b64_tr_b16 %0,%1 offset:%c2":"=&v"(hi[ks]):"v"(vb),"i"(d0*4096+ks*1024+512):"memory");}
    asm volatile("s_waitcnt lgkmcnt(0)":::"memory");SBAR();
    #define PK(k) (bf16x8){lo[k][0],lo[k][1],lo[k][2],lo[k][3],hi[k][0],hi[k][1],hi[k][2],hi[k][3]}
    o[d0]=__builtin_amdgcn_mfma_f32_32x32x16_bf16(pa0,PK(0),o[d0],0,0,0);
    o[d0]=__builtin_amdgcn_mfma_f32_32x32x16_bf16(pa1,PK(1),o[d0],0,0,0);
    o[d0]=__builtin_amdgcn_mfma_f32_32x32x16_bf16(pa2,PK(2),o[d0],0,0,0);
    o[d0]=__builtin_amdgcn_mfma_f32_32x32x16_bf16(pa3,PK(3),o[d0],0,0,0);
    #undef PK
  }
}

#ifndef ATTN_STORE16
#define ATTN_STORE16(p,v) (*(u32x4*)(p)=(v))
#endif
template<int MODE,int QP,int KP,int OP,int THRL,bool FIXM=false> __device__ __forceinline__ void attn_unit(const bf16*Qu,const bf16*__restrict__ Kh,const bf16*__restrict__ Vh,bf16*Ou,int NT,int lat0,int tq0,float sinkl2,char*shm,const int wave_id,const float m0fix,const bool pre,const bool has_next,const bf16*__restrict__ Kh_n,const bf16*__restrict__ Vh_n,const bool unused_=false){
  const int wid=wave_id,lane=lane_id(),r32=lane&31,hi=lane>>5;
  const bf16*Qw=Qu+(long)(wid*QBLK)*QP;
  const unsigned lds0=(unsigned)(uintptr_t)shm;
  float*wsf=(float*)(shm+LDS_WS)+wid*64;
  const bf16*ksrc=Kh+(long)lane*KP+wid*8;
  const bf16*vsrc=Vh+(long)(16*(wid&3)+(lane>>2))*KP+(wid>>2)*32+(lane&3)*8;
  #define KROW(t) ((long)(64*(t)+(((t)>=4)?lat0:0)))
  const unsigned kdst=lds0+LDS_K+wid*1024, vdst=lds0+LDS_V+wid*1024;
  #define DMA_K(t,slot) glds16(ksrc+KROW(t)*KP,(unsigned)__builtin_amdgcn_readfirstlane(kdst+(slot)))
  #define DMA_V(t,slot) glds16(vsrc+KROW(t)*KP,(unsigned)__builtin_amdgcn_readfirstlane(vdst+(slot)))
  const int vb0=(int)(lds0+LDS_V)+((lane>>4)&1)*32+(lane&3)*8+(4*hi+((lane&15)>>2))*64;
  const char*Kbase=shm+LDS_K; bf16x8 kf[8];
  const lds_cptr shm3=(lds_cptr)shm; const lds_cptr kp0=shm3+LDS_K+hi*1024+r32*16; const lds_cptr vp0=shm3+LDS_V+((lane>>4)&1)*32+(lane&3)*8+(4*hi+((lane&15)>>2))*64;
  if(!pre){DMA_K(0,0);DMA_V(0,0);DMA_K(1,SLOTB);}
  bf16x8 qr[4];
  #pragma unroll
  for(int d0=0;d0<4;++d0)qr[d0]=*reinterpret_cast<const bf16x8*>(&Qw[(long)r32*QP+d0*16+hi*8]);
  float mhat=0.f,l_reg=0.f;f32x16 o[2];o[0]=f32x16{};o[1]=f32x16{};f32x16 negm=f32x16{};
  if(FIXM){mhat=m0fix;
    #pragma unroll
    for(int r=0;r<16;++r)negm[r]=-m0fix;}
  asm volatile("":"+v"(negm));
  const int qrel=wid*QBLK+r32;
  const int mq=4*hi-(tq0+qrel)+lat0-256;
  #define CMASK(P0,P1,t) do{ if(MODE==1 && (t)>=4) swamask(P0,P1,mq+64*(t)); }while(0)
  bool resc=false;
  #define START(P0,P1) do{ resc=false; \
    if(!FIXM){ const float rm=rowmax(P0,P1); const float dl=rm; mhat=fadd_s(mhat,dl); \
      _Pragma("unroll") for(int r=0;r<16;++r){P0[r]=fsub_s(P0[r],dl);P1[r]=fsub_s(P1[r],dl);} \
      _Pragma("unroll") for(int r=0;r<16;++r)negm[r]=-mhat; asm volatile("":"+v"(negm)); } \
    _Pragma("unroll") for(int r=0;r<16;++r)P0[r]=__builtin_amdgcn_exp2f(P0[r]); }while(0)
  #define RESC() do{ if(resc){ asm volatile("s_waitcnt lgkmcnt(0)":::"memory"); \
      _Pragma("unroll") for(int d_=0;d_<2;++d_) _Pragma("unroll") for(int r=0;r<16;++r)o[d_][r]*=wsf[crow(r,hi)]; } }while(0)
  f32x16 pA0,pA1,pB0,pB1;
  int sl_prev=0,sl_cur=0,sl_next=SLOTB;
  #define ROT() do{sl_prev=sl_cur;sl_cur=sl_next;sl_next=(sl_next==(NSLOT-1)*SLOTB)?0:sl_next+SLOTB;}while(0)
  DMA_K(2,2*SLOTB);
  WAIT_BAR(3);
  qkt(pA0,pA1,Kbase,qr,negm,r32,hi);asm volatile("s_nop 15\n\ts_nop 7":"+v"(pA0),"+v"(pA1));CMASK(pA0,pA1,0);
  START(pA0,pA1);
  _Pragma("unroll") for(int r=0;r<16;++r)pA1[r]=__builtin_amdgcn_exp2f(pA1[r]);
  WAIT_BAR(0);
  DMA_K(3,0);DMA_V(1,SLOTB);
  ROT();
  kload8(kf,kp0+sl_cur);
  WAIT_BAR(2);
  s16x4 vlo[8],vhi[8]; u32x4 pw0,pw1,pw2,pw3;
  #define PKW(P,B) cvtpk_s(P[B],P[B+1])
  #define PAF(k) __builtin_bit_cast(bf16x8,pw##k)
  #define VFR(i) (bf16x8){vlo[i][0],vlo[i][1],vlo[i][2],vlo[i][3],vhi[i][0],vhi[i][1],vhi[i][2],vhi[i][3]}
  #define PIN(x) asm volatile("":"+v"(x))
  #define MX3(a,b,c) __builtin_fmaxf(__builtin_fmaxf((a),(b)),(c))
  #define GAPA(MF,A0,A1,A2,A3,W0,W1,PW) do{ MF; sacc+=A0; sacc+=A1; sacc+=A2; sacc+=A3; PIN(sacc); W0; W1; PIN(PW); SBAR(); }while(0)
  #define EX(v) __builtin_amdgcn_exp2f(v)
  #define GAPB(MF,X,B) do{ MF; X[B]=EX(X[B]); X[B+1]=EX(X[B+1]); X[B+2]=EX(X[B+2]); X[B+3]=EX(X[B+3]); PIN(X); SBAR(); }while(0)
  #define VRD(i) do{ vlo[i]=vtr(vp_+(((i)>>2)*4096+((i)&3)*1024)); vhi[i]=vtr(vp_+(((i)>>2)*4096+((i)&3)*1024+512)); }while(0)
  #define KRD(G,j) do{ if(G){ kload2(kf,kp0+sl_next,j); SBAR(); } }while(0)
  #define STEP(C0,C1,P0,P1,t,GK,GV,GL) do{ SBAR(); \
    const lds_cptr vp_=vp0+sl_prev; \
    VRD(0); SBAR(); float sacc=(P0[0]+P0[1]); \
    GAPA(C0=__builtin_amdgcn_mfma_f32_32x32x16_bf16(kf[0],qr[0],negm,0,0,0), P0[2],P0[3],P0[4],P0[5],     pw0[0]=PKW(P0,0), pw0[1]=PKW(P0,2), pw0); \
    VRD(4); SBAR(); GAPA(C1=__builtin_amdgcn_mfma_f32_32x32x16_bf16(kf[1],qr[0],negm,0,0,0), P0[6],P0[7],P0[8],P0[9],     pw0[2]=PKW(P0,4), pw0[3]=PKW(P0,6), pw0); \
    VRD(1); SBAR(); GAPA(C0=__builtin_amdgcn_mfma_f32_32x32x16_bf16(kf[2],qr[1],C0,0,0,0),   P0[10],P0[11],P0[12],P0[13], pw1[0]=PKW(P0,8), pw1[1]=PKW(P0,10), pw1); \
    VRD(5); SBAR(); GAPA(C1=__builtin_amdgcn_mfma_f32_32x32x16_bf16(kf[3],qr[1],C1,0,0,0),   P0[14],P0[15],P1[0],P1[1],   pw1[2]=PKW(P0,12),pw1[3]=PKW(P0,14), pw1); \
    VRD(2); SBAR(); GAPA(C0=__builtin_amdgcn_mfma_f32_32x32x16_bf16(kf[4],qr[2],C0,0,0,0),   P1[2],P1[3],P1[4],P1[5],     pw2[0]=PKW(P1,0), pw2[1]=PKW(P1,2), pw2); \
    VRD(6); SBAR(); GAPA(C1=__builtin_amdgcn_mfma_f32_32x32x16_bf16(kf[5],qr[2],C1,0,0,0),   P1[6],P1[7],P1[8],P1[9],     pw2[2]=PKW(P1,4), pw2[3]=PKW(P1,6), pw2); \
    VRD(3); SBAR(); GAPA(C0=__builtin_amdgcn_mfma_f32_32x32x16_bf16(kf[6],qr[3],C0,0,0,0),   P1[10],P1[11],P1[12],P1[13], pw3[0]=PKW(P1,8), pw3[1]=PKW(P1,10), pw3); \
    VRD(7); SBAR(); GAPA(C1=__builtin_amdgcn_mfma_f32_32x32x16_bf16(kf[7],qr[3],C1,0,0,0),   P1[14],P1[15],0.f,0.f,       pw3[2]=PKW(P1,12),pw3[3]=PKW(P1,14), pw3); \
    l_reg+=sacc; \
    if(GK){DMA_K((t)+3,sl_cur);} if(GV){DMA_V((t)+1,sl_next);} \
    CMASK(C0,C1,t); \
    if(!FIXM){ float a=MX3(C0[0],C0[1],C1[0]),b=MX3(C0[2],C0[3],C1[1]); a=MX3(a,C1[2],C1[3]); \
      _Pragma("unroll") for(int r=4;r<16;r+=4){a=MX3(a,C0[r],C0[r+1]);b=MX3(b,C0[r+2],C0[r+3]);a=MX3(a,C1[r],C1[r+1]);b=MX3(b,C1[r+2],C1[r+3]);} \
      float rm=__builtin_fmaxf(a,b); { auto rr=__builtin_amdgcn_permlane32_swap(__float_as_uint(rm),__float_as_uint(rm),false,false); rm=__builtin_fmaxf(__uint_as_float(rr[0]),__uint_as_float(rr[1])); } \
      resc=false; \
      if(__builtin_expect(__any(rm>(float)THRL),0)){ const float dl=__builtin_fmaxf(rm,0.f); mhat+=dl; \
        _Pragma("unroll") for(int r=0;r<16;++r){C0[r]-=dl;C1[r]-=dl;} \
        _Pragma("unroll") for(int r=0;r<16;++r)negm[r]=-mhat; asm volatile("":"+v"(negm)); \
        const float f=__builtin_amdgcn_exp2f(-dl); l_reg*=f; if(hi==0)wsf[r32]=f; resc=true; } } \
    SBAR(); \
    GAPB(o[0]=__builtin_amdgcn_mfma_f32_32x32x16_bf16(PAF(0),VFR(0),o[0],0,0,0), C0,0); \
    GAPB(o[1]=__builtin_amdgcn_mfma_f32_32x32x16_bf16(PAF(0),VFR(4),o[1],0,0,0), C0,4); \
    KRD(GL,0); GAPB(o[0]=__builtin_amdgcn_mfma_f32_32x32x16_bf16(PAF(1),VFR(1),o[0],0,0,0), C0,8); \
    KRD(GL,1); GAPB(o[1]=__builtin_amdgcn_mfma_f32_32x32x16_bf16(PAF(1),VFR(5),o[1],0,0,0), C0,12); \
    KRD(GL,2); GAPB(o[0]=__builtin_amdgcn_mfma_f32_32x32x16_bf16(PAF(2),VFR(2),o[0],0,0,0), C1,0); \
    KRD(GL,3); GAPB(o[1]=__builtin_amdgcn_mfma_f32_32x32x16_bf16(PAF(2),VFR(6),o[1],0,0,0), C1,4); \
    GAPB(o[0]=__builtin_amdgcn_mfma_f32_32x32x16_bf16(PAF(3),VFR(3),o[0],0,0,0), C1,8); \
    GAPB(o[1]=__builtin_amdgcn_mfma_f32_32x32x16_bf16(PAF(3),VFR(7),o[1],0,0,0), C1,12); \
    }while(0)
  int t=1;
  for(;t+5<NT;t+=2){
    STEP(pB0,pB1,pA0,pA1,t,true,true,true);     WAIT_BAR(2); RESC(); ROT();
    STEP(pA0,pA1,pB0,pB1,t+1,true,true,true);   WAIT_BAR(2); RESC(); ROT();
  }
  #define ENDW(tt) do{ if((tt)+3<NT){WAIT_BAR(2);} else if((tt)+2<NT){WAIT_BAR(1);} else {WAIT_BAR(0);} }while(0)
  for(;t+1<NT;t+=2){
    STEP(pB0,pB1,pA0,pA1,t,(t+3<NT),(t+1<NT),(t+1<NT));       ENDW(t);   RESC(); ROT();
    STEP(pA0,pA1,pB0,pB1,t+1,(t+4<NT),(t+2<NT),(t+2<NT));     ENDW(t+1); RESC(); ROT();
  }
  STEP(pB0,pB1,pA0,pA1,NT-1,false,false,false); RESC();
  { float sacc=pB0[0]+pB0[1]; _Pragma("unroll") for(int r=2;r<16;++r)sacc+=pB0[r]; _Pragma("unroll") for(int r=0;r<16;++r)sacc+=pB1[r]; l_reg+=sacc;
    pw0=(u32x4){PKW(pB0,0),PKW(pB0,2),PKW(pB0,4),PKW(pB0,6)};pw1=(u32x4){PKW(pB0,8),PKW(pB0,10),PKW(pB0,12),PKW(pB0,14)};pw2=(u32x4){PKW(pB1,0),PKW(pB1,2),PKW(pB1,4),PKW(pB1,6)};pw3=(u32x4){PKW(pB1,8),PKW(pB1,10),PKW(pB1,12),PKW(pB1,14)};
    SBAR(); pv(o,vb0+sl_cur,PAF(0),PAF(1),PAF(2),PAF(3)); }
  #undef PKW
  #undef PAF
  #undef VFR
  #undef PIN
  #undef MX3
  #undef GAPA
  #undef GAPB
  #undef EX
  #undef VRD
  #undef KRD
  #undef STEP
  #undef ENDW
  asm volatile("s_waitcnt lgkmcnt(0)\n\ts_barrier":::"memory");
  if(has_next){ const bf16*ksn=Kh_n+(long)lane*KP+wid*8; const bf16*vsn=Vh_n+(long)(16*(wid&3)+(lane>>2))*KP+(wid>>2)*32+(lane&3)*8;
    glds16(ksn,(unsigned)__builtin_amdgcn_readfirstlane(kdst)); glds16(vsn,(unsigned)__builtin_amdgcn_readfirstlane(vdst)); glds16(ksn+(long)64*KP,(unsigned)__builtin_amdgcn_readfirstlane(kdst+SLOTB));
 }
  {auto rr=__builtin_amdgcn_permlane32_swap(__float_as_uint(l_reg),__float_as_uint(l_reg),false,false);l_reg=__uint_as_float(rr[0])+__uint_as_float(rr[1]);}
  l_reg+=__builtin_amdgcn_exp2f(sinkl2-mhat);
  if(hi==0)wsf[32+r32]=l_reg;asm volatile("s_waitcnt lgkmcnt(0)":::"memory");
  float rli[16];
  #pragma unroll
  for(int r=0;r<16;++r)rli[r]=__builtin_amdgcn_rcpf(wsf[32+crow(r,hi)]);
  bf16*Ow=Ou+(long)(wid*QBLK)*OP;
  { bf16*stg=(bf16*)(shm+LDS_OST)+wid*2048;
    #pragma unroll
    for(int r=0;r<16;++r){const int orow=crow(r,hi);
      #pragma unroll
      for(int d0=0;d0<2;++d0)stg[orow*64+d0*32+r32]=__float2bfloat16(o[d0][r]*rli[r]);}
    asm volatile("s_waitcnt lgkmcnt(0)":::"memory");
    #pragma unroll
    for(int i=0;i<4;++i){const int row=i*8+(lane>>3),ch=lane&7; const u32x4 v=*(const u32x4*)(stg+row*64+ch*8); ATTN_STORE16(Ow+(long)row*OP+ch*8,v);} }
  asm volatile("s_waitcnt lgkmcnt(0)":::"memory");
  #undef DMA_K
  #undef KROW
  #undef DMA_V
  #undef CMASK
  #undef START
  #undef RESC
  #undef ROT
}
constexpr int ATTN_LDS_BYTES=LDS_BYTES;
#undef SBAR
#undef WAIT_BAR
}
#define XB_TMO      128
#define XB_XCNT(j)  (256  + 64 * (j))
#define XB_XSUB(j)  (1280 + 64 * (j))
#define XB_XGEN(j)  (2304 + 64 * (j))
#define XB_TOP      3328
#define XB_TOPGEN   3392
#define XCD_BAR_WORDS 3456
#define XB_SPIN_CAP (1u << 18)

__device__ __forceinline__ unsigned xb_ld(unsigned* p)              { return __hip_atomic_load(p, __ATOMIC_RELAXED, __HIP_MEMORY_SCOPE_AGENT); }
__device__ __forceinline__ unsigned xb_add(unsigned* p, unsigned v) { return __hip_atomic_fetch_add(p, v, __ATOMIC_RELAXED, __HIP_MEMORY_SCOPE_AGENT); }
__device__ __forceinline__ unsigned xb_xcc_id() { return (unsigned)__builtin_amdgcn_s_getreg((3 << 11) | 20) & 0xFu; }
#define XB_SPIN(cond, bar) do { unsigned _sp = 0; while (cond) { __builtin_amdgcn_s_sleep(1); \
    if ((++_sp & 255u) == 0u) { if (xb_ld(&(bar)[XB_TMO])) break; if (_sp > XB_SPIN_CAP) { atomicAdd(&(bar)[XB_TMO], 1u); break; } } } } while (0)

struct XcdBarrier {
    unsigned* bar; unsigned x;
    volatile LAS unsigned* st;
};

__device__ __forceinline__ XcdBarrier xcd_barrier_post(unsigned* bar, volatile LAS unsigned* st, const bool t0) {
    XcdBarrier b; b.bar = bar; b.x = xb_xcc_id(); b.st = st;
    if (t0) (void)xb_add(&bar[XB_XCNT(b.x)], 1u);
    return b;
}
__device__ __forceinline__ void xcd_barrier_complete(unsigned* bar, unsigned x, unsigned& nloc, unsigned& nx) {
    const unsigned G = gridDim.x * gridDim.y * gridDim.z;
    unsigned sum, cnt, mine, sp = 0u;
    for (;;) {
        sum = 0u; cnt = 0u; mine = 0u;
#pragma unroll
        for (unsigned j = 0; j < 16; ++j) { const unsigned c = xb_ld(&bar[XB_XCNT(j)]); sum += c; cnt += (c > 0u) ? 1u : 0u; mine = (j == x) ? c : mine; }
        if (sum == G) break;
        __builtin_amdgcn_s_sleep(1);
        if ((++sp & 255u) == 0u) { if (xb_ld(&bar[XB_TMO])) break; if (sp > XB_SPIN_CAP) { atomicAdd(&bar[XB_TMO], 1u); break; } }
    }
    nloc = mine > 0u ? mine : 1u; nx = cnt > 0u ? cnt : 1u;
}

__device__ __forceinline__ void xcd_barrier(const XcdBarrier& b, const bool t0) {
    asm volatile("s_waitcnt vmcnt(0)" ::: "memory");
    __syncthreads();
    if (t0) {
        unsigned* bar = b.bar;
        __builtin_amdgcn_s_waitcnt(0);
        unsigned nloc = b.st[0], nx = b.st[1];
        if (nloc == 0u) { xcd_barrier_complete(bar, b.x, nloc, nx); b.st[0] = nloc; b.st[1] = nx; }
        const unsigned old = xb_add(&bar[XB_XSUB(b.x)], 1u);
        const unsigned gen = old / nloc;
        if (old + 1u == (gen + 1u) * nloc) {
            __builtin_amdgcn_fence(__ATOMIC_RELEASE, "agent");
            asm volatile("s_waitcnt vmcnt(0)" ::: "memory");
            const unsigned og = xb_add(&bar[XB_TOP], 1u);
            const unsigned tg = og / nx;
            if (og + 1u == (tg + 1u) * nx) xb_add(&bar[XB_TOPGEN], 1u);
            else XB_SPIN(xb_ld(&bar[XB_TOPGEN]) == tg, bar);
            __builtin_amdgcn_fence(__ATOMIC_ACQUIRE, "agent");
            xb_add(&bar[XB_XGEN(b.x)], 1u);
            asm volatile("s_waitcnt vmcnt(0)" ::: "memory");
        } else {
            XB_SPIN(xb_ld(&bar[XB_XGEN(b.x)]) == gen, bar);
            __builtin_amdgcn_fence(__ATOMIC_ACQUIRE, "agent");
            asm volatile("s_waitcnt vmcnt(0)" ::: "memory");
        }
    }
    __syncthreads();
}
constexpr int NWAVES = 8, NTHR = 512;
struct Args { const float* in[32]; float* out; unsigned char* ws; int ph_lo, ph_hi, one_launch, pad; };
enum InIdx { I_X = 0, I_C, I_CTX, I_CCTX, I_ADAW, I_ADAB, I_N1G, I_N2G, I_EVWIN, I_EVWOUT, I_HYCW, I_HYCB, I_HYW1, I_HYB1, I_HYW2, I_HYB2, I_HYW3, I_HYFREQ, I_HYSKIP, I_SINK,
             I_ODWQKV, I_ODWOUT, I_ODQG, I_ODKG, I_RTGW, I_RTGB, I_RTEW, I_RTEB, I_MOEG, I_MOEU, I_MOED, I_FNG };
struct Frame {
    LAS unsigned char* lds; int wave, G, bid;
    unsigned char* ws; gu32* ctl;
};
struct TItem { const float* src; int ldw; bf16* WT; int Kd, drow0, drow1, k0; bool perm; };
__device__ __forceinline__ int qkv_drow(int n) { const int pn = n >> 8, rem = n & 255; return 256 * pn + 128 * ((rem & 63) >> 5) + 32 * (rem >> 6); }
__device__ __forceinline__ TItem decode_item(const Args& a, unsigned char* ws, int it) {
    constexpr int S1 = 16 * 24, S2 = S1 + 16 * 12, S3 = S2 + 16 * 16, S4 = S3 + 16 * 24, S5 = S4 + 16 * 16;
    TItem t; t.perm = false;
    if (it < S1) { const int kb = it / 24, nb = it % 24, n = 64 * nb; t.src = a.in[I_EVWIN] + (size_t)(64 * kb) * D_IN_EVEN + n; t.ldw = D_IN_EVEN; t.WT = (bf16*)(ws + WS_WHY); t.Kd = 1024; t.drow0 = n; t.drow1 = n + 32; t.k0 = 64 * kb; }
    else if (it < S2) { const int r = it - S1, kb = r / 12, nb = r % 12, n = 64 * nb;
        if (n < 512) { t.drow0 = qkv_drow(n); t.drow1 = qkv_drow(n + 32); t.perm = true; } else { t.drow0 = n; t.drow1 = n + 32; t.perm = n < 640; }
        t.src = a.in[I_EVWIN] + (size_t)(64 * kb) * D_IN_EVEN + 1536 + n; t.ldw = D_IN_EVEN; t.WT = (bf16*)(ws + WS_WATT0); t.Kd = 1024; t.k0 = 64 * kb; }
    else if (it < S3) { const int r = it - S2, kb = r / 16, nb = r % 16, n = 64 * nb; t.src = a.in[I_EVWOUT] + (size_t)(64 * kb) * 1024 + n; t.ldw = 1024; t.WT = (bf16*)(ws + WS_WOUT0); t.Kd = 1024; t.drow0 = n; t.drow1 = n + 32; t.k0 = 64 * kb; }
    else if (it < S4) { const int r = it - S3, kb = r / 24, nb = r % 24, n = 64 * nb;
        t.src = a.in[I_ODWQKV] + (size_t)(64 * kb) * D_QKV1 + n; t.ldw = D_QKV1; t.WT = (bf16*)(ws + WS_WQKV1); t.Kd = 1024; t.drow0 = qkv_drow(n); t.drow1 = qkv_drow(n + 32); t.k0 = 64 * kb; t.perm = n < 1280; }
    else if (it < S5) { const int r = it - S4, kb = r / 16, nb = r % 16, n = 64 * nb; t.src = a.in[I_ODWOUT] + (size_t)(64 * kb) * 1024 + n; t.ldw = 1024; t.WT = (bf16*)(ws + WS_WOUT1); t.Kd = 1024; t.drow0 = n; t.drow1 = n + 32; t.k0 = 64 * kb; }
    else { const int r = it - S5, le = r / 384, sub = r % 384;
        if (sub < 256) { const int up = sub >> 7, s2 = sub & 127, kb = s2 >> 3, nb = s2 & 7, n = 64 * nb;
            t.src = a.in[up ? I_MOEU : I_MOEG] + (size_t)le * 1024 * 512 + (size_t)(64 * kb) * 512 + n; t.ldw = 512; t.WT = (bf16*)(ws + WS_WGU) + (size_t)le * 1024 * 1024; t.Kd = 1024;
            t.drow0 = 256 * (n >> 7) + (n & 127) + 128 * up; t.drow1 = t.drow0 + 32; t.k0 = 64 * kb; }
        else { const int s2 = sub - 256, kb = s2 >> 4, nb = s2 & 15, n = 64 * nb;
            t.src = a.in[I_MOED] + (size_t)le * 512 * 1024 + (size_t)(64 * kb) * 1024 + n; t.ldw = 1024; t.WT = (bf16*)(ws + WS_WDN) + (size_t)le * 1024 * 512; t.Kd = 512; t.drow0 = n; t.drow1 = n + 32; t.k0 = 64 * kb; } }
    return t;
}
__device__ __forceinline__ int pinv32(int j) { return j < 16 ? 8 * (j >> 2) + (j & 3) : 8 * ((j - 16) >> 2) + 4 + ((j - 16) & 3); }
struct TRegs { float v[64]; };
__device__ __forceinline__ TRegs titem_load(const TItem& t, int lane) { TRegs r; const float* p = t.src + lane;
#pragma unroll
    for (int i = 0; i < 64; ++i) r.v[i] = __builtin_nontemporal_load(p + (size_t)i * t.ldw);
    return r; }
__device__ __forceinline__ void titem_store(const TItem& t, const TRegs& r, LAS float* scr, int lane) {
#pragma unroll
    for (int i = 0; i < 64; ++i) scr[i * 65 + lane] = r.v[i];
    LDS_WAIT(); asm volatile("" ::: "memory");
    const int c = lane & 7;
#pragma unroll
    for (int j = 0; j < 8; ++j) { const int n = (lane >> 3) + 8 * j; const LAS float* s = scr + (8 * c) * 65 + n;
        v4u o; o.x = pk2(s[0 * 65], s[1 * 65]); o.y = pk2(s[2 * 65], s[3 * 65]); o.z = pk2(s[4 * 65], s[5 * 65]); o.w = pk2(s[6 * 65], s[7 * 65]);
        const int nl = n & 31;
        *(GAS v4u*)(t.WT + (size_t)((j >= 4 ? t.drow1 : t.drow0) + (t.perm ? pinv32(nl) : nl)) * t.Kd + t.k0 + 8 * c) = o; }
    LDS_WAIT(); asm volatile("" ::: "memory");
}

constexpr int W_ITEMS_ALL = 16 * 24 + 16 * 12 + 16 * 16 + 16 * 24 + 16 * 16 + 64 * 384, W_ITEMS_L1MOE = W_ITEMS_ALL - 32 * 384;
__device__ __forceinline__ void weight_items(Frame& F, const Args& a, const int lo, const int hi, const int rank, const int nblk) {
    const int F_lane = lane_id();
    LAS float* scr = (LAS float*)(F.lds + F.wave * 16896);
    const int gw = lo + rank * NWAVES + F.wave, NGW = nblk * NWAVES;
    if (gw < hi) {
        TItem cur = decode_item(a, F.ws, gw); TRegs rc = titem_load(cur, F_lane);
        for (int it = gw; it < hi; it += NGW) {
            const int itn = it + NGW < hi ? it + NGW : it; const TItem nxt = decode_item(a, F.ws, itn); const TRegs rn = titem_load(nxt, F_lane);
            titem_store(cur, rc, scr, F_lane);
            cur = nxt; rc = rn;
        }
    }
}

__device__ __forceinline__ void p0_prologue(Frame& F, const Args& a) {
    const int F_lane = lane_id(), F_tid = F.wave * 64 + F_lane; (void)F_tid;
    unsigned char* ws = F.ws;
    {
        LAS float* sv = (LAS float*)F.lds; LAS float* red = (LAS float*)(F.lds + 17 * 1024 * 4);
        float* MOD = (float*)(ws + WS_MOD);
        for (int u = F.bid; u < 192; u += F.G) {
            const int l = u / 96, n0 = (u % 96) * 64;
            for (int idx = F_tid; idx < 17 * 1024; idx += NTHR) { const int b = idx >> 10, k = idx & 1023; const float v = b < 16 ? a.in[I_C][b * 1024 + k] : a.in[I_CCTX][k]; sv[idx] = silu_f(v); }
            __syncthreads();
            float acc[17];
#pragma unroll
            for (int b = 0; b < 17; ++b) acc[b] = 0.f;
            const float* Wp = a.in[I_ADAW] + (size_t)l * 1024 * 6144 + n0 + F_lane;
            for (int k0 = F.wave * 128; k0 < F.wave * 128 + 128; k0 += 16) { float wv[16];
#pragma unroll
                for (int kk = 0; kk < 16; ++kk) wv[kk] = Wp[(size_t)(k0 + kk) * 6144];
#pragma unroll
                for (int kk = 0; kk < 16; ++kk)
#pragma unroll
                    for (int b = 0; b < 17; ++b) acc[b] += sv[b * 1024 + k0 + kk] * wv[kk]; }
#pragma unroll
            for (int b = 0; b < 17; ++b) red[(F.wave * 17 + b) * 64 + F_lane] = acc[b];
            __syncthreads();
            for (int idx = F_tid; idx < 17 * 64; idx += NTHR) { const int b = idx >> 6, j = idx & 63; float s = a.in[I_ADAB][l * 6144 + n0 + j];
#pragma unroll
                for (int w = 0; w < 8; ++w) s += red[(w * 17 + b) * 64 + j];
                MOD[((size_t)l * 17 + b) * 6144 + n0 + j] = s; }
            __syncthreads();
        }
    }
    {
        const float* w1 = a.in[I_HYW1]; const float* b1 = a.in[I_HYB1]; const float* w2 = a.in[I_HYW2]; const float* b2 = a.in[I_HYB2]; const float* fr = a.in[I_HYFREQ];
        float* HD2 = (float*)(ws + WS_HD2);
        const int gw = F.bid * NWAVES + F.wave, NGW = F.G * NWAVES;
        if (gw < 4352) {
            float w1c[33], w2c[64];
#pragma unroll
            for (int i = 0; i < 33; ++i) w1c[i] = w1[i * 64 + F_lane];
#pragma unroll
            for (int i = 0; i < 64; ++i) w2c[i] = w2[i * 64 + F_lane];
            const float frl = fr[F_lane], b1l = b1[F_lane], b2l = b2[F_lane];
            for (int tt = gw; tt < 4352; tt += NGW) {
                const int n = tt < 4096 ? 4096 : 256, t = tt < 4096 ? tt : tt - 4096; const float tf = (float)t; const float tn = tf / (float)(n - 1);
                float z = 0.f;
                if (F_lane == 0) z = tn;
                else if (F_lane < 33) { const int m = (F_lane - 1) & 15; const float band = 1e-4f + (float)m * ((15.f - 1e-4f) / 15.f); const float ang = ((float)(2.0 * M_PI / (double)n) * tf) * band;
                    z = F_lane < 17 ? cosf(ang) : -sinf(ang); }
                float h1 = b1l;
#pragma unroll
                for (int i = 0; i < 33; ++i) h1 += __builtin_bit_cast(float, __builtin_amdgcn_readlane(__builtin_bit_cast(int, z), i)) * w1c[i];
                h1 = sinf(frl * h1);
                float h2 = b2l;
#pragma unroll
                for (int i = 0; i < 64; ++i) h2 += __builtin_bit_cast(float, __builtin_amdgcn_readlane(__builtin_bit_cast(int, h1), i)) * w2c[i];
                h2 = sinf(frl * h2);
                HD2[(size_t)tt * 64 + F_lane] = h2;
            }
        }
    }
    if (F.bid == 0) {
        f32x2* RT = (f32x2*)(ws + WS_ROPE);
        for (int idx = F_tid; idx < 1024; idx += NTHR) { const int pos = idx >> 4, i = idx & 15; const float inv = powf(10000.f, -(float)(2 * i) / 32.f); const float ang = (float)pos * inv; RT[idx] = (f32x2){cosf(ang), sinf(ang)}; }
    }
    weight_items(F, a, 0, W_ITEMS_L1MOE, F.bid, F.G);
    __syncthreads();
}

struct RowVec { f32x4 v[4]; };
__device__ __forceinline__ RowVec ld_row(const float* p, int lane) { RowVec r; const f32x4* q = (const f32x4*)p + lane;
#pragma unroll
    for (int j = 0; j < 4; ++j) r.v[j] = q[64 * j]; return r; }
__device__ __forceinline__ RowVec ld_row_nt(const float* p, int lane) { RowVec r; const f32x4* q = (const f32x4*)p + lane;
#pragma unroll
    for (int j = 0; j < 4; ++j) r.v[j] = __builtin_nontemporal_load(q + 64 * j); return r; }
__device__ __forceinline__ void st_row(float* p, int lane, const RowVec& r) { f32x4* q = (f32x4*)p + lane;
#pragma unroll
    for (int j = 0; j < 4; ++j) q[64 * j] = r.v[j]; }
__device__ __forceinline__ void st_row_bf16_nt(bf16* p, int lane, const RowVec& r) { unsigned long long* o8 = (unsigned long long*)p + lane;
#pragma unroll
    for (int j = 0; j < 4; ++j) __builtin_nontemporal_store((unsigned long long)pk2(r.v[j][0], r.v[j][1]) | ((unsigned long long)pk2(r.v[j][2], r.v[j][3]) << 32), o8 + 64 * j); }
__device__ __forceinline__ void st_row_nt(float* p, int lane, const RowVec& r) { f32x4* q = (f32x4*)p + lane;
#pragma unroll
    for (int j = 0; j < 4; ++j) __builtin_nontemporal_store(r.v[j], q + 64 * j); }
__device__ __forceinline__ void st_row_bf16(bf16* p, int lane, const RowVec& r) { unsigned long long* o8 = (unsigned long long*)p + lane;
#pragma unroll
    for (int j = 0; j < 4; ++j) o8[64 * j] = (unsigned long long)pk2(r.v[j][0], r.v[j][1]) | ((unsigned long long)pk2(r.v[j][2], r.v[j][3]) << 32); }
__device__ __forceinline__ RowVec ld_row_bf16(const bf16* p, int lane) { RowVec r; const u32x2* q = (const u32x2*)p + lane;
#pragma unroll
    for (int j = 0; j < 4; ++j) { const u32x2 w = __builtin_nontemporal_load(q + 64 * j); r.v[j] = (f32x4){bflo(w.x), bfhi(w.x), bflo(w.y), bfhi(w.y)}; } return r; }
struct RowRaw { u32x2 w[4]; };
__device__ __forceinline__ RowRaw ld_raw_bf16(const bf16* p, int lane) { RowRaw r; const u32x2* q = (const u32x2*)p + lane;
#pragma unroll
    for (int j = 0; j < 4; ++j) r.w[j] = __builtin_nontemporal_load(q + 64 * j); return r; }
__device__ __forceinline__ RowVec norm_mod(const RowVec& x, const float* g, const float* scale, const float* shift, int lane) {
    float ss = 0.f;
#pragma unroll
    for (int j = 0; j < 4; ++j) ss += (x.v[j][0] * x.v[j][0] + x.v[j][1] * x.v[j][1]) + (x.v[j][2] * x.v[j][2] + x.v[j][3] * x.v[j][3]);
    const float rs = rsqrtf(wave_sum(ss) * (1.f / 1024.f) + NORM_EPS);
    const RowVec gv = ld_row(g, lane); RowVec y;
    if (scale) { const RowVec sc = ld_row(scale, lane), sf = ld_row(shift, lane);
#pragma unroll
        for (int j = 0; j < 4; ++j) y.v[j] = (x.v[j] * rs * gv.v[j]) * (sc.v[j] + 1.f) + sf.v[j];
    } else {
#pragma unroll
        for (int j = 0; j < 4; ++j) y.v[j] = x.v[j] * rs * gv.v[j];
    }
    return y;
}
__device__ __forceinline__ void jrow_split(int row, int& b, int& j) { b = row / RPB; j = row - b * RPB; }

__device__ __forceinline__ void split_hl(const float (&v)[8], bf16x8& hi, bf16x8& lo) {
#pragma unroll
    for (int j = 0; j < 8; ++j) { const unsigned hb = f2bf(v[j]); hi[j] = (short)hb; lo[j] = (short)f2bf(v[j] - __builtin_bit_cast(float, hb << 16)); }
}
__device__ __forceinline__ void p_filter_stage_b(Frame& F, const Args& a, const int rank, const int nblk) {
    const int F_lane = lane_id();
    const float* w3 = a.in[I_HYW3]; const float* HD2 = (const float*)(F.ws + WS_HD2);
    const int gw = rank * NWAVES + F.wave, NGW = nblk * NWAVES;
    const float mind = logf(1e-2f) / 1.5f, maxd = logf(1e-2f) / 0.3f;
    const int lr = F_lane & 15, lg = F_lane >> 4;
    for (int wu = gw; wu < 68 * 32; wu += NGW) {
        const int tc = wu >> 5, cchunk = wu & 31; const bool isc = tc >= 64; const int n = isc ? 256 : 4096; const int t0 = (isc ? tc - 64 : tc) * 64; const int tt0 = isc ? 4096 + t0 : t0;
        float* HR = (float*)(F.ws + (isc ? WS_HRAWC : WS_HRAW)); const int colb = cchunk * 64;
        bf16x8 Ahi[4][2], Alo[4][2];
#pragma unroll
        for (int tt = 0; tt < 4; ++tt)
#pragma unroll
            for (int ks = 0; ks < 2; ++ks) { const float* hp = HD2 + (size_t)(tt0 + 16 * tt + lr) * 64 + 32 * ks + 8 * lg; const f32x4 h0 = *(const f32x4*)hp, h1 = *(const f32x4*)(hp + 4);
                const float v[8] = {h0[0], h0[1], h0[2], h0[3], h1[0], h1[1], h1[2], h1[3]}; split_hl(v, Ahi[tt][ks], Alo[tt][ks]); }
        const float rn1 = 1.f / (float)(n - 1);
#pragma unroll 1
        for (int ct = 0; ct < 4; ++ct) {
            const int col = colb + 16 * ct + lr;
            bf16x8 Bhi[2], Blo[2];
#pragma unroll
            for (int ks = 0; ks < 2; ++ks) { float v[8];
#pragma unroll
                for (int j = 0; j < 8; ++j) v[j] = w3[(size_t)(32 * ks + 8 * lg + j) * 2048 + col];
                split_hl(v, Bhi[ks], Blo[ks]); }
            const float ad = fabsf(mind + (float)(col & 511) * ((maxd - mind) / 511.f)) * LOG2E;
#pragma unroll
            for (int tt = 0; tt < 4; ++tt) { f32x4 acc = (f32x4){0.f, 0.f, 0.f, 0.f};
#pragma unroll
                for (int ks = 0; ks < 2; ++ks) { acc = __builtin_amdgcn_mfma_f32_16x16x32_bf16(Ahi[tt][ks], Bhi[ks], acc, 0, 0, 0); acc = __builtin_amdgcn_mfma_f32_16x16x32_bf16(Alo[tt][ks], Bhi[ks], acc, 0, 0, 0);
                    acc = __builtin_amdgcn_mfma_f32_16x16x32_bf16(Ahi[tt][ks], Blo[ks], acc, 0, 0, 0); }
                const int tb = t0 + 16 * tt + 4 * lg; f32x4 o;
#pragma unroll
                for (int r = 0; r < 4; ++r) o[r] = acc[r] * __builtin_amdgcn_exp2f(-((float)(tb + r) * rn1) * ad);
                *(f32x4*)(HR + (size_t)col * n + tb) = o; }
        }
    }
}

__device__ __forceinline__ bf16* x2b_row(unsigned char* ws, int b, int t) {
    const size_t base = b < 8 ? WS_WGU + (size_t)b * (8 * MiB) : (b < 12 ? WS_WDN + (size_t)(b - 8) * (8 * MiB) : WS_HRAW + (size_t)(b - 12) * (8 * MiB));
    return (bf16*)(ws + base) + (size_t)t * DM;
}
__device__ __forceinline__ const float* p1_src(const Args& a, int row) { int b, j; jrow_split(row, b, j); return j < CTXL ? a.in[I_CTX] + ((size_t)b * CTXL + j) * DM : a.in[I_X] + ((size_t)b * SEQ + (j - CTXL)) * DM; }
__device__ __forceinline__ void p_norm1_l0(Frame& F, const Args& a) {
    const int F_lane = lane_id();
    const float* MOD = (const float*)(F.ws + WS_MOD); bf16* H = (bf16*)(F.ws + WS_BUF1);
    const int gw = F.bid * NWAVES + F.wave, NGW = F.G * NWAVES;
    RowVec xn = ld_row_nt(p1_src(a, gw < NROWS ? gw : 0), F_lane);
    for (int row = gw; row < NROWS; row += NGW) { int b, j; jrow_split(row, b, j);
        const RowVec x = xn; const int rn = row + NGW < NROWS ? row + NGW : row; xn = ld_row_nt(p1_src(a, rn), F_lane);
        const float* md = MOD + (size_t)(j < CTXL ? 16 : b) * 6144;
        const RowVec y = norm_mod(x, a.in[I_N1G], md + 1024, md, F_lane);
        st_row_bf16(H + (size_t)row * DM, F_lane, y); }
}

__device__ __forceinline__ void moe_tab(Frame& F, LAS int* tab, int layer) {
    const int F_lane = lane_id(), F_tid = F.wave * 64 + F_lane; (void)F_tid;
    if (F_tid < 32) tab[64 + F_tid] = (int)__hip_atomic_load(F.ctl + CW_CNT + 64 * layer + F_tid, RLX_AGENT);
    __syncthreads();
    if (F_tid == 0) { int s = 0; for (int e = 0; e < 32; ++e) { tab[e] = s; s += (tab[64 + e] + 255) >> 8; } tab[32] = s; for (int e = 33; e < 64; ++e) tab[e] = 0x7fffffff; }
    __syncthreads();
}

constexpr int RT_HPITCH = 2064;
constexpr int RT_PART_OFF = 2 * 16 * RT_HPITCH, RT_LGS_OFF = RT_PART_OFF + 8 * 48 * 16 * 4, RT_CNT_OFF = RT_LGS_OFF + 16 * 48 * 4, RT_REC_OFF = RT_CNT_OFF + 256, RT_MAXROWS = 288;
static_assert(RT_REC_OFF + 3 * 2 * RT_MAXROWS * 4 <= MISC_OFF, "router LDS map");
template <int LAYER>
__device__ __forceinline__ void p_norm2_route(Frame& F, const Args& a) {
    const int F_lane = lane_id(), F_tid = F.wave * 64 + F_lane;
    const float* MOD = (const float*)(F.ws + WS_MOD) + (size_t)LAYER * 17 * 6144; bf16* H2 = (bf16*)(F.ws + WS_BUF1);
    LAS unsigned char* hbuf = F.lds; LAS unsigned char* hbuf_lo = F.lds + 16 * RT_HPITCH; LAS float* part = (LAS float*)(F.lds + RT_PART_OFF); LAS float* lgs = (LAS float*)(F.lds + RT_LGS_OFF);
    LAS int* lcnt = (LAS int*)(F.lds + RT_CNT_OFF); LAS int* lbase = lcnt + 32;
    LAS int* recE = (LAS int*)(F.lds + RT_REC_OFF); LAS int* recP = recE + 2 * RT_MAXROWS; LAS float* recG = (LAS float*)(recP + 2 * RT_MAXROWS);
    const float* wg = a.in[I_RTGW] + (size_t)LAYER * 1024 * 4; const float* we = a.in[I_RTEW] + (size_t)LAYER * 1024 * 32;
    const float* gb = a.in[I_RTGB] + LAYER * 4; const float* eb = a.in[I_RTEB] + LAYER * 32;
    bf16x8 Whi[3][4], Wlo[3][4];
#pragma unroll
    for (int nt = 0; nt < 3; ++nt) {
        const int o = 16 * nt + (F_lane & 15); float wv[4][8];
#pragma unroll
        for (int ks = 0; ks < 4; ++ks) { const int k0 = 128 * F.wave + 32 * ks + 8 * (F_lane >> 4);
#pragma unroll
            for (int j = 0; j < 8; ++j) { float v = 0.f; if (o < 4) v = wg[(size_t)(k0 + j) * 4 + o]; else if (o < 36) v = we[(size_t)(k0 + j) * 32 + (o - 4)]; wv[ks][j] = v; } }
#pragma unroll
        for (int ks = 0; ks < 4; ++ks) {
#pragma unroll
            for (int j = 0; j < 8; ++j) { const unsigned hb = f2bf(wv[ks][j]); const float hf = __builtin_bit_cast(float, hb << 16); Whi[nt][ks][j] = (short)hb; Wlo[nt][ks][j] = (short)f2bf(wv[ks][j] - hf); }
            asm volatile("" : "+v"(Whi[nt][ks]), "+v"(Wlo[nt][ks]) :: "memory"); }
    }
    if (F_tid < 64) lcnt[F_tid] = 0;
    __syncthreads();
    const int nrows = LAYER == 0 ? NROWS : NB * SEQ; const int chunk = (nrows + F.G - 1) / F.G;
    const int i0 = F.bid * chunk, i1 = (i0 + chunk < nrows) ? i0 + chunk : nrows;
    const bf16* YB = (const bf16*)(F.ws + WS_Y);
#define RT_LDX(i_) ({ RowVec xr_; if (LAYER == 0) { int b_, j_; jrow_split((i_), b_, j_); xr_ = ld_row_nt(j_ < CTXL ? a.in[I_CTX] + ((size_t)b_ * CTXL + j_) * DM : a.in[I_X] + ((size_t)b_ * SEQ + (j_ - CTXL)) * DM, F_lane); } \
    else xr_ = ld_row_bf16(x2b_row(F.ws, (i_) >> 12, (i_) & 4095), F_lane); xr_; })
#define RT_YROW(i_) (LAYER == 0 ? (i_) : ((i_) >> 12) * RPB + CTXL + ((i_) & 4095))
    RowVec xq[2]; RowRaw yq[2];
#pragma unroll
    for (int r = 0; r < 2; ++r) { const int i = (i0 + 2 * F.wave + r < i1) ? i0 + 2 * F.wave + r : i1 - 1; xq[r] = RT_LDX(i); yq[r] = ld_raw_bf16(YB + (size_t)RT_YROW(i) * DM, F_lane); }
    for (int ig = i0; ig < i1; ig += 16) {
#pragma unroll
        for (int r = 0; r < 2; ++r) {
            const int rl = 2 * F.wave + r; const bool valid = ig + rl < i1; const int i = valid ? ig + rl : i1 - 1; int row, b, j;
            if (LAYER == 0) { row = i; jrow_split(row, b, j); } else { b = i >> 12; j = CTXL + (i & 4095); row = b * RPB + j; }
            const float* md = MOD + (size_t)(j < CTXL ? 16 : b) * 6144;
            RowVec x1 = xq[r];
#pragma unroll
            for (int q = 0; q < 4; ++q) x1.v[q] = x1.v[q] + (f32x4){bflo(yq[r].w[q].x), bfhi(yq[r].w[q].x), bflo(yq[r].w[q].y), bfhi(yq[r].w[q].y)};
            const RowVec y = norm_mod(x1, a.in[I_N2G] + LAYER * 1024, md + 4 * 1024, md + 3 * 1024, F_lane);
            unsigned long long pk[4], pl[4];
#pragma unroll
            for (int q = 0; q < 4; ++q) { const unsigned h0 = f2bf(y.v[q][0]), h1 = f2bf(y.v[q][1]), h2_ = f2bf(y.v[q][2]), h3 = f2bf(y.v[q][3]);
                pk[q] = (unsigned long long)(h0 | (h1 << 16)) | ((unsigned long long)(h2_ | (h3 << 16)) << 32);
                const float l0 = y.v[q][0] - __builtin_bit_cast(float, h0 << 16), l1 = y.v[q][1] - __builtin_bit_cast(float, h1 << 16), l2 = y.v[q][2] - __builtin_bit_cast(float, h2_ << 16), l3 = y.v[q][3] - __builtin_bit_cast(float, h3 << 16);
                pl[q] = (unsigned long long)pk2(l0, l1) | ((unsigned long long)pk2(l2, l3) << 32); }
            if (valid) { unsigned long long* o8 = (unsigned long long*)(H2 + (size_t)row * DM) + F_lane;
#pragma unroll
                for (int q = 0; q < 4; ++q) o8[64 * q] = pk[q]; }
#pragma unroll
            for (int q = 0; q < 4; ++q) { *(LAS unsigned long long*)(hbuf + rl * RT_HPITCH + (4 * F_lane + 256 * q) * 2) = pk[q]; *(LAS unsigned long long*)(hbuf_lo + rl * RT_HPITCH + (4 * F_lane + 256 * q) * 2) = pl[q]; }
        }
        {   const int ign = ig + 16;
#pragma unroll
            for (int r = 0; r < 2; ++r) { const int i = (ign + 2 * F.wave + r < i1) ? ign + 2 * F.wave + r : i1 - 1; xq[r] = RT_LDX(i); yq[r] = ld_raw_bf16(YB + (size_t)RT_YROW(i) * DM, F_lane); } }
        __syncthreads();
        {   f32x4 acc[3];
#pragma unroll
            for (int nt = 0; nt < 3; ++nt) acc[nt] = (f32x4){0.f, 0.f, 0.f, 0.f};
#pragma unroll
            for (int ks = 0; ks < 4; ++ks) { const int bo = (F_lane & 15) * RT_HPITCH + (128 * F.wave + 32 * ks + 8 * (F_lane >> 4)) * 2;
                const bf16x8 bfr = *(const LAS bf16x8*)(hbuf + bo), bfl = *(const LAS bf16x8*)(hbuf_lo + bo);
#pragma unroll
                for (int nt = 0; nt < 3; ++nt) { acc[nt] = __builtin_amdgcn_mfma_f32_16x16x32_bf16(Whi[nt][ks], bfr, acc[nt], 0, 0, 0); acc[nt] = __builtin_amdgcn_mfma_f32_16x16x32_bf16(Wlo[nt][ks], bfr, acc[nt], 0, 0, 0);
                    acc[nt] = __builtin_amdgcn_mfma_f32_16x16x32_bf16(Whi[nt][ks], bfl, acc[nt], 0, 0, 0); } }
#pragma unroll
            for (int nt = 0; nt < 3; ++nt)
#pragma unroll
                for (int rg = 0; rg < 4; ++rg) part[(F.wave * 48 + 16 * nt + 4 * (F_lane >> 4) + rg) * 16 + (F_lane & 15)] = acc[nt][rg]; }
        __syncthreads();
        for (int idx = F_tid; idx < 36 * 16; idx += NTHR) { const int o = idx >> 4, r = idx & 15; float sacc = o < 4 ? gb[o] : eb[o - 4];
#pragma unroll
            for (int w = 0; w < 8; ++w) sacc += part[(w * 48 + o) * 16 + r];
            lgs[r * 48 + o] = sacc; }
        __syncthreads();
        if (F_tid < 16 && ig + F_tid < i1) {
            float lg[36];
#pragma unroll
            for (int o4 = 0; o4 < 9; ++o4) { const f32x4 t4 = *(const LAS f32x4*)(lgs + F_tid * 48 + 4 * o4); lg[4 * o4] = t4[0]; lg[4 * o4 + 1] = t4[1]; lg[4 * o4 + 2] = t4[2]; lg[4 * o4 + 3] = t4[3]; }
            int grp = 0; float gmax = lg[0];
#pragma unroll
            for (int q = 1; q < 4; ++q) if (lg[q] > gmax) { gmax = lg[q]; grp = q; }
            float den = 0.f;
#pragma unroll
            for (int q = 0; q < 4; ++q) den += __expf(lg[q] - gmax);
            const float pg = 1.f / den;
            float el[8];
#pragma unroll
            for (int q = 0; q < 8; ++q) { float v = 0.f;
#pragma unroll
                for (int g2 = 0; g2 < 4; ++g2) v = (grp == g2) ? lg[4 + 8 * g2 + q] : v;
                el[q] = v; }
            int i0e = 0; float m0 = el[0];
#pragma unroll
            for (int q = 1; q < 8; ++q) if (el[q] > m0) { m0 = el[q]; i0e = q; }
            int i1e = -1; float m1 = -INFINITY;
#pragma unroll
            for (int q = 0; q < 8; ++q) if (q != i0e && el[q] > m1) { m1 = el[q]; i1e = q; }
            const float ex = __expf(m1 - m0); const float g0 = pg / (1.f + ex), g1 = pg * ex / (1.f + ex);
            const int e0 = grp * 8 + i0e, e1 = grp * 8 + i1e; const int li = ig + F_tid - i0;
            recE[2 * li] = e0; recE[2 * li + 1] = e1; recG[2 * li] = g0; recG[2 * li + 1] = g1;
            recP[2 * li] = atomicAdd((int*)&lcnt[e0], 1); recP[2 * li + 1] = atomicAdd((int*)&lcnt[e1], 1);
        }
    }
    __syncthreads();
    const int tid2 = F.wave * 64 + lane_id();
    if (tid2 < 32) { const int c = lcnt[tid2]; lbase[tid2] = c > 0 ? (int)__hip_atomic_fetch_add(F.ctl + CW_CNT + 64 * LAYER + tid2, (unsigned)c, RLX_AGENT) : 0; }
    __syncthreads();
    int* TOK = (int*)(F.ws + WS_TOKIDX); float* GT = (float*)(F.ws + WS_GATE); int* RT = (int*)(F.ws + WS_ROUTE);
    for (int idx = tid2; idx < 2 * (i1 - i0); idx += NTHR) { const int li = idx >> 1, i = i0 + li; int row;
        if (LAYER == 0) row = i; else row = (i >> 12) * RPB + CTXL + (i & 4095);
        const int e = recE[idx], pos = lbase[e] + recP[idx];
        TOK[(size_t)e * CAP + pos] = row; GT[(size_t)e * CAP + pos] = recG[idx]; RT[(size_t)row * 4 + 2 * (idx & 1)] = e; RT[(size_t)row * 4 + 2 * (idx & 1) + 1] = pos; }
#undef RT_LDX
#undef RT_YROW
}

template <int LAYER> __device__ __forceinline__ int cmb_row(int i) { return LAYER == 0 ? i : (i >> 12) * RPB + CTXL + (i & 4095); }
template <int LAYER>
__device__ __forceinline__ void p_combine(Frame& F, const Args& a) {
    const int F_lane = lane_id(), F_tid = F.wave * 64 + F_lane; (void)F_tid;
    const float* MOD = (const float*)(F.ws + WS_MOD) + (size_t)LAYER * 17 * 6144; const float* MOD1 = (const float*)(F.ws + WS_MOD) + (size_t)17 * 6144;
    float* XC = (float*)(F.ws + WS_XC); bf16* H = (bf16*)(F.ws + WS_BUF1); const bf16* MOUT = (const bf16*)(F.ws + WS_BUF2); const int* RT = (const int*)(F.ws + WS_ROUTE); const bf16* YB = (const bf16*)(F.ws + WS_Y);
    LAS int* tab = (LAS int*)F.lds; moe_tab(F, tab, LAYER);
    const int gw = F.bid * NWAVES + F.wave, NGW = F.G * NWAVES; const int nrows = LAYER == 0 ? NROWS : NB * SEQ;
    if (gw >= nrows) return;
    typedef int i32x4 __attribute__((ext_vector_type(4)));
#define CMB_XP(row_) ({ int b_, j_; jrow_split((row_), b_, j_); j_ < CTXL ? XC + ((size_t)b_ * CTXL + j_) * DM : a.out + ((size_t)b_ * SEQ + (j_ - CTXL)) * DM; })
#define CMB_LDX(row_) ({ RowVec xr_; int b_, j_; jrow_split((row_), b_, j_); if (LAYER == 0) xr_ = ld_row_nt(j_ < CTXL ? a.in[I_CTX] + ((size_t)b_ * CTXL + j_) * DM : a.in[I_X] + ((size_t)b_ * SEQ + (j_ - CTXL)) * DM, F_lane); else xr_ = ld_row_bf16(x2b_row(F.ws, b_, j_ - CTXL), F_lane); xr_; })
    int i = gw; int row = cmb_row<LAYER>(i);
    i32x4 rt = *(const i32x4*)(RT + (size_t)row * 4);
    int i_n = i + NGW < nrows ? i + NGW : i; int row_n = cmb_row<LAYER>(i_n);
    i32x4 rt_n = *(const i32x4*)(RT + (size_t)row_n * 4);
    RowVec x = CMB_LDX(row); RowRaw yr = ld_raw_bf16(YB + (size_t)row * DM, F_lane);
    RowRaw m0 = ld_raw_bf16(MOUT + ((size_t)tab[rt[0]] * 256 + rt[1]) * DM, F_lane), m1 = ld_raw_bf16(MOUT + ((size_t)tab[rt[2]] * 256 + rt[3]) * DM, F_lane);
    for (; i < nrows; ) {
        const int i_nn = i_n + NGW < nrows ? i_n + NGW : i_n; const int row_nn = cmb_row<LAYER>(i_nn);
        const i32x4 rt_nn = *(const i32x4*)(RT + (size_t)row_nn * 4);
        const RowVec x_n = CMB_LDX(row_n); const RowRaw yr_n = ld_raw_bf16(YB + (size_t)row_n * DM, F_lane);
        const RowRaw m0_n = ld_raw_bf16(MOUT + ((size_t)tab[rt_n[0]] * 256 + rt_n[1]) * DM, F_lane), m1_n = ld_raw_bf16(MOUT + ((size_t)tab[rt_n[2]] * 256 + rt_n[3]) * DM, F_lane);
        int b, j; jrow_split(row, b, j); float* xp = CMB_XP(row); const int mb = j < CTXL ? 16 : b;
        const RowVec g5 = ld_row(MOD + (size_t)mb * 6144 + 5 * 1024, F_lane);
#pragma unroll
        for (int q = 0; q < 4; ++q) { const f32x4 a0 = (f32x4){bflo(m0.w[q].x), bfhi(m0.w[q].x), bflo(m0.w[q].y), bfhi(m0.w[q].y)}, a1 = (f32x4){bflo(m1.w[q].x), bfhi(m1.w[q].x), bflo(m1.w[q].y), bfhi(m1.w[q].y)};
            x.v[q] = (x.v[q] + (f32x4){bflo(yr.w[q].x), bfhi(yr.w[q].x), bflo(yr.w[q].y), bfhi(yr.w[q].y)}) + g5.v[q] * (a0 + a1); }
        if (LAYER == 0) { if (j >= CTXL) st_row_bf16_nt(x2b_row(F.ws, b, j - CTXL), F_lane, x); const float* md = MOD1 + (size_t)mb * 6144; const RowVec y = norm_mod(x, a.in[I_N1G] + 1024, md + 1024, md, F_lane); st_row_bf16(H + (size_t)row * DM, F_lane, y); }
        else { const RowVec y = norm_mod(x, a.in[I_FNG], nullptr, nullptr, F_lane); st_row_nt(xp, F_lane, y); }
        if (i + NGW >= nrows) break;
        i = i_n; row = row_n; x = x_n; yr = yr_n; m0 = m0_n; m1 = m1_n; i_n = i_nn; row_n = row_nn; rt_n = rt_nn;
    }
#undef CMB_XP
#undef CMB_LDX
}

__device__ __forceinline__ void p_transpose_y(Frame& F) {
    const int F_lane = lane_id();
    const bf16* YT = (const bf16*)(F.ws + WS_BUF4); bf16* YM = (bf16*)(F.ws + WS_BUF1);
    LAS unsigned short* t = (LAS unsigned short*)(F.lds + F.wave * 9216);
    const int gw = F.bid * NWAVES + F.wave, NGW = F.G * NWAVES; const int NT_R = NROWS / 64; const int NTILES = 8 * NT_R;
    if (gw >= NTILES) return;
    u32x4 cur[8], nxt[8];
#define TY_LOAD(dst, tile_) do { const int cb_ = (tile_) / NT_R, rb_ = (tile_) % NT_R; _Pragma("unroll") for (int i = 0; i < 8; ++i) dst[i] = __builtin_nontemporal_load((const u32x4*)(YT + (size_t)(cb_ * 64 + 8 * i + (F_lane >> 3)) * CT_LD + rb_ * 64 + 8 * (F_lane & 7))); } while (0)
    TY_LOAD(cur, gw);
    for (int tile = gw; tile < NTILES; tile += NGW) { const int cb = tile / NT_R, rb = tile % NT_R; const int c0 = cb * 64, r0 = rb * 64;
        const int tn = tile + NGW < NTILES ? tile + NGW : tile; TY_LOAD(nxt, tn);
#pragma unroll
        for (int i = 0; i < 8; ++i) *(LAS u32x4*)(t + (8 * i + (F_lane >> 3)) * 72 + 8 * (F_lane & 7)) = cur[i];
        LDS_WAIT(); asm volatile("" ::: "memory");
#pragma unroll
        for (int i = 0; i < 8; ++i) { const int r = 8 * i + (F_lane >> 3), cc = F_lane & 7; unsigned short e[8];
#pragma unroll
            for (int k = 0; k < 8; ++k) e[k] = t[(8 * cc + k) * 72 + r];
            u32x4 w; w.x = e[0] | ((unsigned)e[1] << 16); w.y = e[2] | ((unsigned)e[3] << 16); w.z = e[4] | ((unsigned)e[5] << 16); w.w = e[6] | ((unsigned)e[7] << 16);
            *(u32x4*)(YM + (size_t)(r0 + r) * DM + c0 + 8 * cc) = w; }
        LDS_WAIT(); asm volatile("" ::: "memory");
#pragma unroll
        for (int i = 0; i < 8; ++i) cur[i] = nxt[i];
    }
#undef TY_LOAD
}
constexpr int HY_UP = 8208;
constexpr int HY_G_OFF = 16 * HY_UP, HY_GK_BYTES = 4096 * 2 + 64  , HY_G_BYTES = 3 * HY_GK_BYTES, HY_RED_OFF = HY_G_OFF + HY_G_BYTES;
static_assert(HY_RED_OFF + 64 <= MISC_OFF, "hyena LDS map");

#define LAUNDER(x) asm volatile("" : "+v"(x))
__device__ __forceinline__ float hy_tap(const float* HR, int order, int c, int lag) {
    if (lag > 4095 || lag < -4095) return 0.f;
    return lag >= 0 ? HR[(size_t)(order * 512 + c) * 4096 + lag] : HR[(size_t)(1024 + order * 512 + c) * 4096 - lag];
}
__device__ __forceinline__ void hy_load_filter(Frame& F, const float* HR, int order, int c, LAS unsigned char* G3, LAS float* red) {
    const int lane_ = lane_id();
    float fa[8], fb[8], fc[8]; float s = 0.f; int tid = F.wave * 64 + lane_; LAUNDER(tid);
#pragma unroll
    for (int k = 0; k < 8; ++k) { const int i = tid + 512 * k;
        fa[k] = i >= 1 ? hy_tap(HR, order, c, 2048 - i) : 0.f; fb[k] = i >= 1 ? hy_tap(HR, order, c, -i) : 0.f; fc[k] = i >= 1 ? hy_tap(HR, order, c, 4096 - i) : 0.f;
        s += fabsf(fb[k]) + fabsf(fc[k]) + (i == 2048 ? fabsf(fa[k]) : 0.f); }
    s = wave_sum(s); if (lane_ == 0) red[F.wave] = s;
    __syncthreads();
    float S = 0.f;
#pragma unroll
    for (int w = 0; w < 8; ++w) S += red[w];
    const float inv = 1.f / (S + 1e-6f);
#pragma unroll
    for (int k = 0; k < 8; ++k) { const int i = tid + 512 * k; const float a_ = fa[k] * inv;
        ((LAS unsigned short*)G3)[i] = (unsigned short)f2bf(a_);
        ((LAS unsigned short*)(G3 + HY_GK_BYTES))[i] = (unsigned short)f2bf(fb[k] * inv - a_);
        ((LAS unsigned short*)(G3 + 2 * HY_GK_BYTES))[i] = (unsigned short)f2bf(fc[k] * inv - a_); }
    __syncthreads();
}
__device__ __forceinline__ f32x4 sconv4(const bf16* up, int tb, int n, float w0, float w1, float w2, float bias) {
    const u32x2 w = *(const u32x2*)up; const float pv = tb > 0 ? bf2f(up[tb > 0 ? -1 : 0]) : 0.f, nx = tb + 4 < n ? bf2f(up[tb + 4 < n ? 4 : 0]) : 0.f;
    const float u0 = bflo(w.x), u1 = bfhi(w.x), u2 = bflo(w.y), u3 = bfhi(w.y);
    return (f32x4){w0 * pv + w1 * u0 + w2 * u1 + bias, w0 * u0 + w1 * u1 + w2 * u2 + bias, w0 * u1 + w1 * u2 + w2 * u3 + bias, w0 * u2 + w1 * u3 + w2 * nx + bias};
}
template <bool SUMX>
__device__ __forceinline__ void hy_half(f32x4 (&acc)[16], bf16x8 (&Bw)[8], unsigned (&x0)[5], unsigned (&x1)[5], bf16x8& Btmp, const LAS unsigned char* xbase, const int xoff, const LAS unsigned char* bbase, const int boff, const unsigned sh,
                                        const int u, const int qlo, const int qhi, const int par, const bool binstall, const bool bprefetch) {
    if (par == 0 && binstall) Bw[(8 - u) & 7] = Btmp;
    u32x4 w;
#pragma unroll
    for (int k = 0; k < 4; ++k) w[k] = __builtin_amdgcn_alignbit(x0[k + 1], x0[k], sh);
    const bf16x8 a = __builtin_bit_cast(bf16x8, w);
#pragma unroll
    for (int k = 0; k < 5; ++k) { x0[k] = x1[k]; x1[k] = *(const LAS unsigned*)(xbase + xoff + 4 * k); }
    if (par == 0 && bprefetch) { Btmp = *(const LAS bf16x8*)(bbase + boff);
        if (SUMX) { const bf16x8 t1 = *(const LAS bf16x8*)(bbase + 4096 + boff); const u32x4 p0 = __builtin_bit_cast(u32x4, Btmp), p1 = __builtin_bit_cast(u32x4, t1); u32x4 ps;
#pragma unroll
            for (int k = 0; k < 4; ++k) ps[k] = pk2(bflo(p0[k]) + bflo(p1[k]), bfhi(p0[k]) + bfhi(p1[k]));
            Btmp = __builtin_bit_cast(bf16x8, ps); } }
    __builtin_amdgcn_sched_barrier(0);
#pragma unroll
    for (int q = 0; q < 8; ++q) if (q >= qlo && q <= qhi) { const int sl = (q - u) & 7;
        acc[2 * q + par] = __builtin_amdgcn_mfma_f32_16x16x32_bf16(a, Bw[sl], acc[2 * q + par], 0, 0, 0); }
    __builtin_amdgcn_sched_barrier(0);
}
template <bool SUMX>
__device__ __forceinline__ void hy_step(f32x4 (&acc)[16], bf16x8 (&Bw)[8], unsigned (&x0)[5], unsigned (&x1)[5], bf16x8& Btmp, const LAS unsigned char* xbase, const int xoff, const LAS unsigned char* bbase, const int boff, const unsigned sh,
                                        const int u, const int qlo, const int qhi, const bool binstall, const bool bprefetch) {
    hy_half<SUMX>(acc, Bw, x0, x1, Btmp, xbase, xoff - 64, bbase, boff, sh, u, qlo, qhi, 0, binstall, bprefetch);
    hy_half<SUMX>(acc, Bw, x0, x1, Btmp, xbase, xoff - 96, bbase, boff, sh, u, qlo, qhi, 1, false, false);
}
template <int NJ, int UPITCH, bool SUMX = false>
__device__ __forceinline__ void hy_conv_pass(f32x4 (&acc)[16], const LAS unsigned char* U, const LAS unsigned short* GR, int v, int lane_in) {
    int lane = lane_in; LAUNDER(lane); const int row = lane & 15, g = lane >> 4, r = row & 1;
    const unsigned sh = 16u * (unsigned)r;
    const LAS unsigned char* ub = U + row * UPITCH + g * 16;
    const LAS unsigned char* xa = (const LAS unsigned char*)GR + 2 * (32 * NJ - row + 8 * g - r) - 64 * (8 * v - (NJ - 1));
    const LAS unsigned char* bn = ub + (NJ - 2) * 64;
    bf16x8 Bw[8]; bf16x8 Btmp = *(const LAS bf16x8*)(ub + (NJ - 1) * 64); unsigned x0[5], x1[5];
    if (SUMX) { const bf16x8 t1 = *(const LAS bf16x8*)(ub + 4096 + (NJ - 1) * 64); const u32x4 p0 = __builtin_bit_cast(u32x4, Btmp), p1 = __builtin_bit_cast(u32x4, t1); u32x4 ps;
#pragma unroll
        for (int k = 0; k < 4; ++k) ps[k] = pk2(bflo(p0[k]) + bflo(p1[k]), bfhi(p0[k]) + bfhi(p1[k]));
        Btmp = __builtin_bit_cast(bf16x8, ps); }
#pragma unroll
    for (int i = 0; i < 8; ++i) Bw[i] = (bf16x8){0, 0, 0, 0, 0, 0, 0, 0};
#pragma unroll
    for (int k = 0; k < 5; ++k) { x0[k] = *(const LAS unsigned*)(xa + 4 * k); x1[k] = *(const LAS unsigned*)(xa - 32 + 4 * k); }
    { const LAS unsigned char* xl = xa - 64 * 9; const LAS unsigned char* bl = bn - 64 * 7; asm volatile("" : "+v"(xl), "+v"(bl));
#pragma unroll
      for (int s = 0; s < 7; ++s) hy_step<SUMX>(acc, Bw, x0, x1, Btmp, xl, 64 * (9 - s), bl, 64 * (7 - s), sh, s + 1, 0, s, true, true);
      xa -= 64 * 7; bn -= 64 * 7; }
#pragma unroll 1
    for (int it = 0; it < (NJ - 8) / 8; ++it) {
        const LAS unsigned char* xl = xa - 64 * 9; const LAS unsigned char* bl = bn - 64 * 7; asm volatile("" : "+v"(xl), "+v"(bl));
#pragma unroll
        for (int u = 0; u < 8; ++u) hy_step<SUMX>(acc, Bw, x0, x1, Btmp, xl, 64 * (9 - u), bl, 64 * (7 - u), sh, u, 0, 7, true, true);
        xa -= 512; bn -= 512;
    }
    { const LAS unsigned char* xl = xa - 64 * 9; asm volatile("" : "+v"(xl));
      hy_step<SUMX>(acc, Bw, x0, x1, Btmp, xl, 64 * 9, ub, 0, sh, 0, 0, 7, true, false);
#pragma unroll
      for (int m = 1; m < 8; ++m) hy_step<SUMX>(acc, Bw, x0, x1, Btmp, xl, 64 * (9 - m), ub, 0, sh, m, m, 7, false, false); }
}
__device__ __forceinline__ void hyena_latent_unit(Frame& F, const Args& a, int c) {
    const bf16* UT = (const bf16*)(F.ws + WS_BUF2); bf16* YT = (bf16*)(F.ws + WS_BUF4); const float* HR = (const float*)(F.ws + WS_HRAW);
    const int lane_ = lane_id(); const int tid_ = F.wave * 64 + lane_;
    LAS unsigned char* U = F.lds; LAS unsigned char* G3 = F.lds + HY_G_OFF; LAS float* red = (LAS float*)(F.lds + HY_RED_OFF);
    const LAS unsigned short* GA = (const LAS unsigned short*)G3; const LAS unsigned short* GBA = (const LAS unsigned short*)(G3 + HY_GK_BYTES); const LAS unsigned short* GCA = (const LAS unsigned short*)(G3 + 2 * HY_GK_BYTES);
    const float* cw = a.in[I_HYCW]; const float* cb = a.in[I_HYCB]; const float* sk = a.in[I_HYSKIP];
    hy_load_filter(F, HR, 0, c, G3, red);
    {
        const float w0 = cw[c], w1 = cw[1536 + c], w2 = cw[3072 + c], bs = cb[c]; int tid = tid_; LAUNDER(tid);
        const int t8 = (tid & 511) * 8; const bf16* up0 = UT + (size_t)c * CT_LD + CTXL + t8;
        u32x4 uw[16]; unsigned short upv[16], unx[16];
#pragma unroll
        for (int k = 0; k < 16; ++k) { const bf16* up = up0 + (size_t)k * RPB; uw[k] = *(const u32x4*)up; upv[k] = up[-1]; unx[k] = up[8]; }
#pragma unroll
        for (int k = 0; k < 16; ++k) {
            const float e0 = t8 > 0 ? bf2f(upv[k]) : 0.f, e9 = t8 + 8 < 4096 ? bf2f(unx[k]) : 0.f;
            const float e1 = bflo(uw[k].x), e2 = bfhi(uw[k].x), e3 = bflo(uw[k].y), e4 = bfhi(uw[k].y), e5 = bflo(uw[k].z), e6 = bfhi(uw[k].z), e7 = bflo(uw[k].w), e8 = bfhi(uw[k].w);
            u32x4 w; w.x = pk2(w0 * e0 + w1 * e1 + w2 * e2 + bs, w0 * e1 + w1 * e2 + w2 * e3 + bs); w.y = pk2(w0 * e2 + w1 * e3 + w2 * e4 + bs, w0 * e3 + w1 * e4 + w2 * e5 + bs);
            w.z = pk2(w0 * e4 + w1 * e5 + w2 * e6 + bs, w0 * e5 + w1 * e6 + w2 * e7 + bs); w.w = pk2(w0 * e6 + w1 * e7 + w2 * e8 + bs, w0 * e7 + w1 * e8 + w2 * e9 + bs);
            *(LAS u32x4*)(U + k * HY_UP + t8 * 2) = w; }
    }
    __syncthreads();
    u32x2 keep[2][16];
#pragma unroll
    for (int pass = 0; pass < 2; ++pass) {
        const int xoff = pass == 0 ? 512 : 1024;
        const float w0 = cw[xoff + c], w1 = cw[1536 + xoff + c], w2 = cw[3072 + xoff + c], bs = cb[xoff + c], skip = sk[pass * 512 + c];
        f32x4 accP[16];
#pragma unroll
        for (int i = 0; i < 16; ++i) accP[i] = (f32x4){0.f, 0.f, 0.f, 0.f};
        hy_conv_pass<64, HY_UP, true>(accP, U, GA, F.wave, lane_);
#pragma unroll
        for (int sp = 0; sp < 2; ++sp) {
            const int v = 8 * sp + F.wave;
            unsigned pf0, pf1;
            { int lp = lane_; LAUNDER(lp); const bf16* pfp = UT + (size_t)(xoff + c) * CT_LD + (lp & 15) * RPB + CTXL + 256 * v + (lp >> 4) * 32;
              pf0 = *(const unsigned*)pfp; pf1 = *(const unsigned*)(pfp + 128); }
            f32x4 acc[16];
#pragma unroll
            for (int i = 0; i < 16; ++i) acc[i] = accP[i];
            if (sp == 0) hy_conv_pass<64, HY_UP, false>(acc, U + 4096, GBA, F.wave, lane_);
            else         hy_conv_pass<64, HY_UP, false>(acc, U, GCA, F.wave, lane_);
            asm volatile("" :: "v"(pf0), "v"(pf1) : "memory"); __builtin_amdgcn_sched_barrier(0);
            int ln = lane_; LAUNDER(ln); const int b = ln & 15, g = ln >> 4;
            const bf16* ux = UT + (size_t)(xoff + c) * CT_LD + b * RPB + CTXL + 256 * v + 4 * g;
#pragma unroll
            for (int tg = 0; tg < 4; ++tg) {
                u32x2 xw[4]; unsigned short xp[4], xn[4];
#pragma unroll
                for (int j = 0; j < 4; ++j) { const bf16* up = ux + 16 * (4 * tg + j); xw[j] = *(const u32x2*)up; xp[j] = up[-1]; xn[j] = up[4]; }
#pragma unroll
                for (int j = 0; j < 4; ++j) { const int ti = 4 * tg + j; const int tb = 256 * v + 16 * ti + 4 * g;
                    const float pv = tb > 0 ? bf2f(xp[j]) : 0.f, nx = tb + 4 < 4096 ? bf2f(xn[j]) : 0.f; const float u0 = bflo(xw[j].x), u1 = bfhi(xw[j].x), u2 = bflo(xw[j].y), u3 = bfhi(xw[j].y);
                    const f32x4 xx = (f32x4){w0 * pv + w1 * u0 + w2 * u1 + bs, w0 * u0 + w1 * u1 + w2 * u2 + bs, w0 * u1 + w1 * u2 + w2 * u3 + bs, w0 * u2 + w1 * u3 + w2 * nx + bs};
                    const u32x2 vw = *(const LAS u32x2*)(U + b * HY_UP + tb * 2); const f32x4 vv = (f32x4){bflo(vw.x), bfhi(vw.x), bflo(vw.y), bfhi(vw.y)};
                    const f32x4 res = xx * (acc[ti] + vv * skip); u32x2 w; w.x = pk2(res[0], res[1]); w.y = pk2(res[2], res[3]); keep[sp][ti] = w; }
                asm volatile("" : "+v"(keep[sp][4 * tg]), "+v"(keep[sp][4 * tg + 1]), "+v"(keep[sp][4 * tg + 2]), "+v"(keep[sp][4 * tg + 3]) :: "memory");
            }
        }
        __syncthreads();
        {   int ln = lane_; LAUNDER(ln); const int b = ln & 15, g = ln >> 4;
#pragma unroll
            for (int sp = 0; sp < 2; ++sp)
#pragma unroll
                for (int ti = 0; ti < 16; ++ti) { const int tb = 256 * (8 * sp + F.wave) + 16 * ti + 4 * g; *(LAS u32x2*)(U + b * HY_UP + tb * 2) = keep[sp][ti]; } }
        if (pass == 0) hy_load_filter(F, HR, 1, c, G3, red);
        else __syncthreads();
    }
    int tid3 = tid_; LAUNDER(tid3);
#pragma unroll 2
    for (int k = 0; k < 16; ++k) { const int q = tid3 + 512 * k, bb = q >> 9, t8 = (q & 511) * 8; const u32x4 w = *(const LAS u32x4*)(U + bb * HY_UP + t8 * 2);
        *(u32x4*)(YT + (size_t)c * CT_LD + bb * RPB + CTXL + t8) = w; }
    __syncthreads();
}
constexpr int HC_UP = 528, HC_G_OFF = 16 * HC_UP, HC_WAVE_BYTES = HC_G_OFF + 1024 + 64;
__device__ __forceinline__ void hc_load_filter(const float* HR, int order, int c, LAS unsigned short* GR, int lane) {
    float v[8]; float s = 0.f;
#pragma unroll
    for (int k = 0; k < 8; ++k) { const int i = lane + 64 * k; const int lag = 256 - i; float val = 0.f;
        if (i >= 1) val = lag >= 0 ? HR[(size_t)(order * 512 + c) * 256 + lag] : HR[(size_t)(1024 + order * 512 + c) * 256 - lag];
        v[k] = val; s += fabsf(val); }
    const float inv = 1.f / (wave_sum(s) + 1e-6f);
#pragma unroll
    for (int k = 0; k < 8; ++k) GR[lane + 64 * k] = (unsigned short)f2bf(v[k] * inv);
    LDS_WAIT(); asm volatile("" ::: "memory");
}
__device__ __forceinline__ void hyena_ctx_wave(Frame& F, const Args& a, int c) {
    const bf16* UT = (const bf16*)(F.ws + WS_BUF2); bf16* YT = (bf16*)(F.ws + WS_BUF4); const float* HR = (const float*)(F.ws + WS_HRAWC);
    const int lane = lane_id();
    LAS unsigned char* U = F.lds + F.wave * HC_WAVE_BYTES; LAS unsigned short* GR = (LAS unsigned short*)(U + HC_G_OFF);
    const float* cw = a.in[I_HYCW]; const float* cb = a.in[I_HYCB]; const float* sk = a.in[I_HYSKIP];
    hc_load_filter(HR, 0, c, GR, lane);
    {   const float w0 = cw[c], w1 = cw[1536 + c], w2 = cw[3072 + c], bs = cb[c];
#pragma unroll 2
        for (int k = 0; k < 8; ++k) { const int q = lane + 64 * k, b = q >> 5, t8 = (q & 31) * 8; const bf16* up = UT + (size_t)c * CT_LD + b * RPB + t8;
            const u32x4 uw = *(const u32x4*)up; const float e0 = t8 > 0 ? bf2f(up[-1]) : 0.f, e9 = t8 + 8 < 256 ? bf2f(up[8]) : 0.f;
            const float e1 = bflo(uw.x), e2 = bfhi(uw.x), e3 = bflo(uw.y), e4 = bfhi(uw.y), e5 = bflo(uw.z), e6 = bfhi(uw.z), e7 = bflo(uw.w), e8 = bfhi(uw.w);
            u32x4 w; w.x = pk2(w0 * e0 + w1 * e1 + w2 * e2 + bs, w0 * e1 + w1 * e2 + w2 * e3 + bs); w.y = pk2(w0 * e2 + w1 * e3 + w2 * e4 + bs, w0 * e3 + w1 * e4 + w2 * e5 + bs);
            w.z = pk2(w0 * e4 + w1 * e5 + w2 * e6 + bs, w0 * e5 + w1 * e6 + w2 * e7 + bs); w.w = pk2(w0 * e6 + w1 * e7 + w2 * e8 + bs, w0 * e7 + w1 * e8 + w2 * e9 + bs);
            *(LAS u32x4*)(U + b * HC_UP + t8 * 2) = w; }
        LDS_WAIT(); asm volatile("" ::: "memory");
    }
    const int b = lane & 15, g = lane >> 4;
#pragma unroll
    for (int pass = 0; pass < 2; ++pass) {
        const int xoff = pass == 0 ? 512 : 1024;
        const float w0 = cw[xoff + c], w1 = cw[1536 + xoff + c], w2 = cw[3072 + xoff + c], bs = cb[xoff + c], skip = sk[pass * 512 + c];
        f32x4 acc[16];
#pragma unroll
        for (int i = 0; i < 16; ++i) acc[i] = (f32x4){0.f, 0.f, 0.f, 0.f};
        hy_conv_pass<8, HC_UP>(acc, U, GR, 0, lane);
        const bf16* ux = UT + (size_t)(xoff + c) * CT_LD + b * RPB + 4 * g;
        u32x2 keep[16];
#pragma unroll
        for (int ti = 0; ti < 16; ++ti) { const int tb = 16 * ti + 4 * g; const bf16* up = ux + 16 * ti; const u32x2 xw = *(const u32x2*)up;
            const float pv = tb > 0 ? bf2f(up[-1]) : 0.f, nx = tb + 4 < 256 ? bf2f(up[4]) : 0.f; const float u0 = bflo(xw.x), u1 = bfhi(xw.x), u2 = bflo(xw.y), u3 = bfhi(xw.y);
            const f32x4 xx = (f32x4){w0 * pv + w1 * u0 + w2 * u1 + bs, w0 * u0 + w1 * u1 + w2 * u2 + bs, w0 * u1 + w1 * u2 + w2 * u3 + bs, w0 * u2 + w1 * u3 + w2 * nx + bs};
            const u32x2 vw = *(const LAS u32x2*)(U + b * HC_UP + tb * 2); const f32x4 vv = (f32x4){bflo(vw.x), bfhi(vw.x), bflo(vw.y), bfhi(vw.y)};
            const f32x4 res = xx * (acc[ti] + vv * skip); keep[ti].x = pk2(res[0], res[1]); keep[ti].y = pk2(res[2], res[3]); }
        if (pass == 0) {
            LDS_WAIT(); asm volatile("" ::: "memory");
#pragma unroll
            for (int ti = 0; ti < 16; ++ti) *(LAS u32x2*)(U + b * HC_UP + (16 * ti + 4 * g) * 2) = keep[ti];
            hc_load_filter(HR, 1, c, GR, lane);
        } else {
#pragma unroll
            for (int ti = 0; ti < 16; ++ti) *(u32x2*)(YT + (size_t)c * CT_LD + b * RPB + 16 * ti + 4 * g) = keep[ti];
        }
    }
    LDS_WAIT(); asm volatile("" ::: "memory");
}

constexpr int WL1_0 = W_ITEMS_L1MOE, WL1_1 = WL1_0 + 2400, WL1_2 = WL1_1 + 4000, WL1_3 = WL1_2 + 1100, WL1_4 = WL1_3 + 1100, WL1_5 = W_ITEMS_ALL;
__global__ void __launch_bounds__(NTHR, 2) fwd_kernel(Args args) {
    extern __shared__ __attribute__((aligned(16))) unsigned char lds_raw[];
    Frame F; F.lds = (LAS unsigned char*)lds_raw; F.wave = __builtin_amdgcn_readfirstlane((int)threadIdx.x >> 6); F.G = gridDim.x; F.bid = blockIdx.x;
    F.ws = args.ws; F.ctl = (gu32*)(args.ws + WS_CTL);
    unsigned char* ws = args.ws;
    volatile LAS unsigned* MISC = (volatile LAS unsigned*)(F.lds + MISC_OFF);
    { const int l0 = lane_id(); if (F.wave == 0) MISC[l0] = 0u; }
    __syncthreads();
    XcdBarrier bar; bar.bar = (unsigned*)(F.ctl + CW_BAR); bar.x = 0; bar.st = nullptr;
    if (args.one_launch) bar = xcd_barrier_post((unsigned*)(F.ctl + CW_BAR), MISC + 8, F.wave == 0 && lane_id() == 0);
    const int lo = args.ph_lo, hi = args.ph_hi;
#ifndef PHASE_MASK
#define PHASE_MASK 0xFFFFFFFFu
#endif
#define IN(k) ((((PHASE_MASK) >> (k)) & 1u) && lo <= (k) && (k) < hi)
#ifndef REP_PHASE
#define REP_PHASE -1
#endif
#ifndef REP_PART
#define REP_PART 3
#endif
#define TAIL_WEIGHTS(nu_, lo_, hi_) do { const int nu__ = (nu_); const int busy__ = nu__ - (nu__ / F.G) * F.G; if (busy__ > 0 && F.bid >= busy__) weight_items(F, args, (lo_), (hi_), F.bid - busy__, F.G - busy__); else if (busy__ == 0) weight_items(F, args, (lo_), (hi_), F.bid, F.G); __syncthreads(); } while (0)
#define PH(k, ...) if (IN(k)) { __VA_ARGS__ } if (REP_PHASE == (k) && IN(k)) { __VA_ARGS__ }
#define SEAM(k) do { if (IN(k) && IN((k) + 1)) xcd_barrier(bar, F.wave == 0 && lane_id() == 0); } while (0)
    const float* MOD0 = (const float*)(ws + WS_MOD); const float* MOD1 = MOD0 + 17 * 6144;
    LAS unsigned char* ring = F.lds;

    PH(0,  p0_prologue(F, args);) SEAM(0);
    PH(1,  p_norm1_l0(F, args);) SEAM(1);
    PH(2,
        { pg8::SchedInProj S{(const char*)(ws + WS_BUF1), (const char*)(ws + WS_WHY), (const char*)(ws + WS_WATT0), F.G, F.bid};
          pg8::EpiInProj E{pg8::EpiBf16{(bf16*)(ws + WS_BUF2), CT_LD}, pg8::EpiQkv<0>{(bf16*)(ws + WS_BUF3), D_ATT0, (const f32x2*)(ws + WS_ROPE), nullptr, nullptr}};
          pg8::gemm_phase<pg8::EpiInProj, pg8::SchedInProj, true>(ring, 1024, S, E, F.wave);
          { const int busy = 9 * 272 - (9 * 272 / F.G) * F.G; if (busy > 0 && busy < F.G && F.bid >= busy) p_filter_stage_b(F, args, F.bid - busy, F.G - busy); else if (busy == 0 || busy >= F.G) p_filter_stage_b(F, args, F.bid, F.G); __syncthreads(); }
          TAIL_WEIGHTS(9 * 272, WL1_0, WL1_1); }
    ) SEAM(2);
#define P3_HY do { for (int c = F.bid; c < HYC; c += F.G) hyena_latent_unit(F, args, c); for (int c = F.bid + F.G * F.wave; c < HYC; c += F.G * NWAVES) hyena_ctx_wave(F, args, c); __syncthreads(); } while (0)
#define P3_AT do { const attn_body::bf16* QKV = (const attn_body::bf16*)(ws + WS_BUF3); attn_body::bf16* YM = (attn_body::bf16*)(ws + WS_BUF1); \
        for (int L = F.bid; L < 2048 + 128; L += F.G) { \
            if (L < 2048) { const int b = L >> 7, h = (L >> 4) & 7, qb = L & 15, q0 = qb * 256; const int lat0 = q0 >= 128 ? q0 - 128 : 0; const int lend = q0 + 384 < SEQ ? q0 + 384 : SEQ; const int NT = 4 + (lend - lat0) / 64; \
                const attn_body::bf16* base = QKV + (size_t)b * RPB * D_ATT0; \
                attn_body::attn_unit<1, D_ATT0, D_ATT0, DM, 8>(base + (size_t)(CTXL + q0) * D_ATT0 + h * 64, base + 512 + (h >> 2) * 64, base + 640 + (h >> 2) * 64, \
                    YM + ((size_t)b * RPB + CTXL + q0) * DM + 512 + h * 64, NT, lat0, q0, args.in[I_SINK][h] * LOG2E, (char*)lds_raw, F.wave, 0.f, false, false, nullptr, nullptr); } \
            else { const int r = L - 2048, b = r >> 3, h = r & 7; const attn_body::bf16* base = QKV + (size_t)b * RPB * D_ATT0; \
                attn_body::attn_unit<0, D_ATT0, D_ATT0, DM, 8>(base + h * 64, base + 512 + (h >> 2) * 64, base + 640 + (h >> 2) * 64, \
                    YM + (size_t)b * RPB * DM + 512 + h * 64, 4, 0, 0, args.in[I_SINK][h] * LOG2E, (char*)lds_raw, F.wave, 0.f, false, false, nullptr, nullptr); } } } while (0)
    if (IN(3)) {
        P3_HY; if (REP_PHASE == 3 && (REP_PART & 1)) { P3_HY; }
    } SEAM(3);
    if (IN(4)) { if (F.bid & 1) { p_transpose_y(F); __syncthreads(); } P3_AT; if (REP_PHASE == 4) { P3_AT; } if (!(F.bid & 1)) { __syncthreads(); p_transpose_y(F); } } SEAM(4);
    PH(5,
        pg8::SchedDense S; S.init(ws + WS_BUF1, ws + WS_WOUT0, NROWS, 1024, 1024, F.G, F.bid);
        pg8::EpiOut E{(bf16*)(ws + WS_Y), MOD0};
        pg8::gemm_phase<pg8::EpiOut, pg8::SchedDense, true>(ring, 1024, S, E, F.wave);
        TAIL_WEIGHTS(272 * 4, WL1_1, WL1_2);) SEAM(5);
    PH(6,  p_norm2_route<0>(F, args);) SEAM(6);
    PH(7,
        LAS int* tab = (LAS int*)(F.lds + pg8::STAGE_BYTES); moe_tab(F, tab, 0);
        pg8::SchedMoe<true> S{(const char*)(ws + WS_BUF1), (const char*)(ws + WS_WGU), (size_t)1024 * 1024 * 2, 1024, tab, (const int*)(ws + WS_TOKIDX), F.G, F.bid};
        pg8::EpiGateUp E{(bf16*)(ws + WS_BUF5)};
        pg8::gemm_phase<pg8::EpiGateUp, pg8::SchedMoe<true>, true>(ring, 1024, S, E, F.wave);
        { const int nu7 = tab[32] * 4; __syncthreads(); TAIL_WEIGHTS(nu7, WL1_2, WL1_3); }) SEAM(7);
    PH(8,
        LAS int* tab = (LAS int*)(F.lds + pg8::STAGE_BYTES); moe_tab(F, tab, 0);
        pg8::SchedMoe<false> S{(const char*)(ws + WS_BUF5), (const char*)(ws + WS_WDN), (size_t)1024 * 512 * 2, 512, tab, nullptr, F.G, F.bid};
        pg8::EpiDown E{(bf16*)(ws + WS_BUF2), (const float*)(ws + WS_GATE), tab};
        pg8::gemm_phase<pg8::EpiDown, pg8::SchedMoe<false>, true>(ring, 512, S, E, F.wave);
        { const int nu8 = tab[32] * 4; __syncthreads(); TAIL_WEIGHTS(nu8, WL1_3, WL1_4); }) SEAM(8);
    PH(9,  p_combine<0>(F, args);) SEAM(9);
    PH(10,
        pg8::SchedQkv1 S{(const char*)(ws + WS_BUF1), (const char*)(ws + WS_WQKV1), 1024, F.G, F.bid};
        pg8::EpiQkv<1> E{(bf16*)(ws + WS_BUF2), D_QKV1, (const f32x2*)(ws + WS_ROPE), args.in[I_ODQG], args.in[I_ODKG]};
        pg8::gemm_phase<pg8::EpiQkv<1>, pg8::SchedQkv1, true>(ring, 1024, S, E, F.wave);
        TAIL_WEIGHTS(256 * 6 + 32, WL1_4, WL1_5);) SEAM(10);
    PH(11,
        const attn_body::bf16* QKV = (const attn_body::bf16*)(ws + WS_BUF2); attn_body::bf16* AO = (attn_body::bf16*)(ws + WS_BUF1);
        float gqm = 0.f, gkm = 0.f; for (int d = 0; d < 64; ++d) { gqm = fmaxf(gqm, fabsf(args.in[I_ODQG][d])); gkm = fmaxf(gkm, fabsf(args.in[I_ODKG][d])); }
        const float m0 = 64.f * gqm * gkm * QSCALE * 1.02f;
        if (m0 <= 40.f) {
        for (int L = F.bid; L < 4096; L += F.G) { const int b = L >> 8, h = (L >> 4) & 15, qb = L & 15, q0 = qb * 256; const attn_body::bf16* base = QKV + (size_t)b * RPB * D_QKV1;
            const int Ln = L + F.G; const bool hn = Ln < 4096; const int bn_ = hn ? Ln >> 8 : b, hn_ = hn ? (Ln >> 4) & 15 : h, qn_ = hn ? (Ln & 15) * 256 : q0; const attn_body::bf16* basen = QKV + (size_t)bn_ * RPB * D_QKV1;
            attn_body::attn_unit<0, D_QKV1, D_QKV1, DM, 8, true>(base + (size_t)(CTXL + q0) * D_QKV1 + h * 64, base + 1024 + (h >> 2) * 64, base + 1280 + (h >> 2) * 64,
                AO + ((size_t)b * RPB + CTXL + q0) * DM + h * 64, 68, 0, 0, -INFINITY, (char*)lds_raw, F.wave, m0, L != F.bid, hn, basen + 1024 + (hn_ >> 2) * 64, basen + 1280 + (hn_ >> 2) * 64); }
        } else {
        for (int L = F.bid; L < 4096; L += F.G) { const int b = L >> 8, h = (L >> 4) & 15, qb = L & 15, q0 = qb * 256; const attn_body::bf16* base = QKV + (size_t)b * RPB * D_QKV1;
            const int Ln = L + F.G; const bool hn = Ln < 4096; const int bn_ = hn ? Ln >> 8 : b, hn_ = hn ? (Ln >> 4) & 15 : h, qn_ = hn ? (Ln & 15) * 256 : q0; const attn_body::bf16* basen = QKV + (size_t)bn_ * RPB * D_QKV1;
            attn_body::attn_unit<0, D_QKV1, D_QKV1, DM, 8, false>(base + (size_t)(CTXL + q0) * D_QKV1 + h * 64, base + 1024 + (h >> 2) * 64, base + 1280 + (h >> 2) * 64,
                AO + ((size_t)b * RPB + CTXL + q0) * DM + h * 64, 68, 0, 0, -INFINITY, (char*)lds_raw, F.wave, 0.f, L != F.bid, hn, basen + 1024 + (hn_ >> 2) * 64, basen + 1280 + (hn_ >> 2) * 64); }
        }
    ) SEAM(11);
    PH(12,
        pg8::SchedLat S{(const char*)(ws + WS_BUF1), (const char*)(ws + WS_WOUT1), 1024, 4, F.G, F.bid};
        pg8::EpiOut E{(bf16*)(ws + WS_Y), MOD1};
        pg8::gemm_phase<pg8::EpiOut, pg8::SchedLat, true>(ring, 1024, S, E, F.wave);) SEAM(12);
    PH(13,  p_norm2_route<1>(F, args);) SEAM(13);
    PH(14,
        LAS int* tab = (LAS int*)(F.lds + pg8::STAGE_BYTES); moe_tab(F, tab, 1);
        pg8::SchedMoe<true> S{(const char*)(ws + WS_BUF1), (const char*)(ws + WS_WGU) + (size_t)32 * 1024 * 1024 * 2, (size_t)1024 * 1024 * 2, 1024, tab, (const int*)(ws + WS_TOKIDX), F.G, F.bid};
        pg8::EpiGateUp E{(bf16*)(ws + WS_BUF5)};
        pg8::gemm_phase<pg8::EpiGateUp, pg8::SchedMoe<true>, true>(ring, 1024, S, E, F.wave);) SEAM(14);
    PH(15,
        LAS int* tab = (LAS int*)(F.lds + pg8::STAGE_BYTES); moe_tab(F, tab, 1);
        pg8::SchedMoe<false> S{(const char*)(ws + WS_BUF5), (const char*)(ws + WS_WDN) + (size_t)32 * 1024 * 512 * 2, (size_t)1024 * 512 * 2, 512, tab, nullptr, F.G, F.bid};
        pg8::EpiDown E{(bf16*)(ws + WS_BUF2), (const float*)(ws + WS_GATE), tab};
        pg8::gemm_phase<pg8::EpiDown, pg8::SchedMoe<false>, true>(ring, 512, S, E, F.wave);) SEAM(15);
    PH(16, p_combine<1>(F, args);)

#undef IN
#undef SEAM
}

constexpr int N_PHASES = 17;
#ifndef MK_ONE_LAUNCH
#define MK_ONE_LAUNCH 1
#endif
extern "C" void kernel_launch(void* const* d_in, const int* in_sizes, int n_in, void* d_out, int out_size, void* d_ws, size_t ws_size, hipStream_t stream) {
    static int grid = 0;
    if (grid == 0) {
        if (n_in != 32 || out_size != NB * SEQ * DM || ws_size < WS_END) { fprintf(stderr, "kernel_launch: unexpected problem (n_in %d out %d ws %zu, need ws %zu)\n", n_in, out_size, ws_size, (size_t)WS_END); grid = -1; return; }
        int dev = 0, cus = 0, per_cu = 0;
        if (hipGetDevice(&dev) != hipSuccess || hipDeviceGetAttribute(&cus, hipDeviceAttributeMultiprocessorCount, dev) != hipSuccess) { grid = -1; return; }
        if (hipFuncSetAttribute((const void*)fwd_kernel, hipFuncAttributeMaxDynamicSharedMemorySize, LDS_BYTES) != hipSuccess) { fprintf(stderr, "kernel_launch: hipFuncSetAttribute failed\n"); grid = -1; return; }
        if (hipOccupancyMaxActiveBlocksPerMultiprocessor(&per_cu, (const void*)fwd_kernel, NTHR, LDS_BYTES) != hipSuccess || per_cu < 1) fprintf(stderr, "kernel_launch: occupancy query says %d\n", per_cu);
        (void)hipGetLastError();
        grid = cus;
    }
    if (grid < 0) return;
    (void)hipMemsetAsync((char*)d_ws + WS_CTL, 0, CTL_ZERO_BYTES, stream);
    Args a{};
    for (int i = 0; i < 32; ++i) a.in[i] = (const float*)d_in[i];
    a.out = (float*)d_out; a.ws = (unsigned char*)d_ws; a.pad = 0;
    if (MK_ONE_LAUNCH) { a.ph_lo = 0; a.ph_hi = N_PHASES; a.one_launch = 1; hipLaunchKernelGGL(fwd_kernel, dim3(grid), dim3(NTHR), LDS_BYTES, stream, a); }
    else for (int p = 0; p < N_PHASES; ++p) { a.ph_lo = p; a.ph_hi = p + 1; a.one_launch = 0; hipLaunchKernelGGL(fwd_kernel, dim3(grid), dim3(NTHR), LDS_BYTES, stream, a); }
}
```

```cpp
#include <hip/hip_runtime.h>
#include <hip/hip_bf16.h>
#include <cstdio>
#include <cstdint>
#include <cmath>

#define GAS __attribute__((address_space(1)))
#define LAS __attribute__((address_space(3)))
typedef unsigned short bf16;
typedef unsigned short bf16_t;
typedef short bf16x8 __attribute__((ext_vector_type(8)));
typedef short s16x4 __attribute__((ext_vector_type(4)));
typedef float f32x2 __attribute__((ext_vector_type(2)));
typedef float f32x4 __attribute__((ext_vector_type(4)));
typedef float f32x16 __attribute__((ext_vector_type(16)));
typedef unsigned u32x2 __attribute__((ext_vector_type(2)));
typedef unsigned u32x4 __attribute__((ext_vector_type(4)));
typedef unsigned v4u __attribute__((ext_vector_type(4)));
typedef GAS unsigned gu32;

constexpr int NB = 16, SEQ = 4096, CTXL = 256, DM = 1024, RPB = SEQ + CTXL  , NROWS = NB * RPB  ;
constexpr int CT_LD = NROWS + 128;
constexpr int HYC = 512, HD = 64, NEXP = 32, DEXP = 512, NMOD = 6;
constexpr int D_IN_EVEN = 2304, D_ATT0 = 768, D_QKV1 = 1536;
constexpr float NORM_EPS = 1e-6f;
constexpr float LOG2E = 1.4426950408889634f;
constexpr float QSCALE = 0.125f * 1.4426950408889634f;
constexpr int CAP = NROWS;
constexpr int MAXSLOTS = 147456;

constexpr size_t MiB = 1u << 20;
constexpr size_t WS_CTL = 0, CTL_ZERO_BYTES = 1 * MiB;
constexpr size_t WS_MOD = 1 * MiB;
constexpr size_t WS_ROPE = 2 * MiB;
constexpr size_t WS_HD2 = 2 * MiB + 65536;
constexpr size_t WS_ROUTE = 3 * MiB + 512 * 1024;
constexpr size_t WS_TOKIDX = 5 * MiB;
constexpr size_t WS_GATE = 14 * MiB;
constexpr size_t WS_HRAW = 23 * MiB;
constexpr size_t WS_HRAWC = 55 * MiB;
constexpr size_t WS_WHY = 57 * MiB;
constexpr size_t WS_WATT0 = 60 * MiB;
constexpr size_t WS_WOUT0 = 62 * MiB;
constexpr size_t WS_WQKV1 = 64 * MiB;
constexpr size_t WS_WOUT1 = 67 * MiB;
constexpr size_t WS_WGU = 69 * MiB;
constexpr size_t WS_WDN = 197 * MiB;
constexpr size_t WS_XC = 261 * MiB;
constexpr size_t WS_BUF1 = 277 * MiB;
constexpr size_t WS_BUF2 = 413 * MiB;
constexpr size_t WS_BUF3 = 618 * MiB;
constexpr size_t WS_BUF5 = 720 * MiB;
constexpr size_t WS_BUF4 = 864 * MiB;
constexpr size_t WS_Y = 864 * MiB;
constexpr size_t WS_END = 1000 * MiB;
static_assert(WS_BUF2 + (size_t)1536 * CT_LD * 2 <= WS_BUF3 && WS_BUF4 + (size_t)512 * CT_LD * 2 <= WS_END, "padded channel-major images fit");
static_assert(WS_BUF2 + (size_t)MAXSLOTS * 1024 * 2 <= WS_BUF5, "MOUT fits BUF2+BUF3");
constexpr int CW_TMO = 0, CW_CODE = 1;
constexpr int CW_CNT = 1024;
constexpr int CW_BAR = 4096;

constexpr int LDS_BYTES = 160 * 1024 - 256;
constexpr int MISC_OFF = LDS_BYTES - 256;

#define RLX_AGENT __ATOMIC_RELAXED, __HIP_MEMORY_SCOPE_AGENT
#define LDS_WAIT() asm volatile("s_waitcnt lgkmcnt(0)" ::: "memory")
#define VM_WAIT() asm volatile("s_waitcnt vmcnt(0)" ::: "memory")
__device__ __forceinline__ unsigned f2bf(float f) { unsigned u = __builtin_bit_cast(unsigned, f); return (u + 0x7fffu + ((u >> 16) & 1u)) >> 16; }
typedef float f32x2_t_ __attribute__((ext_vector_type(2))); typedef __bf16 bf16x2_t_ __attribute__((ext_vector_type(2)));
__device__ __forceinline__ unsigned pk2(float lo, float hi) { f32x2_t_ v = {lo, hi}; bf16x2_t_ b = __builtin_convertvector(v, bf16x2_t_); return __builtin_bit_cast(unsigned, b); }
__device__ __forceinline__ float bf2f(unsigned short b) { return __builtin_bit_cast(float, (unsigned)b << 16); }
__device__ __forceinline__ float bflo(unsigned w) { return __builtin_bit_cast(float, w << 16); }
__device__ __forceinline__ float bfhi(unsigned w) { return __builtin_bit_cast(float, w & 0xffff0000u); }
__device__ __forceinline__ unsigned cvt_pk_bf16(float lo, float hi) { unsigned r; asm volatile("v_cvt_pk_bf16_f32 %0, %1, %2" : "=v"(r) : "v"(lo), "v"(hi)); return r; }
__device__ __forceinline__ float wave_sum(float v) {
#pragma unroll
    for (int o = 1; o < 64; o <<= 1) v += __shfl_xor(v, o);
    return v;
}
__device__ __forceinline__ int lane_id() { unsigned z = 0u; asm volatile("" : "+s"(z)); return (int)__builtin_amdgcn_mbcnt_hi(~0u, __builtin_amdgcn_mbcnt_lo(~0u, z)); }
__device__ __forceinline__ float silu_f(float x) { return x / (1.f + __expf(-x)); }
namespace pg8 {
constexpr int BM = 256, BK = 64, HALF = 128, HTB = HALF * BK * 2  , STAGE_BYTES = 8 * HTB, NXCD = 8, WGM = 8;
__host__ __device__ __forceinline__ int lds_byte(int r, int c) { const int st = (r >> 4) * 2 + (c >> 5), rr = r & 15, cc = c & 31, ob = rr * 64 + cc * 2; return st * 1024 + (ob ^ (((ob >> 9) & 1) << 5)); }
__host__ __device__ __forceinline__ void stage_rc(int b, int& R, int& C) { const int st = b / 1024, sb = b % 1024, swz = sb ^ (((sb >> 9) & 1) << 5); R = (st >> 1) * 16 + swz / 64; C = (st & 1) * 32 + (swz % 64) / 2; }
__host__ __device__ __forceinline__ int perm32(int rho) { const int n = rho >> 4, i = rho & 15; return 8 * (i >> 2) + 4 * n + (i & 3); }

struct Unit { int pm, pn, e, aux; };

template <class Epi, class Sched, bool ALIGN_EPI = false>
__device__ __forceinline__ void gemm_phase(LAS unsigned char* lds, const int K, const Sched& S, const Epi& E, const int wave_id) {
    const int wid = wave_id, lane = lane_id(), tid = wid * 64 + lane, wr = wid >> 2, wc = wid & 3, fr = lane & 15, fq = lane >> 4;
    const int nt = K / BK;
    int R0, C0, R1, C1; stage_rc(tid * 16, R0, C0); stage_rc(tid * 16 + 8192, R1, C1);
    unsigned voffB[2];
    voffB[0] = (unsigned)(((R0 & ~31) + perm32(R0 & 31)) * K + C0) * 2u; voffB[1] = (unsigned)(((R1 & ~31) + perm32(R1 & 31)) * K + C1) * 2u;
    const size_t kstep = (size_t)(BK * 2);
    const size_t hstep = (size_t)HALF * K * 2;
    const unsigned ldsw = (unsigned)wid * 1024u;
    const int aoff = lds_byte(wr * 64 + fr, fq * 8), boff = lds_byte(wc * 32 + fr, fq * 8);
#define PG8_SA(b, h) (((b) * 2 + (h)) * HTB)
#define PG8_SB(b, h) ((4 + (b) * 2 + (h)) * HTB)
#define PG8_STAGE2(bufoff, gbase, v0, v1) do { \
        __builtin_amdgcn_global_load_lds((const unsigned*)((const char*)(gbase) + (v0)), (LAS unsigned*)(lds + (bufoff) + ldsw), 16, 0, 0); \
        __builtin_amdgcn_global_load_lds((const unsigned*)((const char*)(gbase) + (v1)), (LAS unsigned*)(lds + (bufoff) + ldsw + 8192), 16, 0, 0); } while (0)
#define PG8_STAGEB(bufoff, gbase) PG8_STAGE2(bufoff, gbase, voffB[0], voffB[1])
#define PG8_LDA(dst, b, h) do { _Pragma("unroll") for (int m = 0; m < 4; ++m) _Pragma("unroll") for (int k = 0; k < 2; ++k) dst[m][k] = *(const LAS bf16x8*)(lds + PG8_SA(b, h) + aoff + m * 2048 + k * 1024); } while (0)
#define PG8_LDB(dst, b, h) do { _Pragma("unroll") for (int n = 0; n < 2; ++n) _Pragma("unroll") for (int k = 0; k < 2; ++k) dst[n][k] = *(const LAS bf16x8*)(lds + PG8_SB(b, h) + boff + n * 2048 + k * 1024); } while (0)
#define PG8_MMA(ai, bj, At, Bt) do { __builtin_amdgcn_s_setprio(1); _Pragma("unroll") for (int m = 0; m < 4; ++m) _Pragma("unroll") for (int n = 0; n < 2; ++n) _Pragma("unroll") for (int k = 0; k < 2; ++k) \
        acc[ai][bj][m][n] = __builtin_amdgcn_mfma_f32_16x16x32_bf16(Bt[n][k], At[m][k], acc[ai][bj][m][n], 0, 0, 0); __builtin_amdgcn_s_setprio(0); } while (0)
#define PG8_WAIT_V(n) asm volatile("s_waitcnt vmcnt(" #n ")" ::: "memory")
#define PG8_WAIT_L(n) asm volatile("s_waitcnt lgkmcnt(" #n ")" ::: "memory")
#define PG8_BAR __builtin_amdgcn_s_barrier()
#define PG8_SCHED __builtin_amdgcn_sched_barrier(0)
    Unit cur, nxt; int ui = 0;
    if (!S.next(0, cur)) return;
    f32x4 acc[2][2][4][2];
#pragma unroll
    for (int a = 0; a < 2; ++a)
#pragma unroll
        for (int b = 0; b < 2; ++b)
#pragma unroll
            for (int m = 0; m < 4; ++m)
#pragma unroll
                for (int n = 0; n < 2; ++n) acc[a][b][m][n] = (f32x4){0.f, 0.f, 0.f, 0.f};
    bf16x8 At[4][2], B0[2][2], B1[2][2];
    unsigned cv00, cv01, cv10, cv11, nv00, nv01, nv10, nv11;
    if constexpr (Sched::GATHER) { int r0, r1, r2, r3; S.a_rows(cur, R0, R1, r0, r1, r2, r3);
        cv00 = (unsigned)(r0 * K + C0) * 2u; cv01 = (unsigned)(r1 * K + C1) * 2u; cv10 = (unsigned)(r2 * K + C0) * 2u; cv11 = (unsigned)(r3 * K + C1) * 2u;
    } else { cv00 = (unsigned)(R0 * K + C0) * 2u; cv01 = (unsigned)(R1 * K + C1) * 2u; cv10 = cv00 + (unsigned)hstep; cv11 = cv01 + (unsigned)hstep; }
    nv00 = cv00; nv01 = cv01; nv10 = cv10; nv11 = cv11;
    const char* cA = S.a_base(cur); const char* cB = S.b_base(cur);
    PG8_STAGEB(PG8_SB(0, 0), cB); PG8_STAGEB(PG8_SB(0, 1), cB + hstep); PG8_STAGE2(PG8_SA(0, 0), cA, cv00, cv01); PG8_STAGE2(PG8_SA(0, 1), cA, cv10, cv11);
    if (wr == 1) PG8_BAR;
    PG8_WAIT_V(2); PG8_BAR;
    PG8_STAGEB(PG8_SB(1, 0), cB + kstep); PG8_STAGE2(PG8_SA(1, 0), cA + kstep, cv00, cv01); PG8_STAGEB(PG8_SB(1, 1), cB + hstep + kstep);
    PG8_WAIT_V(6); PG8_BAR;
    for (;;) {
        const bool has_next = S.next(ui + 1, nxt);
        const char* nA = has_next ? S.a_base(nxt) : cA; const char* nB = has_next ? S.b_base(nxt) : cB;
        if constexpr (Sched::GATHER) { if (has_next) { int r0, r1, r2, r3; S.a_rows(nxt, R0, R1, r0, r1, r2, r3);
            nv00 = (unsigned)(r0 * K + C0) * 2u; nv01 = (unsigned)(r1 * K + C1) * 2u; nv10 = (unsigned)(r2 * K + C0) * 2u; nv11 = (unsigned)(r3 * K + C1) * 2u; } else { nv00 = cv00; nv01 = cv01; nv10 = cv10; nv11 = cv11; } }
        for (int t = 0; t < nt; t += 2) {
            const bool last = (t == nt - 2);
            const char* a1 = cA + (size_t)(t + 1) * kstep;
            const char* a2 = last ? nA : cA + (size_t)(t + 2) * kstep; const char* b2 = last ? nB : cB + (size_t)(t + 2) * kstep;
            const char* a3 = a2 + kstep; const char* b3 = b2 + kstep;
            unsigned s00 = cv00, s01 = cv01, s10 = cv10, s11 = cv11;
            if constexpr (Sched::GATHER) { if (last) { s00 = nv00; s01 = nv01; s10 = nv10; s11 = nv11; } }
            PG8_LDB(B0, 0, 0); PG8_LDB(B1, 0, 1); PG8_SCHED; PG8_LDA(At, 0, 0); PG8_STAGE2(PG8_SA(1, 1), a1, cv10, cv11);
            PG8_WAIT_V(8); PG8_WAIT_L(0); PG8_BAR; PG8_MMA(0, 0, At, B0); PG8_MMA(0, 1, At, B1); PG8_BAR; PG8_SCHED;
            PG8_LDA(At, 0, 1); PG8_STAGEB(PG8_SB(0, 0), b2); PG8_STAGEB(PG8_SB(0, 1), b2 + hstep); PG8_STAGE2(PG8_SA(0, 0), a2, s00, s01);
            PG8_WAIT_V(8); PG8_WAIT_L(0); PG8_BAR; PG8_MMA(1, 0, At, B0); PG8_MMA(1, 1, At, B1); PG8_BAR; PG8_SCHED;
            PG8_LDB(B0, 1, 0); PG8_LDB(B1, 1, 1); PG8_SCHED; PG8_LDA(At, 1, 0); PG8_STAGE2(PG8_SA(0, 1), a2, s10, s11);
            PG8_WAIT_V(8); PG8_WAIT_L(0); PG8_BAR; PG8_MMA(0, 0, At, B0); PG8_MMA(0, 1, At, B1); PG8_BAR; PG8_SCHED;
            PG8_LDA(At, 1, 1); PG8_STAGEB(PG8_SB(1, 0), b3); PG8_STAGEB(PG8_SB(1, 1), b3 + hstep); PG8_STAGE2(PG8_SA(1, 0), a3, s00, s01);
            PG8_WAIT_V(8); PG8_WAIT_L(0); PG8_BAR; PG8_MMA(1, 0, At, B0); PG8_MMA(1, 1, At, B1); PG8_BAR; PG8_SCHED;
        }
        if constexpr (ALIGN_EPI) { if (wr == 0) PG8_BAR; }
        E(acc, cur, wr, wc, fr, fq);
        if (!has_next) break;
#pragma unroll
        for (int a = 0; a < 2; ++a)
#pragma unroll
            for (int b = 0; b < 2; ++b)
#pragma unroll
                for (int m = 0; m < 4; ++m)
#pragma unroll
                    for (int n = 0; n < 2; ++n) acc[a][b][m][n] = (f32x4){0.f, 0.f, 0.f, 0.f};
        cur = nxt; cA = nA; cB = nB; ++ui; cv00 = nv00; cv01 = nv01; cv10 = nv10; cv11 = nv11;
        if constexpr (ALIGN_EPI) { if (wr == 1) PG8_BAR; }
    }
    PG8_WAIT_V(0);
    if constexpr (!ALIGN_EPI) { if (wr == 0) PG8_BAR; }
    PG8_BAR;
#undef PG8_SA
#undef PG8_SB
#undef PG8_STAGE2
#undef PG8_STAGEB
#undef PG8_LDA
#undef PG8_LDB
#undef PG8_MMA
#undef PG8_WAIT_V
#undef PG8_WAIT_L
#undef PG8_BAR
#undef PG8_SCHED
}
}
namespace pg8 {
__device__ __forceinline__ int xcd_remap(int L, int n) { const int q = n / NXCD, r = n % NXCD, xcd = L % NXCD, off = L / NXCD; return (xcd < r ? xcd * (q + 1) : r * (q + 1) + (xcd - r) * q) + off; }
struct SchedDense {
    static constexpr bool GATHER = false;
    const char* A; const char* Bt; int K; int nM, nN, nwg, G, c;
    __device__ __forceinline__ void init(const void* A_, const void* Bt_, int M, int N, int K_, int G_, int c_) { A = (const char*)A_; Bt = (const char*)Bt_; K = K_; nM = M / BM; nN = N / BM; nwg = nM * nN; G = G_; c = c_; }
    __device__ __forceinline__ bool next(int i, Unit& u) const {
        const long L = (long)i * G + c; if (L >= nwg) return false;
        int wgid = (int)L; { const int q = nwg / NXCD, r = nwg % NXCD, xcd = wgid % NXCD, off = wgid / NXCD; wgid = (xcd < r ? xcd * (q + 1) : r * (q + 1) + (xcd - r) * q) + off; }
        const int nig = WGM * nN, gid = wgid / nig, fm = gid * WGM, gsz = (nM - fm) < WGM ? (nM - fm) : WGM;
        u.pm = fm + ((wgid % nig) % gsz); u.pn = (wgid % nig) / gsz; u.e = 0; u.aux = 0; return true;
    }
    __device__ __forceinline__ const char* a_base(const Unit& u) const { return A + (size_t)u.pm * BM * K * 2; }
    __device__ __forceinline__ const char* b_base(const Unit& u) const { return Bt + (size_t)u.pn * BM * K * 2; }
    __device__ __forceinline__ void a_rows(const Unit&, int, int, int&, int&, int&, int&) const {}
};
struct SchedQkv1 {
    static constexpr bool GATHER = false;
    const char* A; const char* Bt; int K; int G, c;
    __device__ __forceinline__ bool next(int i, Unit& u) const {
        const int L0 = i * G + c; if (L0 >= 256 * 6 + 32) return false; const int L = xcd_remap(L0, 256 * 6 + 32); const int NL = 256 * 6;
        if (L < NL) { const int g = L / 48, w = L % 48; const int lt = g * 8 + (w % 8); u.pn = w / 8; u.pm = (lt / 16) * 17 + 1 + (lt % 16); u.e = 0; u.aux = 0; return true; }
        const int r = L - NL; if (r >= 32) return false;
        u.pm = (r >> 1) * 17; u.pn = 4 + (r & 1); u.e = 0; u.aux = 0; return true;
    }
    __device__ __forceinline__ const char* a_base(const Unit& u) const { return A + (size_t)u.pm * BM * K * 2; }
    __device__ __forceinline__ const char* b_base(const Unit& u) const { return Bt + (size_t)u.pn * BM * K * 2; }
    __device__ __forceinline__ void a_rows(const Unit&, int, int, int&, int&, int&, int&) const {}
};
struct SchedInProj {
    static constexpr bool GATHER = false;
    const char* H; const char* Why; const char* Watt; int G, c;
    __device__ __forceinline__ bool next(int i, Unit& u) const {
        const int L0 = i * G + c; if (L0 >= 9 * 272) return false; const int L = xcd_remap(L0, 9 * 272); const int N0 = 6 * 272;
        if (L < N0) { u.e = 0; u.pn = L / 6; u.pm = L % 6; u.aux = 0; return true; }
        const int r = L - N0; if (r >= 3 * 272) return false;
        u.e = 1; const int g = r / 24, w = r % 24; u.pm = g * 8 + (w % 8); u.pn = w / 8; u.aux = 0; return true;
    }
    __device__ __forceinline__ const char* a_base(const Unit& u) const { return (u.e == 0 ? Why : H) + (size_t)u.pm * BM * 1024 * 2; }
    __device__ __forceinline__ const char* b_base(const Unit& u) const { return (u.e == 0 ? H : Watt) + (size_t)u.pn * BM * 1024 * 2; }
    __device__ __forceinline__ void a_rows(const Unit&, int, int, int&, int&, int&, int&) const {}
};
struct SchedLat {
    static constexpr bool GATHER = false;
    const char* A; const char* Bt; int K; int nN; int G, c;
    __device__ __forceinline__ bool next(int i, Unit& u) const {
        const int L0 = i * G + c; if (L0 >= 256 * nN) return false; const int L = xcd_remap(L0, 256 * nN);
        const int per = 8 * nN; const int g = L / per, w = L % per; const int lt = g * 8 + (w % 8); u.pn = w / 8; u.pm = (lt / 16) * 17 + 1 + (lt % 16); u.e = 0; u.aux = 0; return true;
    }
    __device__ __forceinline__ const char* a_base(const Unit& u) const { return A + (size_t)u.pm * BM * K * 2; }
    __device__ __forceinline__ const char* b_base(const Unit& u) const { return Bt + (size_t)u.pn * BM * K * 2; }
    __device__ __forceinline__ void a_rows(const Unit&, int, int, int&, int&, int&, int&) const {}
};
template <bool GATH>
struct SchedMoe {
    static constexpr bool GATHER = GATH;
    const char* A; const char* W; size_t wstride; int K; const LAS int* tab; const int* tokidx; int G, c;
    __device__ __forceinline__ bool next(int i, Unit& u) const {
        const int L0 = i * G + c; const int nu = tab[32] * 4; if (L0 >= nu) return false; const int L = xcd_remap(L0, nu); const int tau = L >> 2;
        int e = 0;
#pragma unroll 1
        for (int s = 16; s >= 1; s >>= 1) if (tab[e + s] <= tau) e += s;
        u.pm = tau; u.pn = L & 3; u.e = e; u.aux = tau - tab[e]; return true;
    }
    __device__ __forceinline__ const char* a_base(const Unit& u) const { return GATH ? A : A + (size_t)u.pm * BM * K * 2; }
    __device__ __forceinline__ const char* b_base(const Unit& u) const { return W + (size_t)u.e * wstride + (size_t)u.pn * BM * K * 2; }
    __device__ __forceinline__ void a_rows(const Unit& u, int R0, int R1, int& r0, int& r1, int& r2, int& r3) const {
        const int cnt = tab[64 + u.e]; const int* ti = tokidx + (size_t)u.e * CAP; const int p = u.aux * BM;
        int p0 = p + R0, p1 = p + R1, p2 = p + 128 + R0, p3 = p + 128 + R1;
        p0 = p0 < cnt ? p0 : 0; p1 = p1 < cnt ? p1 : 0; p2 = p2 < cnt ? p2 : 0; p3 = p3 < cnt ? p3 : 0;
        r0 = ti[p0]; r1 = ti[p1]; r2 = ti[p2]; r3 = ti[p3];
    }
};

struct EpiBf16 {
    bf16* O; int ldc;
    __device__ __forceinline__ void operator()(const f32x4 (&acc)[2][2][4][2], const Unit& u, int wr, int wc, int fr, int fq) const {
        const int row0 = u.pm * BM + wr * 64 + fr, col0 = u.pn * BM + wc * 32 + 8 * fq;
#pragma unroll
        for (int ai = 0; ai < 2; ++ai)
#pragma unroll
            for (int m = 0; m < 4; ++m) { bf16* rowp = O + (size_t)(row0 + ai * HALF + m * 16) * ldc + col0;
#pragma unroll
                for (int bj = 0; bj < 2; ++bj) { const f32x4 v0 = acc[ai][bj][m][0], v1 = acc[ai][bj][m][1];
                    u32x4 w; w.x = cvt_pk_bf16(v0[0], v0[1]); w.y = cvt_pk_bf16(v0[2], v0[3]); w.z = cvt_pk_bf16(v1[0], v1[1]); w.w = cvt_pk_bf16(v1[2], v1[3]);
                    *(u32x4*)(rowp + bj * HALF) = w; } }
    }
};
template <int LAYER>
struct EpiQkv {
    bf16* O; int ldc; const f32x2* rope  ; const float* qg; const float* kg;
    __device__ __forceinline__ void operator()(const f32x4 (&acc)[2][2][4][2], const Unit& u, int wr, int wc, int fr, int fq) const {
        const bool ctx = (u.pm % 17) == 0;
        const int jrow0 = u.pm * BM + wr * 64 + fr;
        const int t0 = ((u.pm % 17) - 1) * BM + wr * 64 + fr;
#pragma unroll
        for (int bj = 0; bj < 2; ++bj) {
            int kind;
            if (LAYER == 0) kind = (u.pn < 2) ? 0 : (bj == 0 ? 1 : 2); else kind = (u.pn < 4) ? 0 : (u.pn == 4 ? 1 : 2);
            const bool l0kv = (LAYER == 0 && u.pn == 2);
            const int half = l0kv ? (wc & 1) : bj;
            const int colb = l0kv ? (u.pn * BM + bj * HALF + wc * 32) : (u.pn * BM + wc * 64 + bj * 32);
#pragma unroll
            for (int ai = 0; ai < 2; ++ai)
#pragma unroll
                for (int m = 0; m < 4; ++m) {
                    f32x4 v0 = acc[ai][bj][m][0], v1 = acc[ai][bj][m][1];
                    const int roff = ai * HALF + m * 16;
                    if (LAYER == 1 && kind != 2) {
                        const f32x4 w0 = acc[ai][bj ^ 1][m][0], w1 = acc[ai][bj ^ 1][m][1];
                        float ss = (v0[0] * v0[0] + v0[1] * v0[1]) + (v0[2] * v0[2] + v0[3] * v0[3]) + (v1[0] * v1[0] + v1[1] * v1[1]) + (v1[2] * v1[2] + v1[3] * v1[3])
                                 + (w0[0] * w0[0] + w0[1] * w0[1]) + (w0[2] * w0[2] + w0[3] * w0[3]) + (w1[0] * w1[0] + w1[1] * w1[1]) + (w1[2] * w1[2] + w1[3] * w1[3]);
                        ss += __shfl_xor(ss, 16); ss += __shfl_xor(ss, 32);
                        const float rs = rsqrtf(ss * (1.f / 64.f) + NORM_EPS);
                        const float* g = (kind == 0 ? qg : kg) + 32 * bj;
                        const f32x4 g0 = *(const f32x4*)(g + 4 * fq), g1 = *(const f32x4*)(g + 16 + 4 * fq);
                        v0 = v0 * rs * g0; v1 = v1 * rs * g1;
                    }
                    if (kind != 2 && !ctx) {
                        const int t = t0 + roff; const int pos = half == 0 ? (t >> 6) : (t & 63);
                        const f32x2* rp = rope + pos * 16 + 4 * fq;
                        f32x4 a, b;
#pragma unroll
                        for (int i = 0; i < 4; ++i) { const f32x2 cs = rp[i]; a[i] = v0[i] * cs.x - v1[i] * cs.y; b[i] = v1[i] * cs.x + v0[i] * cs.y; }
                        v0 = a; v1 = b;
                    }
                    if (kind == 0) { v0 = v0 * QSCALE; v1 = v1 * QSCALE; }
                    u32x4 w; w.x = cvt_pk_bf16(v0[0], v0[1]); w.y = cvt_pk_bf16(v0[2], v0[3]); w.z = cvt_pk_bf16(v1[0], v1[1]); w.w = cvt_pk_bf16(v1[2], v1[3]);
                    *(u32x4*)(O + (size_t)(jrow0 + roff) * ldc + colb + 8 * fq) = w;
                }
        }
    }
};
struct EpiInProj {
    EpiBf16 e0; EpiQkv<0> e1;
    __device__ __forceinline__ void operator()(const f32x4 (&acc)[2][2][4][2], const Unit& u, int wr, int wc, int fr, int fq) const { if (u.e == 0) e0(acc, u, wr, wc, fr, fq); else e1(acc, u, wr, wc, fr, fq); }
};
struct EpiOut {
    bf16* Y; const float* mod  ;
    __device__ __forceinline__ void operator()(const f32x4 (&acc)[2][2][4][2], const Unit& u, int wr, int wc, int fr, int fq) const {
        const int b = u.pm / 17, j = u.pm % 17; const bool ctx = (j == 0);
        const float* g = mod + ((size_t)(ctx ? 16 : b) * NMOD + 2) * DM;
        const int row0 = u.pm * BM + wr * 64 + fr, col0 = u.pn * BM + wc * 32 + 8 * fq;
        f32x4 gv[2][2];
#pragma unroll
        for (int bj = 0; bj < 2; ++bj)
#pragma unroll
            for (int n = 0; n < 2; ++n) gv[bj][n] = *(const f32x4*)(g + col0 + bj * HALF + 4 * n);
#pragma unroll
        for (int ai = 0; ai < 2; ++ai)
#pragma unroll
            for (int m = 0; m < 4; ++m) { bf16* rowp = Y + (size_t)(row0 + ai * HALF + m * 16) * DM + col0;
#pragma unroll
                for (int bj = 0; bj < 2; ++bj) { const f32x4 v0 = acc[ai][bj][m][0] * gv[bj][0], v1 = acc[ai][bj][m][1] * gv[bj][1];
                    u32x4 w; w.x = cvt_pk_bf16(v0[0], v0[1]); w.y = cvt_pk_bf16(v0[2], v0[3]); w.z = cvt_pk_bf16(v1[0], v1[1]); w.w = cvt_pk_bf16(v1[2], v1[3]);
                    *(u32x4*)(rowp + bj * HALF) = w; } }
    }
};
struct EpiGateUp {
    bf16* HID;
    __device__ __forceinline__ void operator()(const f32x4 (&acc)[2][2][4][2], const Unit& u, int wr, int wc, int fr, int fq) const {
        const int row0 = u.pm * BM + wr * 64 + fr, col0 = u.pn * 128 + wc * 32 + 8 * fq;
#pragma unroll
        for (int ai = 0; ai < 2; ++ai)
#pragma unroll
            for (int m = 0; m < 4; ++m) {
                const f32x4 g0 = acc[ai][0][m][0], g1 = acc[ai][0][m][1], u0 = acc[ai][1][m][0], u1 = acc[ai][1][m][1];
                float h[8];
#pragma unroll
                for (int i = 0; i < 4; ++i) { h[i] = g0[i] * __builtin_amdgcn_rcpf(1.f + __builtin_amdgcn_exp2f(-LOG2E * g0[i])) * u0[i]; h[4 + i] = g1[i] * __builtin_amdgcn_rcpf(1.f + __builtin_amdgcn_exp2f(-LOG2E * g1[i])) * u1[i]; }
                u32x4 w; w.x = cvt_pk_bf16(h[0], h[1]); w.y = cvt_pk_bf16(h[2], h[3]); w.z = cvt_pk_bf16(h[4], h[5]); w.w = cvt_pk_bf16(h[6], h[7]);
                *(u32x4*)(HID + (size_t)(row0 + ai * HALF + m * 16) * DEXP + col0) = w; }
    }
};
struct EpiDown {
    bf16* MOUT; const float* gate; const LAS int* tab;
    __device__ __forceinline__ void operator()(const f32x4 (&acc)[2][2][4][2], const Unit& u, int wr, int wc, int fr, int fq) const {
        const int r0 = wr * 64 + fr, col0 = u.pn * BM + wc * 32 + 8 * fq; const int cnt = tab[64 + u.e]; const float* gp = gate + (size_t)u.e * CAP;
#pragma unroll
        for (int ai = 0; ai < 2; ++ai)
#pragma unroll
            for (int m = 0; m < 4; ++m) { const int r = r0 + ai * HALF + m * 16; const int pos = u.aux * BM + r; const float gt = pos < cnt ? gp[pos] : 0.f;
                bf16* rowp = MOUT + (size_t)(u.pm * BM + r) * DM + col0;
#pragma unroll
                for (int bj = 0; bj < 2; ++bj) { const f32x4 v0 = acc[ai][bj][m][0] * gt, v1 = acc[ai][bj][m][1] * gt;
                    u32x4 w; w.x = cvt_pk_bf16(v0[0], v0[1]); w.y = cvt_pk_bf16(v0[2], v0[3]); w.z = cvt_pk_bf16(v1[0], v1[1]); w.w = cvt_pk_bf16(v1[2], v1[3]);
                    *(u32x4*)(rowp + bj * HALF) = w; } }
    }
};
}
namespace attn_body {
using bf16=__hip_bfloat16;
using bf16x8=__attribute__((ext_vector_type(8)))short;
using s16x4=__attribute__((ext_vector_type(4)))short;
using f32x16=__attribute__((ext_vector_type(16)))float;
using u32x4=__attribute__((ext_vector_type(4)))unsigned;
constexpr int D=64;
constexpr int NW=8,QBLK=32,QB=QBLK*NW,KVBLK=64;
__device__ __forceinline__ int crow(int r,int hi){return (r&3)+8*(r>>2)+4*hi;}
#define SBAR() __builtin_amdgcn_sched_barrier(0)
__device__ __forceinline__ void swamask(f32x16&p0,f32x16&p1,int d0){
  const float NEG=-INFINITY;
  #pragma unroll
  for(int r=0;r<16;++r){const int d=d0+(r&3)+8*(r>>2); if((unsigned)(d+128)>256u)p0[r]=NEG; if((unsigned)(d+160)>256u)p1[r]=NEG;}
}

constexpr int NSLOT=3, SLOTB=8192;
constexpr int LDS_K=0, LDS_V=NSLOT*SLOTB, LDS_WS=2*NSLOT*SLOTB, LDS_OST=LDS_WS+NW*64*4, LDS_BYTES=LDS_OST+NW*4096;
constexpr float C2=0.125f*1.4426950408889634f;
__device__ __forceinline__ void glds16(const void*gsrc,unsigned lds_dst){unsigned keep;
  asm volatile("s_mov_b32 %0, m0\n\ts_mov_b32 m0, %2\n\ts_nop 0\n\tglobal_load_lds_dwordx4 %1, off\n\ts_mov_b32 m0, %0":"=&s"(keep):"v"(gsrc),"s"(lds_dst):"memory");}
__device__ __forceinline__ float max3f(float a,float b,float c){float r;asm("v_max3_f32 %0, %1, %2, %3":"=v"(r):"v"(a),"v"(b),"v"(c));return r;}
__device__ __forceinline__ float max2f(float a,float b){float r;asm("v_max_f32_e32 %0, %1, %2":"=v"(r):"v"(a),"v"(b));return r;}
__device__ __forceinline__ float fadd_s(float a,float b){float r;asm("v_add_f32_e32 %0, %1, %2":"=v"(r):"v"(a),"v"(b));return r;}
__device__ __forceinline__ float fsub_s(float a,float b){float r;asm("v_sub_f32_e32 %0, %1, %2":"=v"(r):"v"(a),"v"(b));return r;}
typedef float f32x2_t __attribute__((ext_vector_type(2))); typedef __bf16 bf16x2_t __attribute__((ext_vector_type(2)));
__device__ __forceinline__ unsigned cvtpk_s(float lo,float hi){f32x2_t v={lo,hi};bf16x2_t b=__builtin_convertvector(v,bf16x2_t);return __builtin_bit_cast(unsigned,b);}
#define WAIT_BAR(N) asm volatile("s_waitcnt vmcnt(" #N ") lgkmcnt(0)\n\ts_barrier":::"memory")

__device__ __forceinline__ void qkt(f32x16&p0,f32x16&p1,const char*Kslot,const bf16x8*qr,const f32x16&negm,int r32,int hi){
  const char*kb=Kslot+hi*1024+r32*16;
  #pragma unroll
  for(int d0=0;d0<4;++d0){
    const bf16x8 b0=*reinterpret_cast<const bf16x8*>(kb+d0*2048);
    const bf16x8 b1=*reinterpret_cast<const bf16x8*>(kb+d0*2048+512);
    if(d0==0){p0=__builtin_amdgcn_mfma_f32_32x32x16_bf16(b0,qr[0],negm,0,0,0);p1=__builtin_amdgcn_mfma_f32_32x32x16_bf16(b1,qr[0],negm,0,0,0);}
    else{p0=__builtin_amdgcn_mfma_f32_32x32x16_bf16(b0,qr[d0],p0,0,0,0);p1=__builtin_amdgcn_mfma_f32_32x32x16_bf16(b1,qr[d0],p1,0,0,0);}}
}
typedef __attribute__((address_space(3))) const char* lds_cptr;
typedef short v4i16_t __attribute__((ext_vector_type(4)));
__device__ __forceinline__ void kload8(bf16x8*kf,lds_cptr kp){
  kf[0]=*(const __attribute__((address_space(3))) bf16x8*)(kp);      kf[1]=*(const __attribute__((address_space(3))) bf16x8*)(kp+512);
  kf[2]=*(const __attribute__((address_space(3))) bf16x8*)(kp+2048); kf[3]=*(const __attribute__((address_space(3))) bf16x8*)(kp+2560);
  kf[4]=*(const __attribute__((address_space(3))) bf16x8*)(kp+4096); kf[5]=*(const __attribute__((address_space(3))) bf16x8*)(kp+4608);
  kf[6]=*(const __attribute__((address_space(3))) bf16x8*)(kp+6144); kf[7]=*(const __attribute__((address_space(3))) bf16x8*)(kp+6656);
}
__device__ __forceinline__ void kload2(bf16x8*kf,lds_cptr kp,int j){ kf[2*j]=*(const __attribute__((address_space(3))) bf16x8*)(kp+j*2048); kf[2*j+1]=*(const __attribute__((address_space(3))) bf16x8*)(kp+j*2048+512); }
__device__ __forceinline__ s16x4 vtr(lds_cptr p){ return __builtin_bit_cast(s16x4,__builtin_amdgcn_ds_read_tr16_b64_v4i16((__attribute__((address_space(3))) v4i16_t*)p)); }
__device__ __forceinline__ float rowmax(const f32x16&p0,const f32x16&p1){
  float a=max3f(p0[0],p0[1],p1[0]),b=max3f(p0[2],p0[3],p1[1]);a=max3f(a,p1[2],p1[3]);
  #pragma unroll
  for(int r=4;r<16;r+=4){a=max3f(a,p0[r],p0[r+1]);b=max3f(b,p0[r+2],p0[r+3]);a=max3f(a,p1[r],p1[r+1]);b=max3f(b,p1[r+2],p1[r+3]);}
  const float m=max2f(a,b);
  auto rr=__builtin_amdgcn_permlane32_swap(__float_as_uint(m),__float_as_uint(m),false,false);
  return max2f(__uint_as_float(rr[0]),__uint_as_float(rr[1]));
}
__device__ __forceinline__ void pv(f32x16*o,int vb,bf16x8 pa0,bf16x8 pa1,bf16x8 pa2,bf16x8 pa3){
  #pragma unroll
  for(int d0=0;d0<2;++d0){s16x4 lo[4],hi[4];
    #pragma unroll
    for(int ks=0;ks<4;++ks){
      asm volatile("ds_read_b64_tr_b16 %0,%1 offset:%c2":"=&v"(lo[ks]):"v"(vb),"i"(d0*4096+ks*1024):"memory");
      asm volatile("ds_read_b64_tr_b16 %0,%1 offset:%c2":"=&v"(hi[ks]):"v"(vb),"i"(d0*4096+ks*1024+512):"memory");}
    asm volatile("s_waitcnt lgkmcnt(0)":::"memory");SBAR();
    #define PK(k) (bf16x8){lo[k][0],lo[k][1],lo[k][2],lo[k][3],hi[k][0],hi[k][1],hi[k][2],hi[k][3]}
    o[d0]=__builtin_amdgcn_mfma_f32_32x32x16_bf16(pa0,PK(0),o[d0],0,0,0);
    o[d0]=__builtin_amdgcn_mfma_f32_32x32x16_bf16(pa1,PK(1),o[d0],0,0,0);
    o[d0]=__builtin_amdgcn_mfma_f32_32x32x16_bf16(pa2,PK(2),o[d0],0,0,0);
    o[d0]=__builtin_amdgcn_mfma_f32_32x32x16_bf16(pa3,PK(3),o[d0],0,0,0);
    #undef PK
  }
}

#ifndef ATTN_STORE16
#define ATTN_STORE16(p,v) (*(u32x4*)(p)=(v))
#endif
template<int MODE,int QP,int KP,int OP,int THRL,bool FIXM=false> __device__ __forceinline__ void attn_unit(const bf16*Qu,const bf16*__restrict__ Kh,const bf16*__restrict__ Vh,bf16*Ou,int NT,int lat0,int tq0,float sinkl2,char*shm,const int wave_id,const float m0fix,const bool pre,const bool has_next,const bf16*__restrict__ Kh_n,const bf16*__restrict__ Vh_n,const bool unused_=false){
  const int wid=wave_id,lane=lane_id(),r32=lane&31,hi=lane>>5;
  const bf16*Qw=Qu+(long)(wid*QBLK)*QP;
  const unsigned lds0=(unsigned)(uintptr_t)shm;
  float*wsf=(float*)(shm+LDS_WS)+wid*64;
  const bf16*ksrc=Kh+(long)lane*KP+wid*8;
  const bf16*vsrc=Vh+(long)(16*(wid&3)+(lane>>2))*KP+(wid>>2)*32+(lane&3)*8;
  #define KROW(t) ((long)(64*(t)+(((t)>=4)?lat0:0)))
  const unsigned kdst=lds0+LDS_K+wid*1024, vdst=lds0+LDS_V+wid*1024;
  #define DMA_K(t,slot) glds16(ksrc+KROW(t)*KP,(unsigned)__builtin_amdgcn_readfirstlane(kdst+(slot)))
  #define DMA_V(t,slot) glds16(vsrc+KROW(t)*KP,(unsigned)__builtin_amdgcn_readfirstlane(vdst+(slot)))
  const int vb0=(int)(lds0+LDS_V)+((lane>>4)&1)*32+(lane&3)*8+(4*hi+((lane&15)>>2))*64;
  const char*Kbase=shm+LDS_K; bf16x8 kf[8];
  const lds_cptr shm3=(lds_cptr)shm; const lds_cptr kp0=shm3+LDS_K+hi*1024+r32*16; const lds_cptr vp0=shm3+LDS_V+((lane>>4)&1)*32+(lane&3)*8+(4*hi+((lane&15)>>2))*64;
  if(!pre){DMA_K(0,0);DMA_V(0,0);DMA_K(1,SLOTB);}
  bf16x8 qr[4];
  #pragma unroll
  for(int d0=0;d0<4;++d0)qr[d0]=*reinterpret_cast<const bf16x8*>(&Qw[(long)r32*QP+d0*16+hi*8]);
  float mhat=0.f,l_reg=0.f;f32x16 o[2];o[0]=f32x16{};o[1]=f32x16{};f32x16 negm=f32x16{};
  if(FIXM){mhat=m0fix;
    #pragma unroll
    for(int r=0;r<16;++r)negm[r]=-m0fix;}
  asm volatile("":"+v"(negm));
  const int qrel=wid*QBLK+r32;
  const int mq=4*hi-(tq0+qrel)+lat0-256;
  #define CMASK(P0,P1,t) do{ if(MODE==1 && (t)>=4) swamask(P0,P1,mq+64*(t)); }while(0)
  bool resc=false;
  #define START(P0,P1) do{ resc=false; \
    if(!FIXM){ const float rm=rowmax(P0,P1); const float dl=rm; mhat=fadd_s(mhat,dl); \
      _Pragma("unroll") for(int r=0;r<16;++r){P0[r]=fsub_s(P0[r],dl);P1[r]=fsub_s(P1[r],dl);} \
      _Pragma("unroll") for(int r=0;r<16;++r)negm[r]=-mhat; asm volatile("":"+v"(negm)); } \
    _Pragma("unroll") for(int r=0;r<16;++r)P0[r]=__builtin_amdgcn_exp2f(P0[r]); }while(0)
  #define RESC() do{ if(resc){ asm volatile("s_waitcnt lgkmcnt(0)":::"memory"); \
      _Pragma("unroll") for(int d_=0;d_<2;++d_) _Pragma("unroll") for(int r=0;r<16;++r)o[d_][r]*=wsf[crow(r,hi)]; } }while(0)
  f32x16 pA0,pA1,pB0,pB1;
  int sl_prev=0,sl_cur=0,sl_next=SLOTB;
  #define ROT() do{sl_prev=sl_cur;sl_cur=sl_next;sl_next=(sl_next==(NSLOT-1)*SLOTB)?0:sl_next+SLOTB;}while(0)
  DMA_K(2,2*SLOTB);
  WAIT_BAR(3);
  qkt(pA0,pA1,Kbase,qr,negm,r32,hi);asm volatile("s_nop 15\n\ts_nop 7":"+v"(pA0),"+v"(pA1));CMASK(pA0,pA1,0);
  START(pA0,pA1);
  _Pragma("unroll") for(int r=0;r<16;++r)pA1[r]=__builtin_amdgcn_exp2f(pA1[r]);
  WAIT_BAR(0);
  DMA_K(3,0);DMA_V(1,SLOTB);
  ROT();
  kload8(kf,kp0+sl_cur);
  WAIT_BAR(2);
  s16x4 vlo[8],vhi[8]; u32x4 pw0,pw1,pw2,pw3;
  #define PKW(P,B) cvtpk_s(P[B],P[B+1])
  #define PAF(k) __builtin_bit_cast(bf16x8,pw##k)
  #define VFR(i) (bf16x8){vlo[i][0],vlo[i][1],vlo[i][2],vlo[i][3],vhi[i][0],vhi[i][1],vhi[i][2],vhi[i][3]}
  #define PIN(x) asm volatile("":"+v"(x))
  #define MX3(a,b,c) __builtin_fmaxf(__builtin_fmaxf((a),(b)),(c))
  #define GAPA(MF,A0,A1,A2,A3,W0,W1,PW) do{ MF; sacc+=A0; sacc+=A1; sacc+=A2; sacc+=A3; PIN(sacc); W0; W1; PIN(PW); SBAR(); }while(0)
  #define EX(v) __builtin_amdgcn_exp2f(v)
  #define GAPB(MF,X,B) do{ MF; X[B]=EX(X[B]); X[B+1]=EX(X[B+1]); X[B+2]=EX(X[B+2]); X[B+3]=EX(X[B+3]); PIN(X); SBAR(); }while(0)
  #define VRD(i) do{ vlo[i]=vtr(vp_+(((i)>>2)*4096+((i)&3)*1024)); vhi[i]=vtr(vp_+(((i)>>2)*4096+((i)&3)*1024+512)); }while(0)
  #define KRD(G,j) do{ if(G){ kload2(kf,kp0+sl_next,j); SBAR(); } }while(0)
  #define STEP(C0,C1,P0,P1,t,GK,GV,GL) do{ SBAR(); \
    const lds_cptr vp_=vp0+sl_prev; \
    VRD(0); SBAR(); float sacc=(P0[0]+P0[1]); \
    GAPA(C0=__builtin_amdgcn_mfma_f32_32x32x16_bf16(kf[0],qr[0],negm,0,0,0), P0[2],P0[3],P0[4],P0[5],     pw0[0]=PKW(P0,0), pw0[1]=PKW(P0,2), pw0); \
    VRD(4); SBAR(); GAPA(C1=__builtin_amdgcn_mfma_f32_32x32x16_bf16(kf[1],qr[0],negm,0,0,0), P0[6],P0[7],P0[8],P0[9],     pw0[2]=PKW(P0,4), pw0[3]=PKW(P0,6), pw0); \
    VRD(1); SBAR(); GAPA(C0=__builtin_amdgcn_mfma_f32_32x32x16_bf16(kf[2],qr[1],C0,0,0,0),   P0[10],P0[11],P0[12],P0[13], pw1[0]=PKW(P0,8), pw1[1]=PKW(P0,10), pw1); \
    VRD(5); SBAR(); GAPA(C1=__builtin_amdgcn_mfma_f32_32x32x16_bf16(kf[3],qr[1],C1,0,0,0),   P0[14],P0[15],P1[0],P1[1],   pw1[2]=PKW(P0,12),pw1[3]=PKW(P0,14), pw1); \
    VRD(2); SBAR(); GAPA(C0=__builtin_amdgcn_mfma_f32_32x32x16_bf16(kf[4],qr[2],C0,0,0,0),   P1[2],P1[3],P1[4],P1[5],     pw2[0]=PKW(P1,0), pw2[1]=PKW(P1,2), pw2); \
    VRD(6); SBAR(); GAPA(C1=__builtin_amdgcn_mfma_f32_32x32x16_bf16(kf[5],qr[2],C1,0,0,0),   P1[6],P1[7],P1[8],P1[9],     pw2[2]=PKW(P1,4), pw2[3]=PKW(P1,6), pw2); \
    VRD(3); SBAR(); GAPA(C0=__builtin_amdgcn_mfma_f32_32x32x16_bf16(kf[6],qr[3],C0,0,0,0),   P1[10],P1[11],P1[12],P1[13], pw3[0]=PKW(P1,8), pw3[1]=PKW(P1,10), pw3); \
    VRD(7); SBAR(); GAPA(C1=__builtin_amdgcn_mfma_f32_32x32x16_bf16(kf[7],qr[3],C1,0,0,0),   P1[14],P1[15],0.f,0.f,       pw3[2]=PKW(P1,12),pw3[3]=PKW(P1,14), pw3); \
    l_reg+=sacc; \
    if(GK){DMA_K((t)+3,sl_cur);} if(GV){DMA_V((t)+1,sl_next);} \
    CMASK(C0,C1,t); \
    if(!FIXM){ float a=MX3(C0[0],C0[1],C1[0]),b=MX3(C0[2],C0[3],C1[1]); a=MX3(a,C1[2],C1[3]); \
      _Pragma("unroll") for(int r=4;r<16;r+=4){a=MX3(a,C0[r],C0[r+1]);b=MX3(b,C0[r+2],C0[r+3]);a=MX3(a,C1[r],C1[r+1]);b=MX3(b,C1[r+2],C1[r+3]);} \
      float rm=__builtin_fmaxf(a,b); { auto rr=__builtin_amdgcn_permlane32_swap(__float_as_uint(rm),__float_as_uint(rm),false,false); rm=__builtin_fmaxf(__uint_as_float(rr[0]),__uint_as_float(rr[1])); } \
      resc=false; \
      if(__builtin_expect(__any(rm>(float)THRL),0)){ const float dl=__builtin_fmaxf(rm,0.f); mhat+=dl; \
        _Pragma("unroll") for(int r=0;r<16;++r){C0[r]-=dl;C1[r]-=dl;} \
        _Pragma("unroll") for(int r=0;r<16;++r)negm[r]=-mhat; asm volatile("":"+v"(negm)); \
        const float f=__builtin_amdgcn_exp2f(-dl); l_reg*=f; if(hi==0)wsf[r32]=f; resc=true; } } \
    SBAR(); \
    GAPB(o[0]=__builtin_amdgcn_mfma_f32_32x32x16_bf16(PAF(0),VFR(0),o[0],0,0,0), C0,0); \
    GAPB(o[1]=__builtin_amdgcn_mfma_f32_32x32x16_bf16(PAF(0),VFR(4),o[1],0,0,0), C0,4); \
    KRD(GL,0); GAPB(o[0]=__builtin_amdgcn_mfma_f32_32x32x16_bf16(PAF(1),VFR(1),o[0],0,0,0), C0,8); \
    KRD(GL,1); GAPB(o[1]=__builtin_amdgcn_mfma_f32_32x32x16_bf16(PAF(1),VFR(5),o[1],0,0,0), C0,12); \
    KRD(GL,2); GAPB(o[0]=__builtin_amdgcn_mfma_f32_32x32x16_bf16(PAF(2),VFR(2),o[0],0,0,0), C1,0); \
    KRD(GL,3); GAPB(o[1]=__builtin_amdgcn_mfma_f32_32x32x16_bf16(PAF(2),VFR(6),o[1],0,0,0), C1,4); \
    GAPB(o[0]=__builtin_amdgcn_mfma_f32_32x32x16_bf16(PAF(3),VFR(3),o[0],0,0,0), C1,8); \
    GAPB(o[1]=__builtin_amdgcn_mfma_f32_32x32x16_bf16(PAF(3),VFR(7),o[1],0,0,0), C1,12); \
    }while(0)
  int t=1;
  for(;t+5<NT;t+=2){
    STEP(pB0,pB1,pA0,pA1,t,true,true,true);     WAIT_BAR(2); RESC(); ROT();
    STEP(pA0,pA1,pB0,pB1,t+1,true,true,true);   WAIT_BAR(2); RESC(); ROT();
  }
  #define ENDW(tt) do{ if((tt)+3<NT){WAIT_BAR(2);} else if((tt)+2<NT){WAIT_BAR(1);} else {WAIT_BAR(0);} }while(0)
  for(;t+1<NT;t+=2){
    STEP(pB0,pB1,pA0,pA1,t,(t+3<NT),(t+1<NT),(t+1<NT));       ENDW(t);   RESC(); ROT();
    STEP(pA0,pA1,pB0,pB1,t+1,(t+4<NT),(t+2<NT),(t+2<NT));     ENDW(t+1); RESC(); ROT();
  }
  STEP(pB0,pB1,pA0,pA1,NT-1,false,false,false); RESC();
  { float sacc=pB0[0]+pB0[1]; _Pragma("unroll") for(int r=2;r<16;++r)sacc+=pB0[r]; _Pragma("unroll") for(int r=0;r<16;++r)sacc+=pB1[r]; l_reg+=sacc;
    pw0=(u32x4){PKW(pB0,0),PKW(pB0,2),PKW(pB0,4),PKW(pB0,6)};pw1=(u32x4){PKW(pB0,8),PKW(pB0,10),PKW(pB0,12),PKW(pB0,14)};pw2=(u32x4){PKW(pB1,0),PKW(pB1,2),PKW(pB1,4),PKW(pB1,6)};pw3=(u32x4){PKW(pB1,8),PKW(pB1,10),PKW(pB1,12),PKW(pB1,14)};
    SBAR(); pv(o,vb0+sl_cur,PAF(0),PAF(1),PAF(2),PAF(3)); }
  #undef PKW
  #undef PAF
  #undef VFR
  #undef PIN
  #undef MX3
  #undef GAPA
  #undef GAPB
  #undef EX
  #undef VRD
  #undef KRD
  #undef STEP
  #undef ENDW
  asm volatile("s_waitcnt lgkmcnt(0)\n\ts_barrier":::"memory");
  if(has_next){ const bf16*ksn=Kh_n+(long)lane*KP+wid*8; const bf16*vsn=Vh_n+(long)(16*(wid&3)+(lane>>2))*KP+(wid>>2)*32+(lane&3)*8;
    glds16(ksn,(unsigned)__builtin_amdgcn_readfirstlane(kdst)); glds16(vsn,(unsigned)__builtin_amdgcn_readfirstlane(vdst)); glds16(ksn+(long)64*KP,(unsigned)__builtin_amdgcn_readfirstlane(kdst+SLOTB));
 }
  {auto rr=__builtin_amdgcn_permlane32_swap(__float_as_uint(l_reg),__float_as_uint(l_reg),false,false);l_reg=__uint_as_float(rr[0])+__uint_as_float(rr[1]);}
  l_reg+=__builtin_amdgcn_exp2f(sinkl2-mhat);
  if(hi==0)wsf[32+r32]=l_reg;asm volatile("s_waitcnt lgkmcnt(0)":::"memory");
  float rli[16];
  #pragma unroll
  for(int r=0;r<16;++r)rli[r]=__builtin_amdgcn_rcpf(wsf[32+crow(r,hi)]);
  bf16*Ow=Ou+(long)(wid*QBLK)*OP;
  { bf16*stg=(bf16*)(shm+LDS_OST)+wid*2048;
    #pragma unroll
    for(int r=0;r<16;++r){const int orow=crow(r,hi);
      #pragma unroll
      for(int d0=0;d0<2;++d0)stg[orow*64+d0*32+r32]=__float2bfloat16(o[d0][r]*rli[r]);}
    asm volatile("s_waitcnt lgkmcnt(0)":::"memory");
    #pragma unroll
    for(int i=0;i<4;++i){const int row=i*8+(lane>>3),ch=lane&7; const u32x4 v=*(const u32x4*)(stg+row*64+ch*8); ATTN_STORE16(Ow+(long)row*OP+ch*8,v);} }
  asm volatile("s_waitcnt lgkmcnt(0)":::"memory");
  #undef DMA_K
  #undef KROW
  #undef DMA_V
  #undef CMASK
  #undef START
  #undef RESC
  #undef ROT
}
constexpr int ATTN_LDS_BYTES=LDS_BYTES;
#undef SBAR
#undef WAIT_BAR
}
#define XB_TMO      128
#define XB_XCNT(j)  (256  + 64 * (j))
#define XB_XSUB(j)  (1280 + 64 * (j))
#define XB_XGEN(j)  (2304 + 64 * (j))
#define XB_TOP      3328
#define XB_TOPGEN   3392
#define XCD_BAR_WORDS 3456
#define XB_SPIN_CAP (1u << 18)

__device__ __forceinline__ unsigned xb_ld(unsigned* p)              { return __hip_atomic_load(p, __ATOMIC_RELAXED, __HIP_MEMORY_SCOPE_AGENT); }
__device__ __forceinline__ unsigned xb_add(unsigned* p, unsigned v) { return __hip_atomic_fetch_add(p, v, __ATOMIC_RELAXED, __HIP_MEMORY_SCOPE_AGENT); }
__device__ __forceinline__ unsigned xb_xcc_id() { return (unsigned)__builtin_amdgcn_s_getreg((3 << 11) | 20) & 0xFu; }
#define XB_SPIN(cond, bar) do { unsigned _sp = 0; while (cond) { __builtin_amdgcn_s_sleep(1); \
    if ((++_sp & 255u) == 0u) { if (xb_ld(&(bar)[XB_TMO])) break; if (_sp > XB_SPIN_CAP) { atomicAdd(&(bar)[XB_TMO], 1u); break; } } } } while (0)

struct XcdBarrier {
    unsigned* bar; unsigned x;
    volatile LAS unsigned* st;
};

__device__ __forceinline__ XcdBarrier xcd_barrier_post(unsigned* bar, volatile LAS unsigned* st, const bool t0) {
    XcdBarrier b; b.bar = bar; b.x = xb_xcc_id(); b.st = st;
    if (t0) (void)xb_add(&bar[XB_XCNT(b.x)], 1u);
    return b;
}
__device__ __forceinline__ void xcd_barrier_complete(unsigned* bar, unsigned x, unsigned& nloc, unsigned& nx) {
    const unsigned G = gridDim.x * gridDim.y * gridDim.z;
    unsigned sum, cnt, mine, sp = 0u;
    for (;;) {
        sum = 0u; cnt = 0u; mine = 0u;
#pragma unroll
        for (unsigned j = 0; j < 16; ++j) { const unsigned c = xb_ld(&bar[XB_XCNT(j)]); sum += c; cnt += (c > 0u) ? 1u : 0u; mine = (j == x) ? c : mine; }
        if (sum == G) break;
        __builtin_amdgcn_s_sleep(1);
        if ((++sp & 255u) == 0u) { if (xb_ld(&bar[XB_TMO])) break; if (sp > XB_SPIN_CAP) { atomicAdd(&bar[XB_TMO], 1u); break; } }
    }
    nloc = mine > 0u ? mine : 1u; nx = cnt > 0u ? cnt : 1u;
}

__device__ __forceinline__ void xcd_barrier(const XcdBarrier& b, const bool t0) {
    asm volatile("s_waitcnt vmcnt(0)" ::: "memory");
    __syncthreads();
    if (t0) {
        unsigned* bar = b.bar;
        __builtin_amdgcn_s_waitcnt(0);
        unsigned nloc = b.st[0], nx = b.st[1];
        if (nloc == 0u) { xcd_barrier_complete(bar, b.x, nloc, nx); b.st[0] = nloc; b.st[1] = nx; }
        const unsigned old = xb_add(&bar[XB_XSUB(b.x)], 1u);
        const unsigned gen = old / nloc;
        if (old + 1u == (gen + 1u) * nloc) {
            __builtin_amdgcn_fence(__ATOMIC_RELEASE, "agent");
            asm volatile("s_waitcnt vmcnt(0)" ::: "memory");
            const unsigned og = xb_add(&bar[XB_TOP], 1u);
            const unsigned tg = og / nx;
            if (og + 1u == (tg + 1u) * nx) xb_add(&bar[XB_TOPGEN], 1u);
            else XB_SPIN(xb_ld(&bar[XB_TOPGEN]) == tg, bar);
            __builtin_amdgcn_fence(__ATOMIC_ACQUIRE, "agent");
            xb_add(&bar[XB_XGEN(b.x)], 1u);
            asm volatile("s_waitcnt vmcnt(0)" ::: "memory");
        } else {
            XB_SPIN(xb_ld(&bar[XB_XGEN(b.x)]) == gen, bar);
            __builtin_amdgcn_fence(__ATOMIC_ACQUIRE, "agent");
            asm volatile("s_waitcnt vmcnt(0)" ::: "memory");
        }
    }
    __syncthreads();
}
constexpr int NWAVES = 8, NTHR = 512;
struct Args { const float* in[32]; float* out; unsigned char* ws; int ph_lo, ph_hi, one_launch, pad; };
enum InIdx { I_X = 0, I_C, I_CTX, I_CCTX, I_ADAW, I_ADAB, I_N1G, I_N2G, I_EVWIN, I_EVWOUT, I_HYCW, I_HYCB, I_HYW1, I_HYB1, I_HYW2, I_HYB2, I_HYW3, I_HYFREQ, I_HYSKIP, I_SINK,
             I_ODWQKV, I_ODWOUT, I_ODQG, I_ODKG, I_RTGW, I_RTGB, I_RTEW, I_RTEB, I_MOEG, I_MOEU, I_MOED, I_FNG };
struct Frame {
    LAS unsigned char* lds; int wave, G, bid;
    unsigned char* ws; gu32* ctl;
};
struct TItem { const float* src; int ldw; bf16* WT; int Kd, drow0, drow1, k0; bool perm; };
__device__ __forceinline__ int qkv_drow(int n) { const int pn = n >> 8, rem = n & 255; return 256 * pn + 128 * ((rem & 63) >> 5) + 32 * (rem >> 6); }
__device__ __forceinline__ TItem decode_item(const Args& a, unsigned char* ws, int it) {
    constexpr int S1 = 16 * 24, S2 = S1 + 16 * 12, S3 = S2 + 16 * 16, S4 = S3 + 16 * 24, S5 = S4 + 16 * 16;
    TItem t; t.perm = false;
    if (it < S1) { const int kb = it / 24, nb = it % 24, n = 64 * nb; t.src = a.in[I_EVWIN] + (size_t)(64 * kb) * D_IN_EVEN + n; t.ldw = D_IN_EVEN; t.WT = (bf16*)(ws + WS_WHY); t.Kd = 1024; t.drow0 = n; t.drow1 = n + 32; t.k0 = 64 * kb; }
    else if (it < S2) { const int r = it - S1, kb = r / 12, nb = r % 12, n = 64 * nb;
        if (n < 512) { t.drow0 = qkv_drow(n); t.drow1 = qkv_drow(n + 32); t.perm = true; } else { t.drow0 = n; t.drow1 = n + 32; t.perm = n < 640; }
        t.src = a.in[I_EVWIN] + (size_t)(64 * kb) * D_IN_EVEN + 1536 + n; t.ldw = D_IN_EVEN; t.WT = (bf16*)(ws + WS_WATT0); t.Kd = 1024; t.k0 = 64 * kb; }
    else if (it < S3) { const int r = it - S2, kb = r / 16, nb = r % 16, n = 64 * nb; t.src = a.in[I_EVWOUT] + (size_t)(64 * kb) * 1024 + n; t.ldw = 1024; t.WT = (bf16*)(ws + WS_WOUT0); t.Kd = 1024; t.drow0 = n; t.drow1 = n + 32; t.k0 = 64 * kb; }
    else if (it < S4) { const int r = it - S3, kb = r / 24, nb = r % 24, n = 64 * nb;
        t.src = a.in[I_ODWQKV] + (size_t)(64 * kb) * D_QKV1 + n; t.ldw = D_QKV1; t.WT = (bf16*)(ws + WS_WQKV1); t.Kd = 1024; t.drow0 = qkv_drow(n); t.drow1 = qkv_drow(n + 32); t.k0 = 64 * kb; t.perm = n < 1280; }
    else if (it < S5) { const int r = it - S4, kb = r / 16, nb = r % 16, n = 64 * nb; t.src = a.in[I_ODWOUT] + (size_t)(64 * kb) * 1024 + n; t.ldw = 1024; t.WT = (bf16*)(ws + WS_WOUT1); t.Kd = 1024; t.drow0 = n; t.drow1 = n + 32; t.k0 = 64 * kb; }
    else { const int r = it - S5, le = r / 384, sub = r % 384;
        if (sub < 256) { const int up = sub >> 7, s2 = sub & 127, kb = s2 >> 3, nb = s2 & 7, n = 64 * nb;
            t.src = a.in[up ? I_MOEU : I_MOEG] + (size_t)le * 1024 * 512 + (size_t)(64 * kb) * 512 + n; t.ldw = 512; t.WT = (bf16*)(ws + WS_WGU) + (size_t)le * 1024 * 1024; t.Kd = 1024;
            t.drow0 = 256 * (n >> 7) + (n & 127) + 128 * up; t.drow1 = t.drow0 + 32; t.k0 = 64 * kb; }
        else { const int s2 = sub - 256, kb = s2 >> 4, nb = s2 & 15, n = 64 * nb;
            t.src = a.in[I_MOED] + (size_t)le * 512 * 1024 + (size_t)(64 * kb) * 1024 + n; t.ldw = 1024; t.WT = (bf16*)(ws + WS_WDN) + (size_t)le * 1024 * 512; t.Kd = 512; t.drow0 = n; t.drow1 = n + 32; t.k0 = 64 * kb; } }
    return t;
}
__device__ __forceinline__ int pinv32(int j) { return j < 16 ? 8 * (j >> 2) + (j & 3) : 8 * ((j - 16) >> 2) + 4 + ((j - 16) & 3); }
struct TRegs { float v[64]; };
__device__ __forceinline__ TRegs titem_load(const TItem& t, int lane) { TRegs r; const float* p = t.src + lane;
#pragma unroll
    for (int i = 0; i < 64; ++i) r.v[i] = __builtin_nontemporal_load(p + (size_t)i * t.ldw);
    return r; }
__device__ __forceinline__ void titem_store(const TItem& t, const TRegs& r, LAS float* scr, int lane) {
#pragma unroll
    for (int i = 0; i < 64; ++i) scr[i * 65 + lane] = r.v[i];
    LDS_WAIT(); asm volatile("" ::: "memory");
    const int c = lane & 7;
#pragma unroll
    for (int j = 0; j < 8; ++j) { const int n = (lane >> 3) + 8 * j; const LAS float* s = scr + (8 * c) * 65 + n;
        v4u o; o.x = pk2(s[0 * 65], s[1 * 65]); o.y = pk2(s[2 * 65], s[3 * 65]); o.z = pk2(s[4 * 65], s[5 * 65]); o.w = pk2(s[6 * 65], s[7 * 65]);
        const int nl = n & 31;
        *(GAS v4u*)(t.WT + (size_t)((j >= 4 ? t.drow1 : t.drow0) + (t.perm ? pinv32(nl) : nl)) * t.Kd + t.k0 + 8 * c) = o; }
    LDS_WAIT(); asm volatile("" ::: "memory");
}

constexpr int W_ITEMS_ALL = 16 * 24 + 16 * 12 + 16 * 16 + 16 * 24 + 16 * 16 + 64 * 384, W_ITEMS_L1MOE = W_ITEMS_ALL - 32 * 384;
__device__ __forceinline__ void weight_items(Frame& F, const Args& a, const int lo, const int hi, const int rank, const int nblk) {
    const int F_lane = lane_id();
    LAS float* scr = (LAS float*)(F.lds + F.wave * 16896);
    const int gw = lo + rank * NWAVES + F.wave, NGW = nblk * NWAVES;
    if (gw < hi) {
        TItem cur = decode_item(a, F.ws, gw); TRegs rc = titem_load(cur, F_lane);
        for (int it = gw; it < hi; it += NGW) {
            const int itn = it + NGW < hi ? it + NGW : it; const TItem nxt = decode_item(a, F.ws, itn); const TRegs rn = titem_load(nxt, F_lane);
            titem_store(cur, rc, scr, F_lane);
            cur = nxt; rc = rn;
        }
    }
}

__device__ __forceinline__ void p0_prologue(Frame& F, const Args& a) {
    const int F_lane = lane_id(), F_tid = F.wave * 64 + F_lane; (void)F_tid;
    unsigned char* ws = F.ws;
    {
        LAS float* sv = (LAS float*)F.lds; LAS float* red = (LAS float*)(F.lds + 17 * 1024 * 4);
        float* MOD = (float*)(ws + WS_MOD);
        for (int u = F.bid; u < 192; u += F.G) {
            const int l = u / 96, n0 = (u % 96) * 64;
            for (int idx = F_tid; idx < 17 * 1024; idx += NTHR) { const int b = idx >> 10, k = idx & 1023; const float v = b < 16 ? a.in[I_C][b * 1024 + k] : a.in[I_CCTX][k]; sv[idx] = silu_f(v); }
            __syncthreads();
            float acc[17];
#pragma unroll
            for (int b = 0; b < 17; ++b) acc[b] = 0.f;
            const float* Wp = a.in[I_ADAW] + (size_t)l * 1024 * 6144 + n0 + F_lane;
            for (int k0 = F.wave * 128; k0 < F.wave * 128 + 128; k0 += 16) { float wv[16];
#pragma unroll
                for (int kk = 0; kk < 16; ++kk) wv[kk] = Wp[(size_t)(k0 + kk) * 6144];
#pragma unroll
                for (int kk = 0; kk < 16; ++kk)
#pragma unroll
                    for (int b = 0; b < 17; ++b) acc[b] += sv[b * 1024 + k0 + kk] * wv[kk]; }
#pragma unroll
            for (int b = 0; b < 17; ++b) red[(F.wave * 17 + b) * 64 + F_lane] = acc[b];
            __syncthreads();
            for (int idx = F_tid; idx < 17 * 64; idx += NTHR) { const int b = idx >> 6, j = idx & 63; float s = a.in[I_ADAB][l * 6144 + n0 + j];
#pragma unroll
                for (int w = 0; w < 8; ++w) s += red[(w * 17 + b) * 64 + j];
                MOD[((size_t)l * 17 + b) * 6144 + n0 + j] = s; }
            __syncthreads();
        }
    }
    {
        const float* w1 = a.in[I_HYW1]; const float* b1 = a.in[I_HYB1]; const float* w2 = a.in[I_HYW2]; const float* b2 = a.in[I_HYB2]; const float* fr = a.in[I_HYFREQ];
        float* HD2 = (float*)(ws + WS_HD2);
        const int gw = F.bid * NWAVES + F.wave, NGW = F.G * NWAVES;
        if (gw < 4352) {
            float w1c[33], w2c[64];
#pragma unroll
            for (int i = 0; i < 33; ++i) w1c[i] = w1[i * 64 + F_lane];
#pragma unroll
            for (int i = 0; i < 64; ++i) w2c[i] = w2[i * 64 + F_lane];
            const float frl = fr[F_lane], b1l = b1[F_lane], b2l = b2[F_lane];
            for (int tt = gw; tt < 4352; tt += NGW) {
                const int n = tt < 4096 ? 4096 : 256, t = tt < 4096 ? tt : tt - 4096; const float tf = (float)t; const float tn = tf / (float)(n - 1);
                float z = 0.f;
                if (F_lane == 0) z = tn;
                else if (F_lane < 33) { const int m = (F_lane - 1) & 15; const float band = 1e-4f + (float)m * ((15.f - 1e-4f) / 15.f); const float ang = ((float)(2.0 * M_PI / (double)n) * tf) * band;
                    z = F_lane < 17 ? cosf(ang) : -sinf(ang); }
                float h1 = b1l;
#pragma unroll
                for (int i = 0; i < 33; ++i) h1 += __builtin_bit_cast(float, __builtin_amdgcn_readlane(__builtin_bit_cast(int, z), i)) * w1c[i];
                h1 = sinf(frl * h1);
                float h2 = b2l;
#pragma unroll
                for (int i = 0; i < 64; ++i) h2 += __builtin_bit_cast(float, __builtin_amdgcn_readlane(__builtin_bit_cast(int, h1), i)) * w2c[i];
                h2 = sinf(frl * h2);
                HD2[(size_t)tt * 64 + F_lane] = h2;
            }
        }
    }
    if (F.bid == 0) {
        f32x2* RT = (f32x2*)(ws + WS_ROPE);
        for (int idx = F_tid; idx < 1024; idx += NTHR) { const int pos = idx >> 4, i = idx & 15; const float inv = powf(10000.f, -(float)(2 * i) / 32.f); const float ang = (float)pos * inv; RT[idx] = (f32x2){cosf(ang), sinf(ang)}; }
    }
    weight_items(F, a, 0, W_ITEMS_L1MOE, F.bid, F.G);
    __syncthreads();
}

struct RowVec { f32x4 v[4]; };
__device__ __forceinline__ RowVec ld_row(const float* p, int lane) { RowVec r; const f32x4* q = (const f32x4*)p + lane;
#pragma unroll
    for (int j = 0; j < 4; ++j) r.v[j] = q[64 * j]; return r; }
__device__ __forceinline__ RowVec ld_row_nt(const float* p, int lane) { RowVec r; const f32x4* q = (const f32x4*)p + lane;
#pragma unroll
    for (int j = 0; j < 4; ++j) r.v[j] = __builtin_nontemporal_load(q + 64 * j); return r; }
__device__ __forceinline__ void st_row(float* p, int lane, const RowVec& r) { f32x4* q = (f32x4*)p + lane;
#pragma unroll
    for (int j = 0; j < 4; ++j) q[64 * j] = r.v[j]; }
__device__ __forceinline__ void st_row_bf16_nt(bf16* p, int lane, const RowVec& r) { unsigned long long* o8 = (unsigned long long*)p + lane;
#pragma unroll
    for (int j = 0; j < 4; ++j) __builtin_nontemporal_store((unsigned long long)pk2(r.v[j][0], r.v[j][1]) | ((unsigned long long)pk2(r.v[j][2], r.v[j][3]) << 32), o8 + 64 * j); }
__device__ __forceinline__ void st_row_nt(float* p, int lane, const RowVec& r) { f32x4* q = (f32x4*)p + lane;
#pragma unroll
    for (int j = 0; j < 4; ++j) __builtin_nontemporal_store(r.v[j], q + 64 * j); }
__device__ __forceinline__ void st_row_bf16(bf16* p, int lane, const RowVec& r) { unsigned long long* o8 = (unsigned long long*)p + lane;
#pragma unroll
    for (int j = 0; j < 4; ++j) o8[64 * j] = (unsigned long long)pk2(r.v[j][0], r.v[j][1]) | ((unsigned long long)pk2(r.v[j][2], r.v[j][3]) << 32); }
__device__ __forceinline__ RowVec ld_row_bf16(const bf16* p, int lane) { RowVec r; const u32x2* q = (const u32x2*)p + lane;
#pragma unroll
    for (int j = 0; j < 4; ++j) { const u32x2 w = __builtin_nontemporal_load(q + 64 * j); r.v[j] = (f32x4){bflo(w.x), bfhi(w.x), bflo(w.y), bfhi(w.y)}; } return r; }
struct RowRaw { u32x2 w[4]; };
__device__ __forceinline__ RowRaw ld_raw_bf16(const bf16* p, int lane) { RowRaw r; const u32x2* q = (const u32x2*)p + lane;
#pragma unroll
    for (int j = 0; j < 4; ++j) r.w[j] = __builtin_nontemporal_load(q + 64 * j); return r; }
__device__ __forceinline__ RowVec norm_mod(const RowVec& x, const float* g, const float* scale, const float* shift, int lane) {
    float ss = 0.f;
#pragma unroll
    for (int j = 0; j < 4; ++j) ss += (x.v[j][0] * x.v[j][0] + x.v[j][1] * x.v[j][1]) + (x.v[j][2] * x.v[j][2] + x.v[j][3] * x.v[j][3]);
    const float rs = rsqrtf(wave_sum(ss) * (1.f / 1024.f) + NORM_EPS);
    const RowVec gv = ld_row(g, lane); RowVec y;
    if (scale) { const RowVec sc = ld_row(scale, lane), sf = ld_row(shift, lane);
#pragma unroll
        for (int j = 0; j < 4; ++j) y.v[j] = (x.v[j] * rs * gv.v[j]) * (sc.v[j] + 1.f) + sf.v[j];
    } else {
#pragma unroll
        for (int j = 0; j < 4; ++j) y.v[j] = x.v[j] * rs * gv.v[j];
    }
    return y;
}
__device__ __forceinline__ void jrow_split(int row, int& b, int& j) { b = row / RPB; j = row - b * RPB; }

__device__ __forceinline__ void split_hl(const float (&v)[8], bf16x8& hi, bf16x8& lo) {
#pragma unroll
    for (int j = 0; j < 8; ++j) { const unsigned hb = f2bf(v[j]); hi[j] = (short)hb; lo[j] = (short)f2bf(v[j] - __builtin_bit_cast(float, hb << 16)); }
}
__device__ __forceinline__ void p_filter_stage_b(Frame& F, const Args& a, const int rank, const int nblk) {
    const int F_lane = lane_id();
    const float* w3 = a.in[I_HYW3]; const float* HD2 = (const float*)(F.ws + WS_HD2);
    const int gw = rank * NWAVES + F.wave, NGW = nblk * NWAVES;
    const float mind = logf(1e-2f) / 1.5f, maxd = logf(1e-2f) / 0.3f;
    const int lr = F_lane & 15, lg = F_lane >> 4;
    for (int wu = gw; wu < 68 * 32; wu += NGW) {
        const int tc = wu >> 5, cchunk = wu & 31; const bool isc = tc >= 64; const int n = isc ? 256 : 4096; const int t0 = (isc ? tc - 64 : tc) * 64; const int tt0 = isc ? 4096 + t0 : t0;
        float* HR = (float*)(F.ws + (isc ? WS_HRAWC : WS_HRAW)); const int colb = cchunk * 64;
        bf16x8 Ahi[4][2], Alo[4][2];
#pragma unroll
        for (int tt = 0; tt < 4; ++tt)
#pragma unroll
            for (int ks = 0; ks < 2; ++ks) { const float* hp = HD2 + (size_t)(tt0 + 16 * tt + lr) * 64 + 32 * ks + 8 * lg; const f32x4 h0 = *(const f32x4*)hp, h1 = *(const f32x4*)(hp + 4);
                const float v[8] = {h0[0], h0[1], h0[2], h0[3], h1[0], h1[1], h1[2], h1[3]}; split_hl(v, Ahi[tt][ks], Alo[tt][ks]); }
        const float rn1 = 1.f / (float)(n - 1);
#pragma unroll 1
        for (int ct = 0; ct < 4; ++ct) {
            const int col = colb + 16 * ct + lr;
            bf16x8 Bhi[2], Blo[2];
#pragma unroll
            for (int ks = 0; ks < 2; ++ks) { float v[8];
#pragma unroll
                for (int j = 0; j < 8; ++j) v[j] = w3[(size_t)(32 * ks + 8 * lg + j) * 2048 + col];
                split_hl(v, Bhi[ks], Blo[ks]); }
            const float ad = fabsf(mind + (float)(col & 511) * ((maxd - mind) / 511.f)) * LOG2E;
#pragma unroll
            for (int tt = 0; tt < 4; ++tt) { f32x4 acc = (f32x4){0.f, 0.f, 0.f, 0.f};
#pragma unroll
                for (int ks = 0; ks < 2; ++ks) { acc = __builtin_amdgcn_mfma_f32_16x16x32_bf16(Ahi[tt][ks], Bhi[ks], acc, 0, 0, 0); acc = __builtin_amdgcn_mfma_f32_16x16x32_bf16(Alo[tt][ks], Bhi[ks], acc, 0, 0, 0);
                    acc = __builtin_amdgcn_mfma_f32_16x16x32_bf16(Ahi[tt][ks], Blo[ks], acc, 0, 0, 0); }
                const int tb = t0 + 16 * tt + 4 * lg; f32x4 o;
#pragma unroll
                for (int r = 0; r < 4; ++r) o[r] = acc[r] * __builtin_amdgcn_exp2f(-((float)(tb + r) * rn1) * ad);
                *(f32x4*)(HR + (size_t)col * n + tb) = o; }
        }
    }
}

__device__ __forceinline__ bf16* x2b_row(unsigned char* ws, int b, int t) {
    const size_t base = b < 8 ? WS_WGU + (size_t)b * (8 * MiB) : (b < 12 ? WS_WDN + (size_t)(b - 8) * (8 * MiB) : WS_HRAW + (size_t)(b - 12) * (8 * MiB));
    return (bf16*)(ws + base) + (size_t)t * DM;
}
__device__ __forceinline__ const float* p1_src(const Args& a, int row) { int b, j; jrow_split(row, b, j); return j < CTXL ? a.in[I_CTX] + ((size_t)b * CTXL + j) * DM : a.in[I_X] + ((size_t)b * SEQ + (j - CTXL)) * DM; }
__device__ __forceinline__ void p_norm1_l0(Frame& F, const Args& a) {
    const int F_lane = lane_id();
    const float* MOD = (const float*)(F.ws + WS_MOD); bf16* H = (bf16*)(F.ws + WS_BUF1);
    const int gw = F.bid * NWAVES + F.wave, NGW = F.G * NWAVES;
    RowVec xn = ld_row_nt(p1_src(a, gw < NROWS ? gw : 0), F_lane);
    for (int row = gw; row < NROWS; row += NGW) { int b, j; jrow_split(row, b, j);
        const RowVec x = xn; const int rn = row + NGW < NROWS ? row + NGW : row; xn = ld_row_nt(p1_src(a, rn), F_lane);
        const float* md = MOD + (size_t)(j < CTXL ? 16 : b) * 6144;
        const RowVec y = norm_mod(x, a.in[I_N1G], md + 1024, md, F_lane);
        st_row_bf16(H + (size_t)row * DM, F_lane, y); }
}

__device__ __forceinline__ void moe_tab(Frame& F, LAS int* tab, int layer) {
    const int F_lane = lane_id(), F_tid = F.wave * 64 + F_lane; (void)F_tid;
    if (F_tid < 32) tab[64 + F_tid] = (int)__hip_atomic_load(F.ctl + CW_CNT + 64 * layer + F_tid, RLX_AGENT);
    __syncthreads();
    if (F_tid == 0) { int s = 0; for (int e = 0; e < 32; ++e) { tab[e] = s; s += (tab[64 + e] + 255) >> 8; } tab[32] = s; for (int e = 33; e < 64; ++e) tab[e] = 0x7fffffff; }
    __syncthreads();
}

constexpr int RT_HPITCH = 2064;
constexpr int RT_PART_OFF = 2 * 16 * RT_HPITCH, RT_LGS_OFF = RT_PART_OFF + 8 * 48 * 16 * 4, RT_CNT_OFF = RT_LGS_OFF + 16 * 48 * 4, RT_REC_OFF = RT_CNT_OFF + 256, RT_MAXROWS = 288;
static_assert(RT_REC_OFF + 3 * 2 * RT_MAXROWS * 4 <= MISC_OFF, "router LDS map");
template <int LAYER>
__device__ __forceinline__ void p_norm2_route(Frame& F, const Args& a) {
    const int F_lane = lane_id(), F_tid = F.wave * 64 + F_lane;
    const float* MOD = (const float*)(F.ws + WS_MOD) + (size_t)LAYER * 17 * 6144; bf16* H2 = (bf16*)(F.ws + WS_BUF1);
    LAS unsigned char* hbuf = F.lds; LAS unsigned char* hbuf_lo = F.lds + 16 * RT_HPITCH; LAS float* part = (LAS float*)(F.lds + RT_PART_OFF); LAS float* lgs = (LAS float*)(F.lds + RT_LGS_OFF);
    LAS int* lcnt = (LAS int*)(F.lds + RT_CNT_OFF); LAS int* lbase = lcnt + 32;
    LAS int* recE = (LAS int*)(F.lds + RT_REC_OFF); LAS int* recP = recE + 2 * RT_MAXROWS; LAS float* recG = (LAS float*)(recP + 2 * RT_MAXROWS);
    const float* wg = a.in[I_RTGW] + (size_t)LAYER * 1024 * 4; const float* we = a.in[I_RTEW] + (size_t)LAYER * 1024 * 32;
    const float* gb = a.in[I_RTGB] + LAYER * 4; const float* eb = a.in[I_RTEB] + LAYER * 32;
    bf16x8 Whi[3][4], Wlo[3][4];
#pragma unroll
    for (int nt = 0; nt < 3; ++nt) {
        const int o = 16 * nt + (F_lane & 15); float wv[4][8];
#pragma unroll
        for (int ks = 0; ks < 4; ++ks) { const int k0 = 128 * F.wave + 32 * ks + 8 * (F_lane >> 4);
#pragma unroll
            for (int j = 0; j < 8; ++j) { float v = 0.f; if (o < 4) v = wg[(size_t)(k0 + j) * 4 + o]; else if (o < 36) v = we[(size_t)(k0 + j) * 32 + (o - 4)]; wv[ks][j] = v; } }
#pragma unroll
        for (int ks = 0; ks < 4; ++ks) {
#pragma unroll
            for (int j = 0; j < 8; ++j) { const unsigned hb = f2bf(wv[ks][j]); const float hf = __builtin_bit_cast(float, hb << 16); Whi[nt][ks][j] = (short)hb; Wlo[nt][ks][j] = (short)f2bf(wv[ks][j] - hf); }
            asm volatile("" : "+v"(Whi[nt][ks]), "+v"(Wlo[nt][ks]) :: "memory"); }
    }
    if (F_tid < 64) lcnt[F_tid] = 0;
    __syncthreads();
    const int nrows = LAYER == 0 ? NROWS : NB * SEQ; const int chunk = (nrows + F.G - 1) / F.G;
    const int i0 = F.bid * chunk, i1 = (i0 + chunk < nrows) ? i0 + chunk : nrows;
    const bf16* YB = (const bf16*)(F.ws + WS_Y);
#define RT_LDX(i_) ({ RowVec xr_; if (LAYER == 0) { int b_, j_; jrow_split((i_), b_, j_); xr_ = ld_row_nt(j_ < CTXL ? a.in[I_CTX] + ((size_t)b_ * CTXL + j_) * DM : a.in[I_X] + ((size_t)b_ * SEQ + (j_ - CTXL)) * DM, F_lane); } \
    else xr_ = ld_row_bf16(x2b_row(F.ws, (i_) >> 12, (i_) & 4095), F_lane); xr_; })
#define RT_YROW(i_) (LAYER == 0 ? (i_) : ((i_) >> 12) * RPB + CTXL + ((i_) & 4095))
    RowVec xq[2]; RowRaw yq[2];
#pragma unroll
    for (int r = 0; r < 2; ++r) { const int i = (i0 + 2 * F.wave + r < i1) ? i0 + 2 * F.wave + r : i1 - 1; xq[r] = RT_LDX(i); yq[r] = ld_raw_bf16(YB + (size_t)RT_YROW(i) * DM, F_lane); }
    for (int ig = i0; ig < i1; ig += 16) {
#pragma unroll
        for (int r = 0; r < 2; ++r) {
            const int rl = 2 * F.wave + r; const bool valid = ig + rl < i1; const int i = valid ? ig + rl : i1 - 1; int row, b, j;
            if (LAYER == 0) { row = i; jrow_split(row, b, j); } else { b = i >> 12; j = CTXL + (i & 4095); row = b * RPB + j; }
            const float* md = MOD + (size_t)(j < CTXL ? 16 : b) * 6144;
            RowVec x1 = xq[r];
#pragma unroll
            for (int q = 0; q < 4; ++q) x1.v[q] = x1.v[q] + (f32x4){bflo(yq[r].w[q].x), bfhi(yq[r].w[q].x), bflo(yq[r].w[q].y), bfhi(yq[r].w[q].y)};
            const RowVec y = norm_mod(x1, a.in[I_N2G] + LAYER * 1024, md + 4 * 1024, md + 3 * 1024, F_lane);
            unsigned long long pk[4], pl[4];
#pragma unroll
            for (int q = 0; q < 4; ++q) { const unsigned h0 = f2bf(y.v[q][0]), h1 = f2bf(y.v[q][1]), h2_ = f2bf(y.v[q][2]), h3 = f2bf(y.v[q][3]);
                pk[q] = (unsigned long long)(h0 | (h1 << 16)) | ((unsigned long long)(h2_ | (h3 << 16)) << 32);
                const float l0 = y.v[q][0] - __builtin_bit_cast(float, h0 << 16), l1 = y.v[q][1] - __builtin_bit_cast(float, h1 << 16), l2 = y.v[q][2] - __builtin_bit_cast(float, h2_ << 16), l3 = y.v[q][3] - __builtin_bit_cast(float, h3 << 16);
                pl[q] = (unsigned long long)pk2(l0, l1) | ((unsigned long long)pk2(l2, l3) << 32); }
            if (valid) { unsigned long long* o8 = (unsigned long long*)(H2 + (size_t)row * DM) + F_lane;
#pragma unroll
                for (int q = 0; q < 4; ++q) o8[64 * q] = pk[q]; }
#pragma unroll
            for (int q = 0; q < 4; ++q) { *(LAS unsigned long long*)(hbuf + rl * RT_HPITCH + (4 * F_lane + 256 * q) * 2) = pk[q]; *(LAS unsigned long long*)(hbuf_lo + rl * RT_HPITCH + (4 * F_lane + 256 * q) * 2) = pl[q]; }
        }
        {   const int ign = ig + 16;
#pragma unroll
            for (int r = 0; r < 2; ++r) { const int i = (ign + 2 * F.wave + r < i1) ? ign + 2 * F.wave + r : i1 - 1; xq[r] = RT_LDX(i); yq[r] = ld_raw_bf16(YB + (size_t)RT_YROW(i) * DM, F_lane); } }
        __syncthreads();
        {   f32x4 acc[3];
#pragma unroll
            for (int nt = 0; nt < 3; ++nt) acc[nt] = (f32x4){0.f, 0.f, 0.f, 0.f};
#pragma unroll
            for (int ks = 0; ks < 4; ++ks) { const int bo = (F_lane & 15) * RT_HPITCH + (128 * F.wave + 32 * ks + 8 * (F_lane >> 4)) * 2;
                const bf16x8 bfr = *(const LAS bf16x8*)(hbuf + bo), bfl = *(const LAS bf16x8*)(hbuf_lo + bo);
#pragma unroll
                for (int nt = 0; nt < 3; ++nt) { acc[nt] = __builtin_amdgcn_mfma_f32_16x16x32_bf16(Whi[nt][ks], bfr, acc[nt], 0, 0, 0); acc[nt] = __builtin_amdgcn_mfma_f32_16x16x32_bf16(Wlo[nt][ks], bfr, acc[nt], 0, 0, 0);
                    acc[nt] = __builtin_amdgcn_mfma_f32_16x16x32_bf16(Whi[nt][ks], bfl, acc[nt], 0, 0, 0); } }
#pragma unroll
            for (int nt = 0; nt < 3; ++nt)
#pragma unroll
                for (int rg = 0; rg < 4; ++rg) part[(F.wave * 48 + 16 * nt + 4 * (F_lane >> 4) + rg) * 16 + (F_lane & 15)] = acc[nt][rg]; }
        __syncthreads();
        for (int idx = F_tid; idx < 36 * 16; idx += NTHR) { const int o = idx >> 4, r = idx & 15; float sacc = o < 4 ? gb[o] : eb[o - 4];
#pragma unroll
            for (int w = 0; w < 8; ++w) sacc += part[(w * 48 + o) * 16 + r];
            lgs[r * 48 + o] = sacc; }
        __syncthreads();
        if (F_tid < 16 && ig + F_tid < i1) {
            float lg[36];
#pragma unroll
            for (int o4 = 0; o4 < 9; ++o4) { const f32x4 t4 = *(const LAS f32x4*)(lgs + F_tid * 48 + 4 * o4); lg[4 * o4] = t4[0]; lg[4 * o4 + 1] = t4[1]; lg[4 * o4 + 2] = t4[2]; lg[4 * o4 + 3] = t4[3]; }
            int grp = 0; float gmax = lg[0];
#pragma unroll
            for (int q = 1; q < 4; ++q) if (lg[q] > gmax) { gmax = lg[q]; grp = q; }
            float den = 0.f;
#pragma unroll
            for (int q = 0; q < 4; ++q) den += __expf(lg[q] - gmax);
            const float pg = 1.f / den;
            float el[8];
#pragma unroll
            for (int q = 0; q < 8; ++q) { float v = 0.f;
#pragma unroll
                for (int g2 = 0; g2 < 4; ++g2) v = (grp == g2) ? lg[4 + 8 * g2 + q] : v;
                el[q] = v; }
            int i0e = 0; float m0 = el[0];
#pragma unroll
            for (int q = 1; q < 8; ++q) if (el[q] > m0) { m0 = el[q]; i0e = q; }
            int i1e = -1; float m1 = -INFINITY;
#pragma unroll
            for (int q = 0; q < 8; ++q) if (q != i0e && el[q] > m1) { m1 = el[q]; i1e = q; }
            const float ex = __expf(m1 - m0); const float g0 = pg / (1.f + ex), g1 = pg * ex / (1.f + ex);
            const int e0 = grp * 8 + i0e, e1 = grp * 8 + i1e; const int li = ig + F_tid - i0;
            recE[2 * li] = e0; recE[2 * li + 1] = e1; recG[2 * li] = g0; recG[2 * li + 1] = g1;
            recP[2 * li] = atomicAdd((int*)&lcnt[e0], 1); recP[2 * li + 1] = atomicAdd((int*)&lcnt[e1], 1);
        }
    }
    __syncthreads();
    const int tid2 = F.wave * 64 + lane_id();
    if (tid2 < 32) { const int c = lcnt[tid2]; lbase[tid2] = c > 0 ? (int)__hip_atomic_fetch_add(F.ctl + CW_CNT + 64 * LAYER + tid2, (unsigned)c, RLX_AGENT) : 0; }
    __syncthreads();
    int* TOK = (int*)(F.ws + WS_TOKIDX); float* GT = (float*)(F.ws + WS_GATE); int* RT = (int*)(F.ws + WS_ROUTE);
    for (int idx = tid2; idx < 2 * (i1 - i0); idx += NTHR) { const int li = idx >> 1, i = i0 + li; int row;
        if (LAYER == 0) row = i; else row = (i >> 12) * RPB + CTXL + (i & 4095);
        const int e = recE[idx], pos = lbase[e] + recP[idx];
        TOK[(size_t)e * CAP + pos] = row; GT[(size_t)e * CAP + pos] = recG[idx]; RT[(size_t)row * 4 + 2 * (idx & 1)] = e; RT[(size_t)row * 4 + 2 * (idx & 1) + 1] = pos; }
#undef RT_LDX
#undef RT_YROW
}

template <int LAYER> __device__ __forceinline__ int cmb_row(int i) { return LAYER == 0 ? i : (i >> 12) * RPB + CTXL + (i & 4095); }
template <int LAYER>
__device__ __forceinline__ void p_combine(Frame& F, const Args& a) {
    const int F_lane = lane_id(), F_tid = F.wave * 64 + F_lane; (void)F_tid;
    const float* MOD = (const float*)(F.ws + WS_MOD) + (size_t)LAYER * 17 * 6144; const float* MOD1 = (const float*)(F.ws + WS_MOD) + (size_t)17 * 6144;
    float* XC = (float*)(F.ws + WS_XC); bf16* H = (bf16*)(F.ws + WS_BUF1); const bf16* MOUT = (const bf16*)(F.ws + WS_BUF2); const int* RT = (const int*)(F.ws + WS_ROUTE); const bf16* YB = (const bf16*)(F.ws + WS_Y);
    LAS int* tab = (LAS int*)F.lds; moe_tab(F, tab, LAYER);
    const int gw = F.bid * NWAVES + F.wave, NGW = F.G * NWAVES; const int nrows = LAYER == 0 ? NROWS : NB * SEQ;
    if (gw >= nrows) return;
    typedef int i32x4 __attribute__((ext_vector_type(4)));
#define CMB_XP(row_) ({ int b_, j_; jrow_split((row_), b_, j_); j_ < CTXL ? XC + ((size_t)b_ * CTXL + j_) * DM : a.out + ((size_t)b_ * SEQ + (j_ - CTXL)) * DM; })
#define CMB_LDX(row_) ({ RowVec xr_; int b_, j_; jrow_split((row_), b_, j_); if (LAYER == 0) xr_ = ld_row_nt(j_ < CTXL ? a.in[I_CTX] + ((size_t)b_ * CTXL + j_) * DM : a.in[I_X] + ((size_t)b_ * SEQ + (j_ - CTXL)) * DM, F_lane); else xr_ = ld_row_bf16(x2b_row(F.ws, b_, j_ - CTXL), F_lane); xr_; })
    int i = gw; int row = cmb_row<LAYER>(i);
    i32x4 rt = *(const i32x4*)(RT + (size_t)row * 4);
    int i_n = i + NGW < nrows ? i + NGW : i; int row_n = cmb_row<LAYER>(i_n);
    i32x4 rt_n = *(const i32x4*)(RT + (size_t)row_n * 4);
    RowVec x = CMB_LDX(row); RowRaw yr = ld_raw_bf16(YB + (size_t)row * DM, F_lane);
    RowRaw m0 = ld_raw_bf16(MOUT + ((size_t)tab[rt[0]] * 256 + rt[1]) * DM, F_lane), m1 = ld_raw_bf16(MOUT + ((size_t)tab[rt[2]] * 256 + rt[3]) * DM, F_lane);
    for (; i < nrows; ) {
        const int i_nn = i_n + NGW < nrows ? i_n + NGW : i_n; const int row_nn = cmb_row<LAYER>(i_nn);
        const i32x4 rt_nn = *(const i32x4*)(RT + (size_t)row_nn * 4);
        const RowVec x_n = CMB_LDX(row_n); const RowRaw yr_n = ld_raw_bf16(YB + (size_t)row_n * DM, F_lane);
        const RowRaw m0_n = ld_raw_bf16(MOUT + ((size_t)tab[rt_n[0]] * 256 + rt_n[1]) * DM, F_lane), m1_n = ld_raw_bf16(MOUT + ((size_t)tab[rt_n[2]] * 256 + rt_n[3]) * DM, F_lane);
        int b, j; jrow_split(row, b, j); float* xp = CMB_XP(row); const int mb = j < CTXL ? 16 : b;
        const RowVec g5 = ld_row(MOD + (size_t)mb * 6144 + 5 * 1024, F_lane);
#pragma unroll
        for (int q = 0; q < 4; ++q) { const f32x4 a0 = (f32x4){bflo(m0.w[q].x), bfhi(m0.w[q].x), bflo(m0.w[q].y), bfhi(m0.w[q].y)}, a1 = (f32x4){bflo(m1.w[q].x), bfhi(m1.w[q].x), bflo(m1.w[q].y), bfhi(m1.w[q].y)};
            x.v[q] = (x.v[q] + (f32x4){bflo(yr.w[q].x), bfhi(yr.w[q].x), bflo(yr.w[q].y), bfhi(yr.w[q].y)}) + g5.v[q] * (a0 + a1); }
        if (LAYER == 0) { if (j >= CTXL) st_row_bf16_nt(x2b_row(F.ws, b, j - CTXL), F_lane, x); const float* md = MOD1 + (size_t)mb * 6144; const RowVec y = norm_mod(x, a.in[I_N1G] + 1024, md + 1024, md, F_lane); st_row_bf16(H + (size_t)row * DM, F_lane, y); }
        else { const RowVec y = norm_mod(x, a.in[I_FNG], nullptr, nullptr, F_lane); st_row_nt(xp, F_lane, y); }
        if (i + NGW >= nrows) break;
        i = i_n; row = row_n; x = x_n; yr = yr_n; m0 = m0_n; m1 = m1_n; i_n = i_nn; row_n = row_nn; rt_n = rt_nn;
    }
#undef CMB_XP
#undef CMB_LDX
}

__device__ __forceinline__ void p_transpose_y(Frame& F) {
    const int F_lane = lane_id();
    const bf16* YT = (const bf16*)(F.ws + WS_BUF4); bf16* YM = (bf16*)(F.ws + WS_BUF1);
    LAS unsigned short* t = (LAS unsigned short*)(F.lds + F.wave * 9216);
    const int gw = F.bid * NWAVES + F.wave, NGW = F.G * NWAVES; const int NT_R = NROWS / 64; const int NTILES = 8 * NT_R;
    if (gw >= NTILES) return;
    u32x4 cur[8], nxt[8];
#define TY_LOAD(dst, tile_) do { const int cb_ = (tile_) / NT_R, rb_ = (tile_) % NT_R; _Pragma("unroll") for (int i = 0; i < 8; ++i) dst[i] = __builtin_nontemporal_load((const u32x4*)(YT + (size_t)(cb_ * 64 + 8 * i + (F_lane >> 3)) * CT_LD + rb_ * 64 + 8 * (F_lane & 7))); } while (0)
    TY_LOAD(cur, gw);
    for (int tile = gw; tile < NTILES; tile += NGW) { const int cb = tile / NT_R, rb = tile % NT_R; const int c0 = cb * 64, r0 = rb * 64;
        const int tn = tile + NGW < NTILES ? tile + NGW : tile; TY_LOAD(nxt, tn);
#pragma unroll
        for (int i = 0; i < 8; ++i) *(LAS u32x4*)(t + (8 * i + (F_lane >> 3)) * 72 + 8 * (F_lane & 7)) = cur[i];
        LDS_WAIT(); asm volatile("" ::: "memory");
#pragma unroll
        for (int i = 0; i < 8; ++i) { const int r = 8 * i + (F_lane >> 3), cc = F_lane & 7; unsigned short e[8];
#pragma unroll
            for (int k = 0; k < 8; ++k) e[k] = t[(8 * cc + k) * 72 + r];
            u32x4 w; w.x = e[0] | ((unsigned)e[1] << 16); w.y = e[2] | ((unsigned)e[3] << 16); w.z = e[4] | ((unsigned)e[5] << 16); w.w = e[6] | ((unsigned)e[7] << 16);
            *(u32x4*)(YM + (size_t)(r0 + r) * DM + c0 + 8 * cc) = w; }
        LDS_WAIT(); asm volatile("" ::: "memory");
#pragma unroll
        for (int i = 0; i < 8; ++i) cur[i] = nxt[i];
    }
#undef TY_LOAD
}
constexpr int HY_UP = 8208;
constexpr int HY_G_OFF = 16 * HY_UP, HY_GK_BYTES = 4096 * 2 + 64  , HY_G_BYTES = 3 * HY_GK_BYTES, HY_RED_OFF = HY_G_OFF + HY_G_BYTES;
static_assert(HY_RED_OFF + 64 <= MISC_OFF, "hyena LDS map");

#define LAUNDER(x) asm volatile("" : "+v"(x))
__device__ __forceinline__ float hy_tap(const float* HR, int order, int c, int lag) {
    if (lag > 4095 || lag < -4095) return 0.f;
    return lag >= 0 ? HR[(size_t)(order * 512 + c) * 4096 + lag] : HR[(size_t)(1024 + order * 512 + c) * 4096 - lag];
}
__device__ __forceinline__ void hy_load_filter(Frame& F, const float* HR, int order, int c, LAS unsigned char* G3, LAS float* red) {
    const int lane_ = lane_id();
    float fa[8], fb[8], fc[8]; float s = 0.f; int tid = F.wave * 64 + lane_; LAUNDER(tid);
#pragma unroll
    for (int k = 0; k < 8; ++k) { const int i = tid + 512 * k;
        fa[k] = i >= 1 ? hy_tap(HR, order, c, 2048 - i) : 0.f; fb[k] = i >= 1 ? hy_tap(HR, order, c, -i) : 0.f; fc[k] = i >= 1 ? hy_tap(HR, order, c, 4096 - i) : 0.f;
        s += fabsf(fb[k]) + fabsf(fc[k]) + (i == 2048 ? fabsf(fa[k]) : 0.f); }
    s = wave_sum(s); if (lane_ == 0) red[F.wave] = s;
    __syncthreads();
    float S = 0.f;
#pragma unroll
    for (int w = 0; w < 8; ++w) S += red[w];
    const float inv = 1.f / (S + 1e-6f);
#pragma unroll
    for (int k = 0; k < 8; ++k) { const int i = tid + 512 * k; const float a_ = fa[k] * inv;
        ((LAS unsigned short*)G3)[i] = (unsigned short)f2bf(a_);
        ((LAS unsigned short*)(G3 + HY_GK_BYTES))[i] = (unsigned short)f2bf(fb[k] * inv - a_);
        ((LAS unsigned short*)(G3 + 2 * HY_GK_BYTES))[i] = (unsigned short)f2bf(fc[k] * inv - a_); }
    __syncthreads();
}
__device__ __forceinline__ f32x4 sconv4(const bf16* up, int tb, int n, float w0, float w1, float w2, float bias) {
    const u32x2 w = *(const u32x2*)up; const float pv = tb > 0 ? bf2f(up[tb > 0 ? -1 : 0]) : 0.f, nx = tb + 4 < n ? bf2f(up[tb + 4 < n ? 4 : 0]) : 0.f;
    const float u0 = bflo(w.x), u1 = bfhi(w.x), u2 = bflo(w.y), u3 = bfhi(w.y);
    return (f32x4){w0 * pv + w1 * u0 + w2 * u1 + bias, w0 * u0 + w1 * u1 + w2 * u2 + bias, w0 * u1 + w1 * u2 + w2 * u3 + bias, w0 * u2 + w1 * u3 + w2 * nx + bias};
}
template <bool SUMX>
__device__ __forceinline__ void hy_half(f32x4 (&acc)[16], bf16x8 (&Bw)[8], unsigned (&x0)[5], unsigned (&x1)[5], bf16x8& Btmp, const LAS unsigned char* xbase, const int xoff, const LAS unsigned char* bbase, const int boff, const unsigned sh,
                                        const int u, const int qlo, const int qhi, const int par, const bool binstall, const bool bprefetch) {
    if (par == 0 && binstall) Bw[(8 - u) & 7] = Btmp;
    u32x4 w;
#pragma unroll
    for (int k = 0; k < 4; ++k) w[k] = __builtin_amdgcn_alignbit(x0[k + 1], x0[k], sh);
    const bf16x8 a = __builtin_bit_cast(bf16x8, w);
#pragma unroll
    for (int k = 0; k < 5; ++k) { x0[k] = x1[k]; x1[k] = *(const LAS unsigned*)(xbase + xoff + 4 * k); }
    if (par == 0 && bprefetch) { Btmp = *(const LAS bf16x8*)(bbase + boff);
        if (SUMX) { const bf16x8 t1 = *(const LAS bf16x8*)(bbase + 4096 + boff); const u32x4 p0 = __builtin_bit_cast(u32x4, Btmp), p1 = __builtin_bit_cast(u32x4, t1); u32x4 ps;
#pragma unroll
            for (int k = 0; k < 4; ++k) ps[k] = pk2(bflo(p0[k]) + bflo(p1[k]), bfhi(p0[k]) + bfhi(p1[k]));
            Btmp = __builtin_bit_cast(bf16x8, ps); } }
    __builtin_amdgcn_sched_barrier(0);
#pragma unroll
    for (int q = 0; q < 8; ++q) if (q >= qlo && q <= qhi) { const int sl = (q - u) & 7;
        acc[2 * q + par] = __builtin_amdgcn_mfma_f32_16x16x32_bf16(a, Bw[sl], acc[2 * q + par], 0, 0, 0); }
    __builtin_amdgcn_sched_barrier(0);
}
template <bool SUMX>
__device__ __forceinline__ void hy_step(f32x4 (&acc)[16], bf16x8 (&Bw)[8], unsigned (&x0)[5], unsigned (&x1)[5], bf16x8& Btmp, const LAS unsigned char* xbase, const int xoff, const LAS unsigned char* bbase, const int boff, const unsigned sh,
                                        const int u, const int qlo, const int qhi, const bool binstall, const bool bprefetch) {
    hy_half<SUMX>(acc, Bw, x0, x1, Btmp, xbase, xoff - 64, bbase, boff, sh, u, qlo, qhi, 0, binstall, bprefetch);
    hy_half<SUMX>(acc, Bw, x0, x1, Btmp, xbase, xoff - 96, bbase, boff, sh, u, qlo, qhi, 1, false, false);
}
template <int NJ, int UPITCH, bool SUMX = false>
__device__ __forceinline__ void hy_conv_pass(f32x4 (&acc)[16], const LAS unsigned char* U, const LAS unsigned short* GR, int v, int lane_in) {
    int lane = lane_in; LAUNDER(lane); const int row = lane & 15, g = lane >> 4, r = row & 1;
    const unsigned sh = 16u * (unsigned)r;
    const LAS unsigned char* ub = U + row * UPITCH + g * 16;
    const LAS unsigned char* xa = (const LAS unsigned char*)GR + 2 * (32 * NJ - row + 8 * g - r) - 64 * (8 * v - (NJ - 1));
    const LAS unsigned char* bn = ub + (NJ - 2) * 64;
    bf16x8 Bw[8]; bf16x8 Btmp = *(const LAS bf16x8*)(ub + (NJ - 1) * 64); unsigned x0[5], x1[5];
    if (SUMX) { const bf16x8 t1 = *(const LAS bf16x8*)(ub + 4096 + (NJ - 1) * 64); const u32x4 p0 = __builtin_bit_cast(u32x4, Btmp), p1 = __builtin_bit_cast(u32x4, t1); u32x4 ps;
#pragma unroll
        for (int k = 0; k < 4; ++k) ps[k] = pk2(bflo(p0[k]) + bflo(p1[k]), bfhi(p0[k]) + bfhi(p1[k]));
        Btmp = __builtin_bit_cast(bf16x8, ps); }
#pragma unroll
    for (int i = 0; i < 8; ++i) Bw[i] = (bf16x8){0, 0, 0, 0, 0, 0, 0, 0};
#pragma unroll
    for (int k = 0; k < 5; ++k) { x0[k] = *(const LAS unsigned*)(xa + 4 * k); x1[k] = *(const LAS unsigned*)(xa - 32 + 4 * k); }
    { const LAS unsigned char* xl = xa - 64 * 9; const LAS unsigned char* bl = bn - 64 * 7; asm volatile("" : "+v"(xl), "+v"(bl));
#pragma unroll
      for (int s = 0; s < 7; ++s) hy_step<SUMX>(acc, Bw, x0, x1, Btmp, xl, 64 * (9 - s), bl, 64 * (7 - s), sh, s + 1, 0, s, true, true);
      xa -= 64 * 7; bn -= 64 * 7; }
#pragma unroll 1
    for (int it = 0; it < (NJ - 8) / 8; ++it) {
        const LAS unsigned char* xl = xa - 64 * 9; const LAS unsigned char* bl = bn - 64 * 7; asm volatile("" : "+v"(xl), "+v"(bl));
#pragma unroll
        for (int u = 0; u < 8; ++u) hy_step<SUMX>(acc, Bw, x0, x1, Btmp, xl, 64 * (9 - u), bl, 64 * (7 - u), sh, u, 0, 7, true, true);
        xa -= 512; bn -= 512;
    }
    { const LAS unsigned char* xl = xa - 64 * 9; asm volatile("" : "+v"(xl));
      hy_step<SUMX>(acc, Bw, x0, x1, Btmp, xl, 64 * 9, ub, 0, sh, 0, 0, 7, true, false);
#pragma unroll
      for (int m = 1; m < 8; ++m) hy_step<SUMX>(acc, Bw, x0, x1, Btmp, xl, 64 * (9 - m), ub, 0, sh, m, m, 7, false, false); }
}
__device__ __forceinline__ void hyena_latent_unit(Frame& F, const Args& a, int c) {
    const bf16* UT = (const bf16*)(F.ws + WS_BUF2); bf16* YT = (bf16*)(F.ws + WS_BUF4); const float* HR = (const float*)(F.ws + WS_HRAW);
    const int lane_ = lane_id(); const int tid_ = F.wave * 64 + lane_;
    LAS unsigned char* U = F.lds; LAS unsigned char* G3 = F.lds + HY_G_OFF; LAS float* red = (LAS float*)(F.lds + HY_RED_OFF);
    const LAS unsigned short* GA = (const LAS unsigned short*)G3; const LAS unsigned short* GBA = (const LAS unsigned short*)(G3 + HY_GK_BYTES); const LAS unsigned short* GCA = (const LAS unsigned short*)(G3 + 2 * HY_GK_BYTES);
    const float* cw = a.in[I_HYCW]; const float* cb = a.in[I_HYCB]; const float* sk = a.in[I_HYSKIP];
    hy_load_filter(F, HR, 0, c, G3, red);
    {
        const float w0 = cw[c], w1 = cw[1536 + c], w2 = cw[3072 + c], bs = cb[c]; int tid = tid_; LAUNDER(tid);
        const int t8 = (tid & 511) * 8; const bf16* up0 = UT + (size_t)c * CT_LD + CTXL + t8;
        u32x4 uw[16]; unsigned short upv[16], unx[16];
#pragma unroll
        for (int k = 0; k < 16; ++k) { const bf16* up = up0 + (size_t)k * RPB; uw[k] = *(const u32x4*)up; upv[k] = up[-1]; unx[k] = up[8]; }
#pragma unroll
        for (int k = 0; k < 16; ++k) {
            const float e0 = t8 > 0 ? bf2f(upv[k]) : 0.f, e9 = t8 + 8 < 4096 ? bf2f(unx[k]) : 0.f;
            const float e1 = bflo(uw[k].x), e2 = bfhi(uw[k].x), e3 = bflo(uw[k].y), e4 = bfhi(uw[k].y), e5 = bflo(uw[k].z), e6 = bfhi(uw[k].z), e7 = bflo(uw[k].w), e8 = bfhi(uw[k].w);
            u32x4 w; w.x = pk2(w0 * e0 + w1 * e1 + w2 * e2 + bs, w0 * e1 + w1 * e2 + w2 * e3 + bs); w.y = pk2(w0 * e2 + w1 * e3 + w2 * e4 + bs, w0 * e3 + w1 * e4 + w2 * e5 + bs);
            w.z = pk2(w0 * e4 + w1 * e5 + w2 * e6 + bs, w0 * e5 + w1 * e6 + w2 * e7 + bs); w.w = pk2(w0 * e6 + w1 * e7 + w2 * e8 + bs, w0 * e7 + w1 * e8 + w2 * e9 + bs);
            *(LAS u32x4*)(U + k * HY_UP + t8 * 2) = w; }
    }
    __syncthreads();
    u32x2 keep[2][16];
#pragma unroll
    for (int pass = 0; pass < 2; ++pass) {
        const int xoff = pass == 0 ? 512 : 1024;
        const float w0 = cw[xoff + c], w1 = cw[1536 + xoff + c], w2 = cw[3072 + xoff + c], bs = cb[xoff + c], skip = sk[pass * 512 + c];
        f32x4 accP[16];
#pragma unroll
        for (int i = 0; i < 16; ++i) accP[i] = (f32x4){0.f, 0.f, 0.f, 0.f};
        hy_conv_pass<64, HY_UP, true>(accP, U, GA, F.wave, lane_);
#pragma unroll
        for (int sp = 0; sp < 2; ++sp) {
            const int v = 8 * sp + F.wave;
            unsigned pf0, pf1;
            { int lp = lane_; LAUNDER(lp); const bf16* pfp = UT + (size_t)(xoff + c) * CT_LD + (lp & 15) * RPB + CTXL + 256 * v + (lp >> 4) * 32;
              pf0 = *(const unsigned*)pfp; pf1 = *(const unsigned*)(pfp + 128); }
            f32x4 acc[16];
#pragma unroll
            for (int i = 0; i < 16; ++i) acc[i] = accP[i];
            if (sp == 0) hy_conv_pass<64, HY_UP, false>(acc, U + 4096, GBA, F.wave, lane_);
            else         hy_conv_pass<64, HY_UP, false>(acc, U, GCA, F.wave, lane_);
            asm volatile("" :: "v"(pf0), "v"(pf1) : "memory"); __builtin_amdgcn_sched_barrier(0);
            int ln = lane_; LAUNDER(ln); const int b = ln & 15, g = ln >> 4;
            const bf16* ux = UT + (size_t)(xoff + c) * CT_LD + b * RPB + CTXL + 256 * v + 4 * g;
#pragma unroll
            for (int tg = 0; tg < 4; ++tg) {
                u32x2 xw[4]; unsigned short xp[4], xn[4];
#pragma unroll
                for (int j = 0; j < 4; ++j) { const bf16* up = ux + 16 * (4 * tg + j); xw[j] = *(const u32x2*)up; xp[j] = up[-1]; xn[j] = up[4]; }
#pragma unroll
                for (int j = 0; j < 4; ++j) { const int ti = 4 * tg + j; const int tb = 256 * v + 16 * ti + 4 * g;
                    const float pv = tb > 0 ? bf2f(xp[j]) : 0.f, nx = tb + 4 < 4096 ? bf2f(xn[j]) : 0.f; const float u0 = bflo(xw[j].x), u1 = bfhi(xw[j].x), u2 = bflo(xw[j].y), u3 = bfhi(xw[j].y);
                    const f32x4 xx = (f32x4){w0 * pv + w1 * u0 + w2 * u1 + bs, w0 * u0 + w1 * u1 + w2 * u2 + bs, w0 * u1 + w1 * u2 + w2 * u3 + bs, w0 * u2 + w1 * u3 + w2 * nx + bs};
                    const u32x2 vw = *(const LAS u32x2*)(U + b * HY_UP + tb * 2); const f32x4 vv = (f32x4){bflo(vw.x), bfhi(vw.x), bflo(vw.y), bfhi(vw.y)};
                    const f32x4 res = xx * (acc[ti] + vv * skip); u32x2 w; w.x = pk2(res[0], res[1]); w.y = pk2(res[2], res[3]); keep[sp][ti] = w; }
                asm volatile("" : "+v"(keep[sp][4 * tg]), "+v"(keep[sp][4 * tg + 1]), "+v"(keep[sp][4 * tg + 2]), "+v"(keep[sp][4 * tg + 3]) :: "memory");
            }
        }
        __syncthreads();
        {   int ln = lane_; LAUNDER(ln); const int b = ln & 15, g = ln >> 4;
#pragma unroll
            for (int sp = 0; sp < 2; ++sp)
#pragma unroll
                for (int ti = 0; ti < 16; ++ti) { const int tb = 256 * (8 * sp + F.wave) + 16 * ti + 4 * g; *(LAS u32x2*)(U + b * HY_UP + tb * 2) = keep[sp][ti]; } }
        if (pass == 0) hy_load_filter(F, HR, 1, c, G3, red);
        else __syncthreads();
    }
    int tid3 = tid_; LAUNDER(tid3);
#pragma unroll 2
    for (int k = 0; k < 16; ++k) { const int q = tid3 + 512 * k, bb = q >> 9, t8 = (q & 511) * 8; const u32x4 w = *(const LAS u32x4*)(U + bb * HY_UP + t8 * 2);
        *(u32x4*)(YT + (size_t)c * CT_LD + bb * RPB + CTXL + t8) = w; }
    __syncthreads();
}
constexpr int HC_UP = 528, HC_G_OFF = 16 * HC_UP, HC_WAVE_BYTES = HC_G_OFF + 1024 + 64;
__device__ __forceinline__ void hc_load_filter(const float* HR, int order, int c, LAS unsigned short* GR, int lane) {
    float v[8]; float s = 0.f;
#pragma unroll
    for (int k = 0; k < 8; ++k) { const int i = lane + 64 * k; const int lag = 256 - i; float val = 0.f;
        if (i >= 1) val = lag >= 0 ? HR[(size_t)(order * 512 + c) * 256 + lag] : HR[(size_t)(1024 + order * 512 + c) * 256 - lag];
        v[k] = val; s += fabsf(val); }
    const float inv = 1.f / (wave_sum(s) + 1e-6f);
#pragma unroll
    for (int k = 0; k < 8; ++k) GR[lane + 64 * k] = (unsigned short)f2bf(v[k] * inv);
    LDS_WAIT(); asm volatile("" ::: "memory");
}
__device__ __forceinline__ void hyena_ctx_wave(Frame& F, const Args& a, int c) {
    const bf16* UT = (const bf16*)(F.ws + WS_BUF2); bf16* YT = (bf16*)(F.ws + WS_BUF4); const float* HR = (const float*)(F.ws + WS_HRAWC);
    const int lane = lane_id();
    LAS unsigned char* U = F.lds + F.wave * HC_WAVE_BYTES; LAS unsigned short* GR = (LAS unsigned short*)(U + HC_G_OFF);
    const float* cw = a.in[I_HYCW]; const float* cb = a.in[I_HYCB]; const float* sk = a.in[I_HYSKIP];
    hc_load_filter(HR, 0, c, GR, lane);
    {   const float w0 = cw[c], w1 = cw[1536 + c], w2 = cw[3072 + c], bs = cb[c];
#pragma unroll 2
        for (int k = 0; k < 8; ++k) { const int q = lane + 64 * k, b = q >> 5, t8 = (q & 31) * 8; const bf16* up = UT + (size_t)c * CT_LD + b * RPB + t8;
            const u32x4 uw = *(const u32x4*)up; const float e0 = t8 > 0 ? bf2f(up[-1]) : 0.f, e9 = t8 + 8 < 256 ? bf2f(up[8]) : 0.f;
            const float e1 = bflo(uw.x), e2 = bfhi(uw.x), e3 = bflo(uw.y), e4 = bfhi(uw.y), e5 = bflo(uw.z), e6 = bfhi(uw.z), e7 = bflo(uw.w), e8 = bfhi(uw.w);
            u32x4 w; w.x = pk2(w0 * e0 + w1 * e1 + w2 * e2 + bs, w0 * e1 + w1 * e2 + w2 * e3 + bs); w.y = pk2(w0 * e2 + w1 * e3 + w2 * e4 + bs, w0 * e3 + w1 * e4 + w2 * e5 + bs);
            w.z = pk2(w0 * e4 + w1 * e5 + w2 * e6 + bs, w0 * e5 + w1 * e6 + w2 * e7 + bs); w.w = pk2(w0 * e6 + w1 * e7 + w2 * e8 + bs, w0 * e7 + w1 * e8 + w2 * e9 + bs);
            *(LAS u32x4*)(U + b * HC_UP + t8 * 2) = w; }
        LDS_WAIT(); asm volatile("" ::: "memory");
    }
    const int b = lane & 15, g = lane >> 4;
#pragma unroll
    for (int pass = 0; pass < 2; ++pass) {
        const int xoff = pass == 0 ? 512 : 1024;
        const float w0 = cw[xoff + c], w1 = cw[1536 + xoff + c], w2 = cw[3072 + xoff + c], bs = cb[xoff + c], skip = sk[pass * 512 + c];
        f32x4 acc[16];
#pragma unroll
        for (int i = 0; i < 16; ++i) acc[i] = (f32x4){0.f, 0.f, 0.f, 0.f};
        hy_conv_pass<8, HC_UP>(acc, U, GR, 0, lane);
        const bf16* ux = UT + (size_t)(xoff + c) * CT_LD + b * RPB + 4 * g;
        u32x2 keep[16];
#pragma unroll
        for (int ti = 0; ti < 16; ++ti) { const int tb = 16 * ti + 4 * g; const bf16* up = ux + 16 * ti; const u32x2 xw = *(const u32x2*)up;
            const float pv = tb > 0 ? bf2f(up[-1]) : 0.f, nx = tb + 4 < 256 ? bf2f(up[4]) : 0.f; const float u0 = bflo(xw.x), u1 = bfhi(xw.x), u2 = bflo(xw.y), u3 = bfhi(xw.y);
            const f32x4 xx = (f32x4){w0 * pv + w1 * u0 + w2 * u1 + bs, w0 * u0 + w1 * u1 + w2 * u2 + bs, w0 * u1 + w1 * u2 + w2 * u3 + bs, w0 * u2 + w1 * u3 + w2 * nx + bs};
            const u32x2 vw = *(const LAS u32x2*)(U + b * HC_UP + tb * 2); const f32x4 vv = (f32x4){bflo(vw.x), bfhi(vw.x), bflo(vw.y), bfhi(vw.y)};
            const f32x4 res = xx * (acc[ti] + vv * skip); keep[ti].x = pk2(res[0], res[1]); keep[ti].y = pk2(res[2], res[3]); }
        if (pass == 0) {
            LDS_WAIT(); asm volatile("" ::: "memory");
#pragma unroll
            for (int ti = 0; ti < 16; ++ti) *(LAS u32x2*)(U + b * HC_UP + (16 * ti + 4 * g) * 2) = keep[ti];
            hc_load_filter(HR, 1, c, GR, lane);
        } else {
#pragma unroll
            for (int ti = 0; ti < 16; ++ti) *(u32x2*)(YT + (size_t)c * CT_LD + b * RPB + 16 * ti + 4 * g) = keep[ti];
        }
    }
    LDS_WAIT(); asm volatile("" ::: "memory");
}

constexpr int WL1_0 = W_ITEMS_L1MOE, WL1_1 = WL1_0 + 2400, WL1_2 = WL1_1 + 4000, WL1_3 = WL1_2 + 1100, WL1_4 = WL1_3 + 1100, WL1_5 = W_ITEMS_ALL;
__global__ void __launch_bounds__(NTHR, 2) fwd_kernel(Args args) {
    extern __shared__ __attribute__((aligned(16))) unsigned char lds_raw[];
    Frame F; F.lds = (LAS unsigned char*)lds_raw; F.wave = __builtin_amdgcn_readfirstlane((int)threadIdx.x >> 6); F.G = gridDim.x; F.bid = blockIdx.x;
    F.ws = args.ws; F.ctl = (gu32*)(args.ws + WS_CTL);
    unsigned char* ws = args.ws;
    volatile LAS unsigned* MISC = (volatile LAS unsigned*)(F.lds + MISC_OFF);
    { const int l0 = lane_id(); if (F.wave == 0) MISC[l0] = 0u; }
    __syncthreads();
    XcdBarrier bar; bar.bar = (unsigned*)(F.ctl + CW_BAR); bar.x = 0; bar.st = nullptr;
    if (args.one_launch) bar = xcd_barrier_post((unsigned*)(F.ctl + CW_BAR), MISC + 8, F.wave == 0 && lane_id() == 0);
    const int lo = args.ph_lo, hi = args.ph_hi;
#ifndef PHASE_MASK
#define PHASE_MASK 0xFFFFFFFFu
#endif
#define IN(k) ((((PHASE_MASK) >> (k)) & 1u) && lo <= (k) && (k) < hi)
#ifndef REP_PHASE
#define REP_PHASE -1
#endif
#ifndef REP_PART
#define REP_PART 3
#endif
#define TAIL_WEIGHTS(nu_, lo_, hi_) do { const int nu__ = (nu_); const int busy__ = nu__ - (nu__ / F.G) * F.G; if (busy__ > 0 && F.bid >= busy__) weight_items(F, args, (lo_), (hi_), F.bid - busy__, F.G - busy__); else if (busy__ == 0) weight_items(F, args, (lo_), (hi_), F.bid, F.G); __syncthreads(); } while (0)
#define PH(k, ...) if (IN(k)) { __VA_ARGS__ } if (REP_PHASE == (k) && IN(k)) { __VA_ARGS__ }
#define SEAM(k) do { if (IN(k) && IN((k) + 1)) xcd_barrier(bar, F.wave == 0 && lane_id() == 0); } while (0)
    const float* MOD0 = (const float*)(ws + WS_MOD); const float* MOD1 = MOD0 + 17 * 6144;
    LAS unsigned char* ring = F.lds;

    PH(0,  p0_prologue(F, args);) SEAM(0);
    PH(1,  p_norm1_l0(F, args);) SEAM(1);
    PH(2,
        { pg8::SchedInProj S{(const char*)(ws + WS_BUF1), (const char*)(ws + WS_WHY), (const char*)(ws + WS_WATT0), F.G, F.bid};
          pg8::EpiInProj E{pg8::EpiBf16{(bf16*)(ws + WS_BUF2), CT_LD}, pg8::EpiQkv<0>{(bf16*)(ws + WS_BUF3), D_ATT0, (const f32x2*)(ws + WS_ROPE), nullptr, nullptr}};
          pg8::gemm_phase<pg8::EpiInProj, pg8::SchedInProj, true>(ring, 1024, S, E, F.wave);
          { const int busy = 9 * 272 - (9 * 272 / F.G) * F.G; if (busy > 0 && busy < F.G && F.bid >= busy) p_filter_stage_b(F, args, F.bid - busy, F.G - busy); else if (busy == 0 || busy >= F.G) p_filter_stage_b(F, args, F.bid, F.G); __syncthreads(); }
          TAIL_WEIGHTS(9 * 272, WL1_0, WL1_1); }
    ) SEAM(2);
#define P3_HY do { for (int c = F.bid; c < HYC; c += F.G) hyena_latent_unit(F, args, c); for (int c = F.bid + F.G * F.wave; c < HYC; c += F.G * NWAVES) hyena_ctx_wave(F, args, c); __syncthreads(); } while (0)
#define P3_AT do { const attn_body::bf16* QKV = (const attn_body::bf16*)(ws + WS_BUF3); attn_body::bf16* YM = (attn_body::bf16*)(ws + WS_BUF1); \
        for (int L = F.bid; L < 2048 + 128; L += F.G) { \
            if (L < 2048) { const int b = L >> 7, h = (L >> 4) & 7, qb = L & 15, q0 = qb * 256; const int lat0 = q0 >= 128 ? q0 - 128 : 0; const int lend = q0 + 384 < SEQ ? q0 + 384 : SEQ; const int NT = 4 + (lend - lat0) / 64; \
                const attn_body::bf16* base = QKV + (size_t)b * RPB * D_ATT0; \
                attn_body::attn_unit<1, D_ATT0, D_ATT0, DM, 8>(base + (size_t)(CTXL + q0) * D_ATT0 + h * 64, base + 512 + (h >> 2) * 64, base + 640 + (h >> 2) * 64, \
                    YM + ((size_t)b * RPB + CTXL + q0) * DM + 512 + h * 64, NT, lat0, q0, args.in[I_SINK][h] * LOG2E, (char*)lds_raw, F.wave, 0.f, false, false, nullptr, nullptr); } \
            else { const int r = L - 2048, b = r >> 3, h = r & 7; const attn_body::bf16* base = QKV + (size_t)b * RPB * D_ATT0; \
                attn_body::attn_unit<0, D_ATT0, D_ATT0, DM, 8>(base + h * 64, base + 512 + (h >> 2) * 64, base + 640 + (h >> 2) * 64, \
                    YM + (size_t)b * RPB * DM + 512 + h * 64, 4, 0, 0, args.in[I_SINK][h] * LOG2E, (char*)lds_raw, F.wave, 0.f, false, false, nullptr, nullptr); } } } while (0)
    if (IN(3)) {
        P3_HY; if (REP_PHASE == 3 && (REP_PART & 1)) { P3_HY; }
    } SEAM(3);
    if (IN(4)) { if (F.bid & 1) { p_transpose_y(F); __syncthreads(); } P3_AT; if (REP_PHASE == 4) { P3_AT; } if (!(F.bid & 1)) { __syncthreads(); p_transpose_y(F); } } SEAM(4);
    PH(5,
        pg8::SchedDense S; S.init(ws + WS_BUF1, ws + WS_WOUT0, NROWS, 1024, 1024, F.G, F.bid);
        pg8::EpiOut E{(bf16*)(ws + WS_Y), MOD0};
        pg8::gemm_phase<pg8::EpiOut, pg8::SchedDense, true>(ring, 1024, S, E, F.wave);
        TAIL_WEIGHTS(272 * 4, WL1_1, WL1_2);) SEAM(5);
    PH(6,  p_norm2_route<0>(F, args);) SEAM(6);
    PH(7,
        LAS int* tab = (LAS int*)(F.lds + pg8::STAGE_BYTES); moe_tab(F, tab, 0);
        pg8::SchedMoe<true> S{(const char*)(ws + WS_BUF1), (const char*)(ws + WS_WGU), (size_t)1024 * 1024 * 2, 1024, tab, (const int*)(ws + WS_TOKIDX), F.G, F.bid};
        pg8::EpiGateUp E{(bf16*)(ws + WS_BUF5)};
        pg8::gemm_phase<pg8::EpiGateUp, pg8::SchedMoe<true>, true>(ring, 1024, S, E, F.wave);
        { const int nu7 = tab[32] * 4; __syncthreads(); TAIL_WEIGHTS(nu7, WL1_2, WL1_3); }) SEAM(7);
    PH(8,
        LAS int* tab = (LAS int*)(F.lds + pg8::STAGE_BYTES); moe_tab(F, tab, 0);
        pg8::SchedMoe<false> S{(const char*)(ws + WS_BUF5), (const char*)(ws + WS_WDN), (size_t)1024 * 512 * 2, 512, tab, nullptr, F.G, F.bid};
        pg8::EpiDown E{(bf16*)(ws + WS_BUF2), (const float*)(ws + WS_GATE), tab};
        pg8::gemm_phase<pg8::EpiDown, pg8::SchedMoe<false>, true>(ring, 512, S, E, F.wave);
        { const int nu8 = tab[32] * 4; __syncthreads(); TAIL_WEIGHTS(nu8, WL1_3, WL1_4); }) SEAM(8);
    PH(9,  p_combine<0>(F, args);) SEAM(9);
    PH(10,
        pg8::SchedQkv1 S{(const char*)(ws + WS_BUF1), (const char*)(ws + WS_WQKV1), 1024, F.G, F.bid};
        pg8::EpiQkv<1> E{(bf16*)(ws + WS_BUF2), D_QKV1, (const f32x2*)(ws + WS_ROPE), args.in[I_ODQG], args.in[I_ODKG]};
        pg8::gemm_phase<pg8::EpiQkv<1>, pg8::SchedQkv1, true>(ring, 1024, S, E, F.wave);
        TAIL_WEIGHTS(256 * 6 + 32, WL1_4, WL1_5);) SEAM(10);
    PH(11,
        const attn_body::bf16* QKV = (const attn_body::bf16*)(ws + WS_BUF2); attn_body::bf16* AO = (attn_body::bf16*)(ws + WS_BUF1);
        float gqm = 0.f, gkm = 0.f; for (int d = 0; d < 64; ++d) { gqm = fmaxf(gqm, fabsf(args.in[I_ODQG][d])); gkm = fmaxf(gkm, fabsf(args.in[I_ODKG][d])); }
        const float m0 = 64.f * gqm * gkm * QSCALE * 1.02f;
        if (m0 <= 40.f) {
        for (int L = F.bid; L < 4096; L += F.G) { const int b = L >> 8, h = (L >> 4) & 15, qb = L & 15, q0 = qb * 256; const attn_body::bf16* base = QKV + (size_t)b * RPB * D_QKV1;
            const int Ln = L + F.G; const bool hn = Ln < 4096; const int bn_ = hn ? Ln >> 8 : b, hn_ = hn ? (Ln >> 4) & 15 : h, qn_ = hn ? (Ln & 15) * 256 : q0; const attn_body::bf16* basen = QKV + (size_t)bn_ * RPB * D_QKV1;
            attn_body::attn_unit<0, D_QKV1, D_QKV1, DM, 8, true>(base + (size_t)(CTXL + q0) * D_QKV1 + h * 64, base + 1024 + (h >> 2) * 64, base + 1280 + (h >> 2) * 64,
                AO + ((size_t)b * RPB + CTXL + q0) * DM + h * 64, 68, 0, 0, -INFINITY, (char*)lds_raw, F.wave, m0, L != F.bid, hn, basen + 1024 + (hn_ >> 2) * 64, basen + 1280 + (hn_ >> 2) * 64); }
        } else {
        for (int L = F.bid; L < 4096; L += F.G) { const int b = L >> 8, h = (L >> 4) & 15, qb = L & 15, q0 = qb * 256; const attn_body::bf16* base = QKV + (size_t)b * RPB * D_QKV1;
            const int Ln = L + F.G; const bool hn = Ln < 4096; const int bn_ = hn ? Ln >> 8 : b, hn_ = hn ? (Ln >> 4) & 15 : h, qn_ = hn ? (Ln & 15) * 256 : q0; const attn_body::bf16* basen = QKV + (size_t)bn_ * RPB * D_QKV1;
            attn_body::attn_unit<0, D_QKV1, D_QKV1, DM, 8, false>(base + (size_t)(CTXL + q0) * D_QKV1 + h * 64, base + 1024 + (h >> 2) * 64, base + 1280 + (h >> 2) * 64,
                AO + ((size_t)b * RPB + CTXL + q0) * DM + h * 64, 68, 0, 0, -INFINITY, (char*)lds_raw, F.wave, 0.f, L != F.bid, hn, basen + 1024 + (hn_ >> 2) * 64, basen + 1280 + (hn_ >> 2) * 64); }
        }
    ) SEAM(11);
    PH(12,
        pg8::SchedLat S{(const char*)(ws + WS_BUF1), (const char*)(ws + WS_WOUT1), 1024, 4, F.G, F.bid};
        pg8::EpiOut E{(bf16*)(ws + WS_Y), MOD1};
        pg8::gemm_phase<pg8::EpiOut, pg8::SchedLat, true>(ring, 1024, S, E, F.wave);) SEAM(12);
    PH(13,  p_norm2_route<1>(F, args);) SEAM(13);
    PH(14,
        LAS int* tab = (LAS int*)(F.lds + pg8::STAGE_BYTES); moe_tab(F, tab, 1);
        pg8::SchedMoe<true> S{(const char*)(ws + WS_BUF1), (const char*)(ws + WS_WGU) + (size_t)32 * 1024 * 1024 * 2, (size_t)1024 * 1024 * 2, 1024, tab, (const int*)(ws + WS_TOKIDX), F.G, F.bid};
        pg8::EpiGateUp E{(bf16*)(ws + WS_BUF5)};
        pg8::gemm_phase<pg8::EpiGateUp, pg8::SchedMoe<true>, true>(ring, 1024, S, E, F.wave);) SEAM(14);
    PH(15,
        LAS int* tab = (LAS int*)(F.lds + pg8::STAGE_BYTES); moe_tab(F, tab, 1);
        pg8::SchedMoe<false> S{(const char*)(ws + WS_BUF5), (const char*)(ws + WS_WDN) + (size_t)32 * 1024 * 512 * 2, (size_t)1024 * 512 * 2, 512, tab, nullptr, F.G, F.bid};
        pg8::EpiDown E{(bf16*)(ws + WS_BUF2), (const float*)(ws + WS_GATE), tab};
        pg8::gemm_phase<pg8::EpiDown, pg8::SchedMoe<false>, true>(ring, 512, S, E, F.wave);) SEAM(15);
    PH(16, p_combine<1>(F, args);)

#undef IN
#undef SEAM
}

constexpr int N_PHASES = 17;
#ifndef MK_ONE_LAUNCH
#define MK_ONE_LAUNCH 1
#endif
extern "C" void kernel_launch(void* const* d_in, const int* in_sizes, int n_in, void* d_out, int out_size, void* d_ws, size_t ws_size, hipStream_t stream) {
    static int grid = 0;
    if (grid == 0) {
        if (n_in != 32 || out_size != NB * SEQ * DM || ws_size < WS_END) { fprintf(stderr, "kernel_launch: unexpected problem (n_in %d out %d ws %zu, need ws %zu)\n", n_in, out_size, ws_size, (size_t)WS_END); grid = -1; return; }
        int dev = 0, cus = 0, per_cu = 0;
        if (hipGetDevice(&dev) != hipSuccess || hipDeviceGetAttribute(&cus, hipDeviceAttributeMultiprocessorCount, dev) != hipSuccess) { grid = -1; return; }
        if (hipFuncSetAttribute((const void*)fwd_kernel, hipFuncAttributeMaxDynamicSharedMemorySize, LDS_BYTES) != hipSuccess) { fprintf(stderr, "kernel_launch: hipFuncSetAttribute failed\n"); grid = -1; return; }
        if (hipOccupancyMaxActiveBlocksPerMultiprocessor(&per_cu, (const void*)fwd_kernel, NTHR, LDS_BYTES) != hipSuccess || per_cu < 1) fprintf(stderr, "kernel_launch: occupancy query says %d\n", per_cu);
        (void)hipGetLastError();
        grid = cus;
    }
    if (grid < 0) return;
    (void)hipMemsetAsync((char*)d_ws + WS_CTL, 0, CTL_ZERO_BYTES, stream);
    Args a{};
    for (int i = 0; i < 32; ++i) a.in[i] = (const float*)d_in[i];
    a.out = (float*)d_out; a.ws = (unsigned char*)d_ws; a.pad = 0;
    if (MK_ONE_LAUNCH) { a.ph_lo = 0; a.ph_hi = N_PHASES; a.one_launch = 1; hipLaunchKernelGGL(fwd_kernel, dim3(grid), dim3(NTHR), LDS_BYTES, stream, a); }
    else for (int p = 0; p < N_PHASES; ++p) { a.ph_lo = p; a.ph_hi = p + 1; a.one_launch = 0; hipLaunchKernelGGL(fwd_kernel, dim3(grid), dim3(NTHR), LDS_BYTES, stream, a); }
}
```
